# Optimizing an MI355X kernel written in HIP

```python
import jax, jax.numpy as jnp
from jax import lax
import numpy as np

D_MODEL = 2048
BATCH = 2
SEQ = 16384
DEPTH = 2
DEC_BATCH = 32
DEC_SEQ = 16
PAST_LEN = 4096

CHUNK = 64
N_BRANCH = 4
BRANCH_WIDTH = D_MODEL // N_BRANCH
HEAD_DIM = 128
N_HEADS = BRANCH_WIDTH // HEAD_DIM
CONV_WIDTH = 31
CONV_CH = BRANCH_WIDTH
Q_BLOCK = 128
ROPE_BASE = 10000.0
NORM_EPS = 1e-6
LN_EPS = 1e-5
N_IN = 16 * BRANCH_WIDTH + 2 * N_HEADS + N_BRANCH * D_MODEL

kernel_name = 'streaming_hybrid_gated_encoder'


def _split_cols(p):
    W, H, D = BRANCH_WIDTH, N_HEADS, D_MODEL
    sizes = [W] * 4 + [W] * 5 + [H, H] + [W] * 4 + [W] * 3 + [D] * N_BRANCH
    idx = np.cumsum(sizes)[:-1].tolist()
    return jnp.split(p, idx, axis=-1)


def _rmsnorm(x, g):
    x32 = x.astype(jnp.float32)
    y = x32 * lax.rsqrt(jnp.mean(x32 * x32, axis=-1, keepdims=True) + NORM_EPS)
    return (y * g.astype(jnp.float32)).astype(x.dtype)


def _head_norm(x):
    mu = jnp.mean(x, axis=-1, keepdims=True)
    xc = x - mu
    return xc * lax.rsqrt(jnp.mean(xc * xc, axis=-1, keepdims=True) + LN_EPS)


def _layernorm(x, g, b):
    x32 = x.astype(jnp.float32)
    return _head_norm(x32) * g.astype(jnp.float32) + b.astype(jnp.float32)


def _rotary(x, pos):
    half = HEAD_DIM // 2
    inv = ROPE_BASE ** (-jnp.arange(half, dtype=jnp.float32) / half)
    ang = pos.astype(jnp.float32)[:, None] * inv[None, :]
    cos = jnp.cos(ang)[None, :, None, :]
    sin = jnp.sin(ang)[None, :, None, :]
    x1, x2 = x[..., :half], x[..., half:]
    return jnp.concatenate([x1 * cos - x2 * sin, x1 * sin + x2 * cos], axis=-1)


def _sb_block(q, k, v, q_pos, k_pos):
    z = jnp.einsum('bqhd,bkhd->bhqk', q, k).astype(jnp.float32) * (HEAD_DIM ** -0.5)
    causal = (k_pos[None, :] < q_pos[:, None])[None, None]
    log_1mb = jnp.where(causal, jax.nn.log_sigmoid(-z), 0.0)
    later = lax.cumsum(log_1mb, axis=3, reverse=True) - log_1mb
    w = jnp.where(causal, jnp.exp(jax.nn.log_sigmoid(z) + later), 0.0)
    return jnp.einsum('bhqk,bkhd->bqhd', w.astype(v.dtype), v)


def _stick_breaking(q, k, v, q_pos, k_pos):
    B, T, H, d = q.shape
    blk = min(Q_BLOCK, T)
    nb = T // blk
    qb = q.reshape(B, nb, blk, H, d).transpose(1, 0, 2, 3, 4)
    pb = q_pos.reshape(nb, blk)
    out = lax.map(lambda a: _sb_block(a[0], k, v, a[1], k_pos), (qb, pb))
    return out.transpose(1, 0, 2, 3, 4).reshape(B, T, H, d)


def _mlstm(q, k, v, i_pre, log_f, C0, n0, m0):
    B, T, H, d = q.shape
    L = min(CHUNK, T)
    nc = T // L
    to_chunks = lambda a: a.reshape((B, nc, L) + a.shape[2:]).swapaxes(0, 1)
    tri = jnp.tril(jnp.ones((L, L), bool))

    def step(carry, xs):
        C, n, m = carry
        qc, kc, vc, ic, fc = xs
        b = jnp.cumsum(fc, axis=1).swapaxes(1, 2)
        iT = ic.swapaxes(1, 2)
        logD = jnp.where(tri, b[..., :, None] - b[..., None, :] + iT[..., None, :], -jnp.inf)
        inter = m[..., None] + b
        m_row = jnp.maximum(inter, jnp.max(logD, axis=-1))
        w = jnp.exp(logD - m_row[..., None]) * jnp.einsum('bthd,bshd->bhts', qc, kc)
        a_inter = jnp.exp(inter - m_row)
        num = (jnp.einsum('bhts,bshe->bthe', w, vc)
               + a_inter.swapaxes(1, 2)[..., None] * jnp.einsum('bthd,bhde->bthe', qc, C))
        den = jnp.sum(w, axis=-1) + a_inter * jnp.einsum('bthd,bhd->bht', qc, n)
        h = num / jnp.maximum(jnp.abs(den), jnp.exp(-m_row)).swapaxes(1, 2)[..., None]
        g = b[..., -1:] - b + iT
        m_new = jnp.maximum(m + b[..., -1], jnp.max(g, axis=-1))
        decay = jnp.exp(m + b[..., -1] - m_new)
        wg = jnp.exp(g - m_new[..., None])
        C_new = decay[..., None, None] * C + jnp.einsum('bhs,bshd,bshe->bhde', wg, kc, vc)
        n_new = decay[..., None] * n + jnp.einsum('bhs,bshd->bhd', wg, kc)
        return (C_new, n_new, m_new), h

    (C, n, m), hs = lax.scan(step, (C0, n0, m0), tuple(to_chunks(a) for a in (q, k, v, i_pre, log_f)))
    return hs.swapaxes(0, 1).reshape(B, T, H, d), C, n, m


def _retention(q, k, v, S0):
    B, T, H, d = q.shape
    L = min(CHUNK, T)
    nc = T // L
    lg = jnp.log1p(-jnp.exp2(-5.0 - jnp.arange(H, dtype=jnp.float32)))
    t = jnp.arange(L, dtype=jnp.float32)
    rel = t[:, None] - t[None, :]
    decay_mask = jnp.where(rel >= 0, jnp.exp(lg[:, None, None] * jnp.maximum(rel, 0.0)), 0.0)
    q_decay = jnp.exp(lg[:, None] * (t + 1.0)).T[None, :, :, None]
    k_decay = jnp.exp(lg[:, None] * (L - 1.0 - t))
    chunk_decay = jnp.exp(lg * L)[:, None, None]
    to_chunks = lambda a: a.reshape(B, nc, L, H, d).swapaxes(0, 1)

    def step(S, xs):
        qc, kc, vc = xs
        att = jnp.einsum('bthd,bshd->bhts', qc, kc) * decay_mask
        o = jnp.einsum('bhts,bshe->bthe', att, vc) + jnp.einsum('bthd,bhde->bthe', qc, S) * q_decay
        S_new = chunk_decay * S + jnp.einsum('bshd,bshe,hs->bhde', kc, vc, k_decay)
        return S_new, o

    S, os_ = lax.scan(step, S0, (to_chunks(q), to_chunks(k), to_chunks(v)))
    return os_.swapaxes(0, 1).reshape(B, T, H, d), S


def _causal_dwconv(u, buf, w, b):
    xp = jnp.concatenate([buf.astype(u.dtype), u], axis=1)
    y = lax.conv_general_dilated(xp, w[:, None, :].astype(u.dtype), window_strides=(1,), padding='VALID',
                                 dimension_numbers=('NWC', 'WIO', 'NWC'), feature_group_count=u.shape[-1])
    return y + b.astype(u.dtype), xp[:, xp.shape[1] - (CONV_WIDTH - 1):]


def _layer(x, pos, past_kv, C0, n0, m0, S0, conv0,
           norm_g, w_in, b_i, b_f, conv_w, conv_b, ln_g, ln_b, w_branch, w_out):
    B, T, _ = x.shape
    f32 = jnp.float32
    dt = x.dtype
    hin = _rmsnorm(x, norm_g)
    (qa, ka, va, za, qb, kb, vb, ob, zb, ib, fb,
     qc, kc, vc, zc, ud, gd, zd, *gate_pre) = _split_cols(hin @ w_in)
    heads = lambda a: a.reshape(B, T, N_HEADS, HEAD_DIM)

    ka_h, va_h = heads(ka), heads(va)
    if past_kv is None:
        k_all, v_all = ka_h, va_h
    else:
        k_all = jnp.concatenate([past_kv[0].astype(dt), ka_h], axis=1)
        v_all = jnp.concatenate([past_kv[1].astype(dt), va_h], axis=1)
    k_pos = jnp.arange(k_all.shape[1])
    ya = _stick_breaking(heads(qa), k_all, v_all, pos, k_pos).reshape(B, T, BRANCH_WIDTH) * jax.nn.silu(za)

    hb, C1, n1, m1 = _mlstm(heads(qb).astype(f32), heads(kb).astype(f32) * (HEAD_DIM ** -0.5),
                            heads(vb).astype(f32), ib.astype(f32) + b_i.astype(f32),
                            jax.nn.log_sigmoid(fb.astype(f32) + b_f.astype(f32)),
                            C0.astype(f32), n0.astype(f32), m0.astype(f32))
    yb = (_head_norm(hb).reshape(B, T, BRANCH_WIDTH) * jax.nn.sigmoid(ob.astype(f32))).astype(dt) * jax.nn.silu(zb)

    qr = _rotary(heads(qc).astype(f32), pos)
    kr = _rotary(heads(kc).astype(f32), pos) * (HEAD_DIM ** -0.5)
    hc, S1 = _retention(qr, kr, heads(vc).astype(f32), S0.astype(f32))
    yc = _head_norm(hc).reshape(B, T, BRANCH_WIDTH).astype(dt) * jax.nn.silu(zc)

    glu = ud * jax.nn.sigmoid(gd)
    cv, conv1 = _causal_dwconv(glu, conv0, conv_w, conv_b)
    yd = jax.nn.silu(_layernorm(cv, ln_g, ln_b)).astype(dt) * jax.nn.silu(zd)

    merged = jax.nn.sigmoid(gate_pre[0]) * (ya @ w_branch[0])
    merged = merged + jax.nn.sigmoid(gate_pre[1]) * (yb @ w_branch[1])
    merged = merged + jax.nn.sigmoid(gate_pre[2]) * (yc @ w_branch[2])
    merged = merged + jax.nn.sigmoid(gate_pre[3]) * (yd @ w_branch[3])
    new_state = (ka_h, va_h, C1.astype(dt), n1.astype(dt), m1.astype(dt), S1.astype(dt), conv1)
    return x + merged @ w_out, new_state


def _trunk(x, past_len, cache_k, cache_v, C0, n0, m0, S0, conv0,
           norm_g, w_in, b_i, b_f, conv_w, conv_b, ln_g, ln_b, w_branch, w_out, final_g):
    T = x.shape[1]
    pos = past_len + jnp.arange(T)
    per_layer = []
    for l in range(DEPTH):
        past = None if cache_k is None else (cache_k[l], cache_v[l])
        x, st = _layer(x, pos, past, C0[l], n0[l], m0[l], S0[l], conv0[l],
                       norm_g[l], w_in[l], b_i[l], b_f[l], conv_w[l], conv_b[l],
                       ln_g[l], ln_b[l], w_branch[l], w_out[l])
        per_layer.append(st)
    stacked = tuple(jnp.stack(s, axis=0) for s in zip(*per_layer))
    return _rmsnorm(x, final_g), stacked


def setup_inputs(seed: int = 0) -> dict:
    key = jax.random.key(seed)
    ks = jax.random.split(key, 20)
    H, HD, W, D = N_HEADS, HEAD_DIM, BRANCH_WIDTH, D_MODEL
    nrm = lambda k, shape, s=1.0: s * jax.random.normal(k, shape, jnp.float32)
    return {
        'x_prompt': nrm(ks[0], (BATCH, SEQ, D)),
        'x_sample': nrm(ks[1], (DEC_BATCH, DEC_SEQ, D)),
        'cache_sb_k': nrm(ks[2], (DEPTH, DEC_BATCH, PAST_LEN, H, HD)),
        'cache_sb_v': nrm(ks[3], (DEPTH, DEC_BATCH, PAST_LEN, H, HD)),
        'state_mlstm_C': nrm(ks[4], (DEPTH, DEC_BATCH, H, HD, HD), 0.5),
        'state_mlstm_n': nrm(ks[5], (DEPTH, DEC_BATCH, H, HD), 0.5),
        'state_mlstm_m': nrm(ks[6], (DEPTH, DEC_BATCH, H)),
        'state_ret_S': nrm(ks[7], (DEPTH, DEC_BATCH, H, HD, HD)),
        'state_conv': nrm(ks[8], (DEPTH, DEC_BATCH, CONV_WIDTH - 1, CONV_CH), 0.5),
        'norm_g': 1.0 + nrm(ks[9], (DEPTH, D), 0.02),
        'w_in': nrm(ks[10], (DEPTH, D, N_IN), D ** -0.5),
        'mlstm_b_i': nrm(ks[11], (DEPTH, H), 0.1),
        'mlstm_b_f': jnp.linspace(3.0, 6.0, H, dtype=jnp.float32)[None, :] + nrm(ks[12], (DEPTH, H), 0.1),
        'conv_w': nrm(ks[13], (DEPTH, CONV_WIDTH, CONV_CH), CONV_WIDTH ** -0.5),
        'conv_b': nrm(ks[14], (DEPTH, CONV_CH), 0.02),
        'conv_ln_g': 1.0 + nrm(ks[15], (DEPTH, CONV_CH), 0.02),
        'conv_ln_b': nrm(ks[16], (DEPTH, CONV_CH), 0.02),
        'w_branch': nrm(ks[17], (DEPTH, N_BRANCH, W, D), W ** -0.5),
        'w_out': nrm(ks[18], (DEPTH, D, D), D ** -0.5),
        'final_g': 1.0 + nrm(ks[19], (D,), 0.02),
    }


def reference(x_prompt, x_sample, cache_sb_k, cache_sb_v, state_mlstm_C, state_mlstm_n, state_mlstm_m,
              state_ret_S, state_conv, norm_g, w_in, mlstm_b_i, mlstm_b_f, conv_w, conv_b,
              conv_ln_g, conv_ln_b, w_branch, w_out, final_g):
    Bp = x_prompt.shape[0]
    zC = jnp.zeros((DEPTH, Bp, N_HEADS, HEAD_DIM, HEAD_DIM), jnp.float32)
    zn = jnp.zeros((DEPTH, Bp, N_HEADS, HEAD_DIM), jnp.float32)
    zm = jnp.zeros((DEPTH, Bp, N_HEADS), jnp.float32)
    zconv = jnp.zeros((DEPTH, Bp, CONV_WIDTH - 1, CONV_CH), x_prompt.dtype)
    y_prompt, (pk, pv, pC, pn, pm, pS, pconv) = _trunk(
        x_prompt, 0, None, None, zC, zn, zm, zC, zconv,
        norm_g, w_in, mlstm_b_i, mlstm_b_f, conv_w, conv_b, conv_ln_g, conv_ln_b, w_branch, w_out, final_g)
    y_sample, (sk, sv, sC, sn, sm, sS, sconv) = _trunk(
        x_sample, cache_sb_k.shape[2], cache_sb_k, cache_sb_v, state_mlstm_C, state_mlstm_n, state_mlstm_m,
        state_ret_S, state_conv,
        norm_g, w_in, mlstm_b_i, mlstm_b_f, conv_w, conv_b, conv_ln_g, conv_ln_b, w_branch, w_out, final_g)
    return (y_prompt, y_sample, pk, pv, pC, pn, pm, pS, pconv, sk, sv, sC, sn, sm, sS, sconv)
```

```cpp
#ifndef EMU
#include <hip/hip_runtime.h>
#include <cstdio>
#include <cstdint>
#include <cstring>
#endif

typedef unsigned short bf16_t;
typedef short bf16x8 __attribute__((ext_vector_type(8)));
typedef short s16x4 __attribute__((ext_vector_type(4)));
typedef float f32x4 __attribute__((ext_vector_type(4)));
typedef float f32x16 __attribute__((ext_vector_type(16)));
typedef unsigned u32x4 __attribute__((ext_vector_type(4)));
typedef unsigned u32x2 __attribute__((ext_vector_type(2)));

#ifdef EMU
#define DI inline
#define LAS
#define GAS
DI unsigned f_bits(float f) { unsigned u; memcpy(&u, &f, 4); return u; }
DI float bits_f(unsigned u) { float f; memcpy(&f, &u, 4); return f; }
DI float ex2(float x) { return exp2f(x); }
DI float lg2(float x) { return log2f(x); }
DI float frcp(float x) { return 1.0f / x; }
DI float wshfl(float v, int src) { auto s = emu::wave_exchange(&v, 4); float r; memcpy(&r, s[src & 63], 4); return r; }
DI float wshfl_xor(float v, int m, int lane) { return wshfl(v, lane ^ m); }
DI float wshfl_up(float v, int d, int lane) { return wshfl(v, lane >= d ? lane - d : lane); }
DI int rfl(int v) { return v; }
DI float bf2f(bf16_t b) { return bits_f((unsigned)b << 16); }
DI f32x16 mfma32(bf16x8 a, bf16x8 b, f32x16 c) {
  struct { bf16x8 a, b; } d{a, b};
  auto s = emu::wave_exchange(&d, 32);
  int lane = emu::tid() & 63, r = lane & 31, h = lane >> 5;
  f32x16 o = c;
  for (int i = 0; i < 16; ++i) {
    int row = (i & 3) + 8 * (i >> 2) + 4 * h; double acc = 0;
    for (int k = 0; k < 16; ++k) {
      bf16x8 av, bv; memcpy(&av, s[row + 32 * (k >> 3)], 16); memcpy(&bv, (char*)s[r + 32 * (k >> 3)] + 16, 16);
      acc += (double)bf2f((bf16_t)av[k & 7]) * (double)bf2f((bf16_t)bv[k & 7]);
    }
    o[i] = c[i] + (float)acc;
  }
  return o;
}
DI s16x4 ds_tr16(const void* p) {
  auto s = emu::wave_exchange(&p, 8);
  int lane = emu::tid() & 63, g = lane & ~15, i = lane & 15;
  s16x4 o;
  for (int q = 0; q < 4; ++q) { const short* a; memcpy(&a, s[g + 4 * q + (i >> 2)], 8); o[q] = a[i & 3]; }
  return o;
}
#define OPAQUE_V(x) do {} while (0)
#define NT_STORE(ptr, val) (*(ptr) = (val))
#define VM_WAIT() do {} while (0)
#define LDS_WAIT() do { int _z = 0; (void)emu::wave_exchange(&_z, 4); } while (0)
#define DYN_LDS(name) unsigned char* name = emu::g_blk->lds
DI float log1p_f(float x) { return log1pf(x); }
#else
#define DI __device__ __forceinline__
#define LAS __attribute__((address_space(3)))
#define GAS __attribute__((address_space(1)))
DI unsigned f_bits(float f) { return __builtin_bit_cast(unsigned, f); }
DI float bits_f(unsigned u) { return __builtin_bit_cast(float, u); }
DI float ex2(float x) { return __builtin_amdgcn_exp2f(x); }
DI float lg2(float x) { return __builtin_amdgcn_logf(x); }
DI float frcp(float x) { return __builtin_amdgcn_rcpf(x); }
DI float wshfl(float v, int src) { return bits_f((unsigned)__builtin_amdgcn_ds_bpermute(src << 2, (int)f_bits(v))); }
DI float wshfl_xor(float v, int m, int lane) { return wshfl(v, lane ^ m); }
DI float wshfl_up(float v, int d, int lane) { return wshfl(v, lane >= d ? lane - d : lane); }
DI int rfl(int v) { return __builtin_amdgcn_readfirstlane(v); }
DI float bf2f(bf16_t b) { return bits_f((unsigned)b << 16); }
DI f32x16 mfma32(bf16x8 a, bf16x8 b, f32x16 c) { return __builtin_amdgcn_mfma_f32_32x32x16_bf16(a, b, c, 0, 0, 0); }
DI s16x4 ds_tr16(const LAS void* p) { return __builtin_amdgcn_ds_read_tr16_b64_v4i16((LAS s16x4*)p); }
#define OPAQUE_V(x) asm volatile("" : "+v"(x))
#define NT_STORE(ptr, val) __builtin_nontemporal_store((val), (ptr))
#define VM_WAIT() asm volatile("s_waitcnt vmcnt(0)" ::: "memory")
#define LDS_WAIT() asm volatile("s_waitcnt lgkmcnt(0)" ::: "memory")
#define DYN_LDS(name) extern __shared__ __attribute__((aligned(16))) unsigned char name##_raw[]; LAS unsigned char* name = (LAS unsigned char*)name##_raw
DI float log1p_f(float x) { return x < 1e-4f ? x * (1.0f - 0.5f * x) : __builtin_amdgcn_logf(1.0f + x) * 0.6931471805599453f; }
#endif

DI bf16_t f2bf(float f) { unsigned u = f_bits(f); return (bf16_t)((u + 0x7fffu + ((u >> 16) & 1u)) >> 16); }
#ifdef EMU
DI unsigned pk2(float lo, float hi) { return (unsigned)f2bf(lo) | ((unsigned)f2bf(hi) << 16); }
#else
typedef float f32x2_t __attribute__((ext_vector_type(2))); typedef __bf16 bf16x2_t __attribute__((ext_vector_type(2)));
DI unsigned pk2(float lo, float hi) { f32x2_t v = {lo, hi}; bf16x2_t b = __builtin_convertvector(v, bf16x2_t); return __builtin_bit_cast(unsigned, b); }
#endif
DI bf16x8 pack8(float a0, float a1, float a2, float a3, float a4, float a5, float a6, float a7) {
  u32x4 p; p.x = pk2(a0, a1); p.y = pk2(a2, a3); p.z = pk2(a4, a5); p.w = pk2(a6, a7); return __builtin_bit_cast(bf16x8, p);
}
DI void unpack8(const u32x4 g, float (&o)[8]) {
#pragma unroll
  for (int j = 0; j < 4; ++j) { o[2 * j] = bits_f(g[j] << 16); o[2 * j + 1] = bits_f(g[j] & 0xffff0000u); }
}
DI float wave_sum(float v, int lane) {
#pragma unroll
  for (int o = 1; o < 64; o <<= 1) v += wshfl_xor(v, o, lane);
  return v;
}
DI float wave_max(float v, int lane) {
#pragma unroll
  for (int o = 1; o < 64; o <<= 1) v = fmaxf(v, wshfl_xor(v, o, lane));
  return v;
}
DI float wave_min(float v, int lane) {
#pragma unroll
  for (int o = 1; o < 64; o <<= 1) v = fminf(v, wshfl_xor(v, o, lane));
  return v;
}
DI float half_sum(float v, int lane) {
#pragma unroll
  for (int o = 1; o < 32; o <<= 1) v += wshfl_xor(v, o, lane);
  return v;
}
DI float sigmoid_f(float x) { return 1.0f / (1.0f + __expf(-x)); }
DI float silu_f(float x) { return x * sigmoid_f(x); }
DI int crow(int i, int h) { return (i & 3) + 8 * (i >> 2) + 4 * h; }


#ifdef EMU
constexpr int SEQ = EMU_SEQ, PAST = EMU_PAST;
#else
constexpr int SEQ = 16384, PAST = 4096;
#endif
constexpr int D = 2048, NBATCH = 2, DEPTH = 2, DB = 32, DS = 16, W = 512, NH = 4, HD = 128, CW = 31;
constexpr int TP = NBATCH * SEQ, TS = DB * DS, T = TP + TS;
constexpr int NP = 16384, N_IN = 16392, GATE_COL = 4608;
#define PIX(row, cb) (((size_t)(cb) * T + (size_t)(row)) * 512)
constexpr int NCH_P = SEQ / 64, NSEQ_P = NBATCH * NH, NSEQ_S = DB * NH, NSEQ = NSEQ_P + NSEQ_S;
constexpr int NCHUNK = NSEQ_P * NCH_P + NSEQ_S;
constexpr int NWAVES = 8, NTHREADS = 512;
static_assert(T % 256 == 0 && SEQ % 64 == 0 && PAST % 32 == 0 && PAST + DS <= SEQ, "shapes");
constexpr int CB_QA = 0, CB_KA = 1, CB_VA = 2, CB_ZA = 3, CB_QB = 4, CB_KB = 5, CB_VB = 6, CB_OB = 7, CB_ZB = 8, CB_QC = 9, CB_KC = 10, CB_VC = 11, CB_ZC = 12,
              CB_UD = 13, CB_GD = 14, CB_ZD = 15, CB_G0 = 16;
constexpr size_t O_Y = 0;
constexpr size_t O_PK = O_Y + (size_t)T * D;
constexpr size_t O_PV = O_PK + (size_t)DEPTH * TP * W;
constexpr size_t O_PC = O_PV + (size_t)DEPTH * TP * W;
constexpr size_t O_PN = O_PC + (size_t)DEPTH * NBATCH * NH * HD * HD;
constexpr size_t O_PM = O_PN + (size_t)DEPTH * NBATCH * NH * HD;
constexpr size_t O_PS = O_PM + (size_t)DEPTH * NBATCH * NH;
constexpr size_t O_PCONV = O_PS + (size_t)DEPTH * NBATCH * NH * HD * HD;
constexpr size_t O_SK = O_PCONV + (size_t)DEPTH * NBATCH * 30 * W;
constexpr size_t O_SV = O_SK + (size_t)DEPTH * TS * W;
constexpr size_t O_SC = O_SV + (size_t)DEPTH * TS * W;
constexpr size_t O_SN = O_SC + (size_t)DEPTH * DB * NH * HD * HD;
constexpr size_t O_SM = O_SN + (size_t)DEPTH * DB * NH * HD;
constexpr size_t O_SS = O_SM + (size_t)DEPTH * DB * NH;
constexpr size_t O_SCONV = O_SS + (size_t)DEPTH * DB * NH * HD * HD;
constexpr size_t O_END = O_SCONV + (size_t)DEPTH * DB * 30 * W;
constexpr size_t MiB = 1u << 20;
constexpr size_t al(size_t x) { return (x + 4095) & ~(size_t)4095; }
constexpr size_t WS_CTL = 0, CTL_BYTES = 1 * MiB;
constexpr size_t WS_WIN = WS_CTL + CTL_BYTES;
constexpr size_t WS_WBR = WS_WIN + al((size_t)DEPTH * NP * D * 2);
constexpr size_t WS_WOUT = WS_WBR + al((size_t)DEPTH * 4 * D * W * 2);
constexpr size_t WS_ROPE = WS_WOUT + al((size_t)DEPTH * D * D * 2);
constexpr size_t WS_IG = WS_ROPE + al((size_t)SEQ * 64 * 8);
constexpr size_t WS_LF = WS_IG + al((size_t)T * 4 * 4);
constexpr size_t WS_SCB = WS_LF + al((size_t)T * 4 * 4);
constexpr size_t WS_SCG = WS_SCB + al((size_t)NCHUNK * 4);
constexpr size_t WS_MC = WS_SCG + al((size_t)NCHUNK * 4);
constexpr size_t WS_HIN = WS_MC + al((size_t)NCHUNK * 4);
constexpr int ST_ROWS = 160;
constexpr size_t ST_BYTES = (size_t)ST_ROWS * HD * 2;
constexpr size_t WS_ST = WS_HIN + al((size_t)T * D * 2);
constexpr size_t WS_ST2 = WS_ST + al((size_t)2 * NCHUNK * ST_BYTES);
constexpr size_t WS_P = WS_ST2 + al((size_t)2 * NCHUNK * ST_BYTES);
constexpr size_t WS_YCAT = WS_P + al((size_t)T * NP * 2);
constexpr size_t WS_MG = WS_YCAT + al((size_t)T * D * 2);
constexpr size_t WS_END = WS_MG + al((size_t)T * D * 2);
constexpr int WSCR = 18304;
constexpr int LDSCTL_OFF = NWAVES * WSCR;
constexpr int LDS_BYTES = 147456;
static_assert(LDSCTL_OFF + 64 <= LDS_BYTES && LDSCTL_OFF % 16 == 0, "lds map");
constexpr int TS272 = 272;

struct Args {
  const float* in[20]; float* out; unsigned char* ws; int ph_lo, ph_hi;
};

namespace pg8 {
constexpr int BM = 256, BK = 64, HALF = 128, HTB = HALF * BK * 2, STAGE_BYTES = 8 * HTB, NXCD = 8, WGM = 4;
__host__ __device__ inline int lds_byte(int r, int c) { const int st = (r >> 4) * 2 + (c >> 5), rr = r & 15, cc = c & 31, ob = rr * 64 + cc * 2; return st * 1024 + (ob ^ (((ob >> 9) & 1) << 5)); }
__host__ __device__ inline void stage_rc(int b, int& R, int& C) { const int st = b / 1024, sb = b % 1024, swz = sb ^ (((sb >> 9) & 1) << 5); R = (st >> 1) * 16 + swz / 64; C = (st & 1) * 32 + (swz % 64) / 2; }
__host__ __device__ inline int perm32(int rho) { const int n = rho >> 4, i = rho & 15; return 8 * (i >> 2) + 4 * n + (i & 3); }
struct Unit { int pm, pn, kb; };
struct Gemm { const bf16_t* A; const bf16_t* Bt; int M, N, K, lda, ldb; size_t kbA, kbB; };
struct StaticOrder {
  int nM, nN, nwg, G, c;
  __host__ __device__ void init(int M, int N, int G_, int c_) { nM = M / BM; nN = N / BM; nwg = nM * nN; G = G_; c = c_; }
  __host__ __device__ bool tile(long L, Unit& u) const {
    if (L >= nwg) return false;
    int wgid = (int)L; { const int q = nwg / NXCD, r = nwg % NXCD, xcd = wgid % NXCD, off = wgid / NXCD; wgid = (xcd < r ? xcd * (q + 1) : r * (q + 1) + (xcd - r) * q) + off; }
    const int nig = WGM * nN, gid = wgid / nig, fm = gid * WGM, gsz = (nM - fm) < WGM ? (nM - fm) : WGM;
    u.pm = fm + ((wgid % nig) % gsz); u.pn = (wgid % nig) / gsz; u.kb = 0; return true;
  }
  __host__ __device__ bool next(int i, Unit& u) const { return tile((long)i * G + c, u); }
};
#ifndef EMU
template <class Epi, class Sched, bool ALIGN_EPI>
__device__ __forceinline__ void gemm_phase(LAS unsigned char* lds, const Gemm g, const Sched& S, const Epi& E, const int tid) {
  const int wid = __builtin_amdgcn_readfirstlane(tid >> 6), lane = tid & 63, wr = wid >> 2, wc = wid & 3, fr = lane & 15, fq = lane >> 4;
  const int nt = g.K / BK;
  unsigned voffA[2], voffB[2];
#pragma unroll
  for (int i = 0; i < 2; ++i) { int R, C; stage_rc(tid * 16 + i * 8192, R, C); const int Rb = Epi::PERM ? ((R & ~31) + perm32(R & 31)) : R;
    voffA[i] = (unsigned)(R * g.lda + C) * 2u; voffB[i] = (unsigned)(Rb * g.ldb + C) * 2u; }
  const size_t kstep = (size_t)(BK * 2);
  const size_t hstepA = (size_t)HALF * g.lda * 2, hstepB = (size_t)HALF * g.ldb * 2;
  const unsigned ldsw = (unsigned)wid * 1024u;
  const int aoff = lds_byte(wr * 64 + fr, fq * 8), boff = lds_byte(wc * 32 + fr, fq * 8);
#define PG8_SA(b, h) (((b) * 2 + (h)) * HTB)
#define PG8_SB(b, h) ((4 + (b) * 2 + (h)) * HTB)
#define PG8_STAGE(bufoff, gbase, voff) do { _Pragma("unroll") for (int _i = 0; _i < 2; ++_i) \
    __builtin_amdgcn_global_load_lds((const unsigned*)((const char*)(gbase) + (voff)[_i]), (LAS unsigned*)(lds + (bufoff) + ldsw + _i * 8192), 16, 0, 0); } while (0)
#define PG8_LDA(dst, b, h) do { _Pragma("unroll") for (int m = 0; m < 4; ++m) _Pragma("unroll") for (int k = 0; k < 2; ++k) dst[m][k] = *(const LAS bf16x8*)(lds + PG8_SA(b, h) + aoff + m * 2048 + k * 1024); } while (0)
#define PG8_LDB(dst, b, h) do { _Pragma("unroll") for (int n = 0; n < 2; ++n) _Pragma("unroll") for (int k = 0; k < 2; ++k) dst[n][k] = *(const LAS bf16x8*)(lds + PG8_SB(b, h) + boff + n * 2048 + k * 1024); } while (0)
#define PG8_MMA(ai, bj, At, Bt) do { __builtin_amdgcn_s_setprio(1); _Pragma("unroll") for (int m = 0; m < 4; ++m) _Pragma("unroll") for (int n = 0; n < 2; ++n) _Pragma("unroll") for (int k = 0; k < 2; ++k) \
    acc[ai][bj][m][n] = __builtin_amdgcn_mfma_f32_16x16x32_bf16(Bt[n][k], At[m][k], acc[ai][bj][m][n], 0, 0, 0); __builtin_amdgcn_s_setprio(0); } while (0)
#define PG8_WAIT_V(n) asm volatile("s_waitcnt vmcnt(" #n ")" ::: "memory")
#define PG8_WAIT_L(n) asm volatile("s_waitcnt lgkmcnt(" #n ")" ::: "memory")
#define PG8_BAR __builtin_amdgcn_s_barrier()
#define PG8_SCHED __builtin_amdgcn_sched_barrier(0)
  Unit cur, nxt; int ui = 0;
  if (!S.next(0, cur)) return;
  f32x4 acc[2][2][4][2];
#pragma unroll
  for (int a = 0; a < 2; ++a)
#pragma unroll
    for (int b = 0; b < 2; ++b)
#pragma unroll
      for (int m = 0; m < 4; ++m)
#pragma unroll
        for (int n = 0; n < 2; ++n) acc[a][b][m][n] = (f32x4){0.f, 0.f, 0.f, 0.f};
  bf16x8 At[4][2], B0[2][2], B1[2][2];
  const char* cA = (const char*)g.A + (size_t)cur.pm * 2 * hstepA + (size_t)cur.kb * g.kbA;
  const char* cB = (const char*)g.Bt + (size_t)cur.pn * 2 * hstepB + (size_t)cur.kb * g.kbB;
  PG8_STAGE(PG8_SB(0, 0), cB, voffB); PG8_STAGE(PG8_SB(0, 1), cB + hstepB, voffB); PG8_STAGE(PG8_SA(0, 0), cA, voffA); PG8_STAGE(PG8_SA(0, 1), cA + hstepA, voffA);
  if (wr == 1) PG8_BAR;
  PG8_WAIT_V(2); PG8_BAR;
  PG8_STAGE(PG8_SB(1, 0), cB + kstep, voffB); PG8_STAGE(PG8_SA(1, 0), cA + kstep, voffA); PG8_STAGE(PG8_SB(1, 1), cB + hstepB + kstep, voffB);
  PG8_WAIT_V(6); PG8_BAR;
  for (;;) {
    const bool has_next = S.next(ui + 1, nxt);
    const char* nA = has_next ? (const char*)g.A + (size_t)nxt.pm * 2 * hstepA + (size_t)nxt.kb * g.kbA : cA;
    const char* nB = has_next ? (const char*)g.Bt + (size_t)nxt.pn * 2 * hstepB + (size_t)nxt.kb * g.kbB : cB;
    for (int t = 0; t < nt; t += 2) {
      const bool last = (t == nt - 2);
      const char* a1 = cA + (size_t)(t + 1) * kstep;
      const char* a2 = last ? nA : cA + (size_t)(t + 2) * kstep; const char* b2 = last ? nB : cB + (size_t)(t + 2) * kstep;
      const char* a3 = a2 + kstep; const char* b3 = b2 + kstep;
      PG8_LDB(B0, 0, 0); PG8_LDB(B1, 0, 1); PG8_SCHED; PG8_LDA(At, 0, 0); PG8_STAGE(PG8_SA(1, 1), a1 + hstepA, voffA);
      PG8_WAIT_V(8); PG8_WAIT_L(0); PG8_BAR; PG8_MMA(0, 0, At, B0); PG8_MMA(0, 1, At, B1); PG8_BAR; PG8_SCHED;
      PG8_LDA(At, 0, 1); PG8_STAGE(PG8_SB(0, 0), b2, voffB); PG8_STAGE(PG8_SB(0, 1), b2 + hstepB, voffB); PG8_STAGE(PG8_SA(0, 0), a2, voffA);
      PG8_WAIT_V(8); PG8_WAIT_L(0); PG8_BAR; PG8_MMA(1, 0, At, B0); PG8_MMA(1, 1, At, B1); PG8_BAR; PG8_SCHED;
      PG8_LDB(B0, 1, 0); PG8_LDB(B1, 1, 1); PG8_SCHED; PG8_LDA(At, 1, 0); PG8_STAGE(PG8_SA(0, 1), a2 + hstepA, voffA);
      PG8_WAIT_V(8); PG8_WAIT_L(0); PG8_BAR; PG8_MMA(0, 0, At, B0); PG8_MMA(0, 1, At, B1); PG8_BAR; PG8_SCHED;
      PG8_LDA(At, 1, 1); PG8_STAGE(PG8_SB(1, 0), b3, voffB); PG8_STAGE(PG8_SB(1, 1), b3 + hstepB, voffB); PG8_STAGE(PG8_SA(1, 0), a3, voffA);
      PG8_WAIT_V(8); PG8_WAIT_L(0); PG8_BAR; PG8_MMA(1, 0, At, B0); PG8_MMA(1, 1, At, B1); PG8_BAR; PG8_SCHED;
      if constexpr (Epi::MID > 0) { if (((t + 2) % Epi::MID) == 0 && (t + 2) < nt) E.mid(acc, cur, (t + 2) / Epi::MID - 1, wr, wc, fr, fq); }
    }
    if constexpr (ALIGN_EPI) { if (wr == 0) PG8_BAR; }
    E(acc, cur, wr, wc, fr, fq);
    if (!has_next) break;
#pragma unroll
    for (int a = 0; a < 2; ++a)
#pragma unroll
      for (int b = 0; b < 2; ++b)
#pragma unroll
        for (int m = 0; m < 4; ++m)
#pragma unroll
          for (int n = 0; n < 2; ++n) acc[a][b][m][n] = (f32x4){0.f, 0.f, 0.f, 0.f};
    cur = nxt; cA = nA; cB = nB; ++ui;
    if constexpr (ALIGN_EPI) { if (wr == 1) PG8_BAR; }
  }
  PG8_WAIT_V(0);
  if constexpr (!ALIGN_EPI) { if (wr == 0) PG8_BAR; }
  PG8_BAR;
#undef PG8_SA
#undef PG8_SB
#undef PG8_STAGE
#undef PG8_LDA
#undef PG8_LDB
#undef PG8_MMA
#undef PG8_WAIT_V
#undef PG8_WAIT_L
#undef PG8_BAR
#undef PG8_SCHED
}
#else
template <class Epi, class Sched, bool ALIGN_EPI>
inline void gemm_phase(unsigned char* lds, const Gemm g, const Sched& S, const Epi& E, const int tid) {
  (void)lds;
  const int wid = tid >> 6, lane = tid & 63, wr = wid >> 2, wc = wid & 3, fr = lane & 15, fq = lane >> 4;
  emu::Block* blk = emu::g_blk;
  Unit u;
  for (int ui = 0; S.next(ui, u); ++ui) {
    __syncthreads();
    if (tid == 0) { blk->fa.resize((size_t)256 * g.K); blk->fb.resize((size_t)256 * g.K); }
    __syncthreads();
    const bf16_t* A = (const bf16_t*)((const char*)g.A + (size_t)u.kb * g.kbA) + (size_t)u.pm * 256 * g.lda;
    const bf16_t* B = (const bf16_t*)((const char*)g.Bt + (size_t)u.kb * g.kbB) + (size_t)u.pn * 256 * g.ldb;
    for (int i = tid; i < 256; i += NTHREADS) for (int k = 0; k < g.K; ++k) { blk->fa[(size_t)i * g.K + k] = bf2f(A[(size_t)i * g.lda + k]); blk->fb[(size_t)i * g.K + k] = bf2f(B[(size_t)i * g.ldb + k]); }
    __syncthreads();
    f32x4 acc[2][2][4][2];
    const int nseg = Epi::MID > 0 ? g.K / (Epi::MID * BK) : 1, segk = g.K / nseg;
    for (int ai = 0; ai < 2; ++ai) for (int bj = 0; bj < 2; ++bj) for (int m = 0; m < 4; ++m) for (int n = 0; n < 2; ++n) for (int j = 0; j < 4; ++j) acc[ai][bj][m][n][j] = 0.f;
    for (int sg = 0; sg < nseg; ++sg) {
      for (int ai = 0; ai < 2; ++ai) for (int bj = 0; bj < 2; ++bj) for (int m = 0; m < 4; ++m) for (int n = 0; n < 2; ++n) for (int j = 0; j < 4; ++j) {
        const int row = 128 * ai + 64 * wr + 16 * m + fr;
        const int col = Epi::PERM ? 128 * bj + 32 * wc + 8 * fq + 4 * n + j : 128 * bj + 32 * wc + 16 * n + 4 * fq + j;
        const float* a = &blk->fa[(size_t)row * g.K + sg * segk]; const float* b = &blk->fb[(size_t)col * g.K + sg * segk];
        float s = 0.f; for (int k = 0; k < segk; ++k) s += a[k] * b[k];
        acc[ai][bj][m][n][j] += s;
      }
      if constexpr (Epi::MID > 0) { if (sg + 1 < nseg) E.mid(acc, u, sg, wr, wc, fr, fq); }
    }
    E(acc, u, wr, wc, fr, fq);
  }
  __syncthreads();
}
#endif
}

#ifndef EMU
#define XB_TMO      128
#define XB_XCNT(j)  (256  + 64 * (j))
#define XB_XSUB(j)  (1280 + 64 * (j))
#define XB_XGEN(j)  (2304 + 64 * (j))
#define XB_TOP      3328
#define XB_TOPGEN   3392
#define XCD_BAR_WORDS 3456
#define XB_SPIN_CAP (1u << 18)
__device__ __forceinline__ unsigned xb_ld(unsigned* p)              { return __hip_atomic_load(p, __ATOMIC_RELAXED, __HIP_MEMORY_SCOPE_AGENT); }
__device__ __forceinline__ unsigned xb_add(unsigned* p, unsigned v) { return __hip_atomic_fetch_add(p, v, __ATOMIC_RELAXED, __HIP_MEMORY_SCOPE_AGENT); }
__device__ __forceinline__ unsigned xb_xcc_id() { return (unsigned)__builtin_amdgcn_s_getreg((3 << 11) | 20) & 0xFu; }
#define XB_SPIN(cond, bar) do { unsigned _sp = 0; while (cond) { __builtin_amdgcn_s_sleep(1); \
    if ((++_sp & 255u) == 0u) { if (xb_ld(&(bar)[XB_TMO])) break; if (_sp > XB_SPIN_CAP) { atomicAdd(&(bar)[XB_TMO], 1u); break; } } } } while (0)
struct XcdBarrier { unsigned* bar; unsigned x; volatile LAS unsigned* st; };
__device__ __forceinline__ XcdBarrier xcd_barrier_post(unsigned* bar, volatile LAS unsigned* st) {
  XcdBarrier b; b.bar = bar; b.x = xb_xcc_id(); b.st = st;
  if (threadIdx.x == 0) (void)xb_add(&bar[XB_XCNT(b.x)], 1u);
  return b;
}
__device__ __forceinline__ void xcd_barrier_complete(unsigned* bar, unsigned x, unsigned& nloc, unsigned& nx) {
  const unsigned G = gridDim.x * gridDim.y * gridDim.z;
  unsigned sum, cnt, mine, sp = 0u;
  for (;;) {
    sum = 0u; cnt = 0u; mine = 0u;
#pragma unroll
    for (unsigned j = 0; j < 16; ++j) { const unsigned c = xb_ld(&bar[XB_XCNT(j)]); sum += c; cnt += (c > 0u) ? 1u : 0u; mine = (j == x) ? c : mine; }
    if (sum == G) break;
    __builtin_amdgcn_s_sleep(1);
    if ((++sp & 255u) == 0u) { if (xb_ld(&bar[XB_TMO])) break; if (sp > XB_SPIN_CAP) { atomicAdd(&bar[XB_TMO], 1u); break; } }
  }
  nloc = mine > 0u ? mine : 1u; nx = cnt > 0u ? cnt : 1u;
}
__device__ __forceinline__ void xcd_barrier(const XcdBarrier& b) {
  asm volatile("s_waitcnt vmcnt(0)" ::: "memory");
  __syncthreads();
  if (threadIdx.x == 0) {
    unsigned* bar = b.bar;
    __builtin_amdgcn_s_waitcnt(0);
    unsigned nloc = b.st[0], nx = b.st[1];
    if (nloc == 0u) { xcd_barrier_complete(bar, b.x, nloc, nx); b.st[0] = nloc; b.st[1] = nx; }
    const unsigned old = xb_add(&bar[XB_XSUB(b.x)], 1u);
    const unsigned gen = old / nloc;
    if (old + 1u == (gen + 1u) * nloc) {
      __builtin_amdgcn_fence(__ATOMIC_RELEASE, "agent");
      asm volatile("s_waitcnt vmcnt(0)" ::: "memory");
      const unsigned og = xb_add(&bar[XB_TOP], 1u);
      const unsigned tg = og / nx;
      if (og + 1u == (tg + 1u) * nx) xb_add(&bar[XB_TOPGEN], 1u);
      else XB_SPIN(xb_ld(&bar[XB_TOPGEN]) == tg, bar);
      __builtin_amdgcn_fence(__ATOMIC_ACQUIRE, "agent");
      xb_add(&bar[XB_XGEN(b.x)], 1u);
      asm volatile("s_waitcnt vmcnt(0)" ::: "memory");
    } else {
      XB_SPIN(xb_ld(&bar[XB_XGEN(b.x)]) == gen, bar);
      __builtin_amdgcn_fence(__ATOMIC_ACQUIRE, "agent");
      asm volatile("s_waitcnt vmcnt(0)" ::: "memory");
    }
  }
  __syncthreads();
}
#endif

struct Ctx {
  LAS unsigned char* lds;
  LAS unsigned char* scr;
  int tid, lane, wave, G, bid;
  const float* in[20]; float* out; unsigned char* ws;
};
enum { IN_XP = 0, IN_XS, IN_CK, IN_CV, IN_MC, IN_MN, IN_MM, IN_RS, IN_CONV, IN_NG, IN_WIN, IN_BI, IN_BF, IN_CWT, IN_CB, IN_LNG, IN_LNB, IN_WBR, IN_WOUT, IN_FG };

DI const float* x_row_in(const Ctx& c, int r) { return r < TP ? c.in[IN_XP] + (size_t)r * D : c.in[IN_XS] + (size_t)(r - TP) * D; }

#ifdef EMU
static const float ROPE_INV[64] = {1.000000000e+00f, 8.659643531e-01f, 7.498942614e-01f, 6.493816376e-01f, 5.623413324e-01f, 4.869675338e-01f, 4.216965139e-01f, 3.651741147e-01f, 3.162277639e-01f, 2.738419771e-01f, 2.371373773e-01f, 2.053525001e-01f, 1.778279394e-01f, 1.539926529e-01f, 1.333521307e-01f, 1.154782027e-01f, 1.000000015e-01f, 8.659642935e-02f, 7.498941571e-02f, 6.493816525e-02f, 5.623413250e-02f, 4.869675264e-02f, 4.216965288e-02f, 3.651741147e-02f, 3.162277490e-02f, 2.738419734e-02f, 2.371373773e-02f, 2.053525113e-02f, 1.778279431e-02f, 1.539926510e-02f, 1.333521493e-02f, 1.154782064e-02f, 9.999999776e-03f, 8.659643121e-03f, 7.498941850e-03f, 6.493816152e-03f, 5.623413250e-03f, 4.869675264e-03f, 4.216964822e-03f, 3.651741194e-03f, 3.162277630e-03f, 2.738419687e-03f, 2.371373586e-03f, 2.053524833e-03f, 1.778279431e-03f, 1.539926510e-03f, 1.333521446e-03f, 1.154781901e-03f, 1.000000047e-03f, 8.659643354e-04f, 7.498942432e-04f, 6.493816618e-04f, 5.623413017e-04f, 4.869675322e-04f, 4.216965172e-04f, 3.651741426e-04f, 3.162277571e-04f, 2.738419571e-04f, 2.371373703e-04f, 2.053525095e-04f, 1.778279402e-04f, 1.539926452e-04f, 1.333521504e-04f, 1.154782003e-04f};
#else
__constant__ float ROPE_INV[64] = {1.000000000e+00f, 8.659643531e-01f, 7.498942614e-01f, 6.493816376e-01f, 5.623413324e-01f, 4.869675338e-01f, 4.216965139e-01f, 3.651741147e-01f, 3.162277639e-01f, 2.738419771e-01f, 2.371373773e-01f, 2.053525001e-01f, 1.778279394e-01f, 1.539926529e-01f, 1.333521307e-01f, 1.154782027e-01f, 1.000000015e-01f, 8.659642935e-02f, 7.498941571e-02f, 6.493816525e-02f, 5.623413250e-02f, 4.869675264e-02f, 4.216965288e-02f, 3.651741147e-02f, 3.162277490e-02f, 2.738419734e-02f, 2.371373773e-02f, 2.053525113e-02f, 1.778279431e-02f, 1.539926510e-02f, 1.333521493e-02f, 1.154782064e-02f, 9.999999776e-03f, 8.659643121e-03f, 7.498941850e-03f, 6.493816152e-03f, 5.623413250e-03f, 4.869675264e-03f, 4.216964822e-03f, 3.651741194e-03f, 3.162277630e-03f, 2.738419687e-03f, 2.371373586e-03f, 2.053524833e-03f, 1.778279431e-03f, 1.539926510e-03f, 1.333521446e-03f, 1.154781901e-03f, 1.000000047e-03f, 8.659643354e-04f, 7.498942432e-04f, 6.493816618e-04f, 5.623413017e-04f, 4.869675322e-04f, 4.216965172e-04f, 3.651741426e-04f, 3.162277571e-04f, 2.738419571e-04f, 2.371373703e-04f, 2.053525095e-04f, 1.778279402e-04f, 1.539926452e-04f, 1.333521504e-04f, 1.154782003e-04f};
#endif
DI void transpose_item(const float* Wsrc, int ldn, int K, bf16_t* WT, LAS float* scr, int kb, int n0src, int n0dst, int lane, int koff = 0) {
  const int k0 = 64 * kb;
#pragma unroll 8
  for (int i = 0; i < 32; ++i) { const int kk = 2 * i + (lane >> 5); scr[kk * 33 + (lane & 31)] = Wsrc[(size_t)(k0 + kk) * ldn + n0src + (lane & 31)]; }
  LDS_WAIT();
  const int ch = lane & 7;
#pragma unroll
  for (int j = 0; j < 4; ++j) { const int n = (lane >> 3) + 8 * j; const LAS float* s = scr + (8 * ch) * 33 + n;
    u32x4 o; o.x = pk2(s[0 * 33], s[1 * 33]); o.y = pk2(s[2 * 33], s[3 * 33]); o.z = pk2(s[4 * 33], s[5 * 33]); o.w = pk2(s[6 * 33], s[7 * 33]);
    *(u32x4*)(WT + (size_t)(n0dst + n) * K + koff + k0 + 8 * ch) = o; }
  LDS_WAIT();
}
DI void phase_prologue(const Ctx& c) {
  LAS float* scr = (LAS float*)c.scr;
  const int gw = c.bid * NWAVES + c.wave, NGW = c.G * NWAVES;
  constexpr int I_IN = (D / 64) * (NP / 32), I_BR = 4 * (W / 64) * (D / 32), I_OUT = (D / 64) * (D / 32), I_L = I_IN + I_BR + I_OUT;
  for (int it = gw; it < DEPTH * I_L; it += NGW) {
    const int l = it / I_L; int r = it % I_L;
    if (r < I_IN) { const int nblk = NP / 32, kb = r / nblk, nb = r % nblk, n0 = 32 * nb;
      transpose_item(c.in[IN_WIN] + (size_t)l * D * N_IN, N_IN, D, (bf16_t*)(c.ws + WS_WIN) + (size_t)l * NP * D, scr, kb, n0 + (n0 >= GATE_COL ? 8 : 0), n0, c.lane); continue; }
    r -= I_IN;
    if (r < I_BR) { const int per = (W / 64) * (D / 32), br = r / per, rr = r % per, nblk = D / 32, kb = rr / nblk, nb = rr % nblk;
      transpose_item(c.in[IN_WBR] + ((size_t)l * 4 + br) * W * D, D, D, (bf16_t*)(c.ws + WS_WBR) + (size_t)l * D * D, scr, kb, 32 * nb, 32 * nb, c.lane, br * W); continue; }
    r -= I_BR;
    { const int nblk = D / 32, kb = r / nblk, nb = r % nblk;
      transpose_item(c.in[IN_WOUT] + (size_t)l * D * D, D, D, (bf16_t*)(c.ws + WS_WOUT) + (size_t)l * D * D, scr, kb, 32 * nb, 32 * nb, c.lane); }
  }
  float* rope = (float*)(c.ws + WS_ROPE);
  for (int i = c.bid * NTHREADS + c.tid; i < SEQ * 64; i += c.G * NTHREADS) {
    const int pos = i >> 6, j = i & 63;
    const float inv = ROPE_INV[j];
    const float ang = (float)pos * inv;
    const double a = (double)ang, n = rint(a * 0.15915494309189535), red = (a - n * 6.283185307179586) ;
    const float rr = (float)(red - n * 2.4492935982947064e-16);
    rope[2 * i] = cosf(rr); rope[2 * i + 1] = sinf(rr);
  }
}

DI void phase_norm(const Ctx& c, int l) {
  LAS float* gw = (LAS float*)c.lds;
  const float* win = c.in[IN_WIN] + (size_t)l * D * N_IN + GATE_COL;
  for (int i = c.tid; i < D * 8; i += NTHREADS) gw[i] = win[(size_t)(i >> 3) * N_IN + (i & 7)];
  __syncthreads();
  const float* ng = c.in[IN_NG] + (size_t)l * D;
  bf16_t* HIN = (bf16_t*)(c.ws + WS_HIN);
  float* IG = (float*)(c.ws + WS_IG); float* LF = (float*)(c.ws + WS_LF);
  const int gwv = c.bid * NWAVES + c.wave, NGW = c.G * NWAVES, lane = c.lane;
  const int gq = (lane & 1) * 4 + ((lane >> 1) & 1) * 2 + ((lane >> 2) & 1);
  const float gbias = gq < 4 ? c.in[IN_BI][l * NH + gq] : c.in[IN_BF][l * NH + gq - 4];
  const bool b0 = lane & 1, b1 = lane & 2, b2 = lane & 4;
  const int loff = 4 * lane;
  f32x4 vn[8];
  {
    const float* xr = (l == 0) ? x_row_in(c, gwv < T ? gwv : 0) : c.out + O_Y + (size_t)(gwv < T ? gwv : 0) * D;
#pragma unroll
    for (int j = 0; j < 8; ++j) vn[j] = *(const f32x4*)(xr + loff + 256 * j);
  }
  for (int r = gwv; r < T; r += NGW) {
    f32x4 v[8]; float ss = 0.f;
#pragma unroll
    for (int j = 0; j < 8; ++j) { v[j] = vn[j]; ss += (v[j].x * v[j].x + v[j].y * v[j].y) + (v[j].z * v[j].z + v[j].w * v[j].w); }
    {
      const int rn = r + NGW < T ? r + NGW : r;
      const float* xr = (l == 0) ? x_row_in(c, rn) : c.out + O_Y + (size_t)rn * D;
#pragma unroll
      for (int j = 0; j < 8; ++j) vn[j] = *(const f32x4*)(xr + loff + 256 * j);
    }
    const float rstd = 1.0f / sqrtf(wave_sum(ss, lane) * (1.0f / D) + 1e-6f);
    float ga[8];
#pragma unroll
    for (int k = 0; k < 8; ++k) ga[k] = 0.f;
    bf16_t* hrow = HIN + (size_t)r * D + loff;
#pragma unroll
    for (int j = 0; j < 8; ++j) {
      const LAS float* gp = gw + (256 * j + loff) * 8;
      const f32x4 gvj = *(const f32x4*)(ng + 256 * j + loff);
      v[j] = v[j] * rstd * gvj;
      *(u32x2*)(hrow + 256 * j) = (u32x2){pk2(v[j].x, v[j].y), pk2(v[j].z, v[j].w)};
#pragma unroll
      for (int e = 0; e < 4; ++e) {
        const f32x4 w0 = *(const LAS f32x4*)(gp + e * 8), w1 = *(const LAS f32x4*)(gp + e * 8 + 4);
        const float xv = v[j][e];
        ga[0] += xv * w0.x; ga[1] += xv * w0.y; ga[2] += xv * w0.z; ga[3] += xv * w0.w;
        ga[4] += xv * w1.x; ga[5] += xv * w1.y; ga[6] += xv * w1.z; ga[7] += xv * w1.w;
      }
      asm volatile("" ::: "memory");
    }
    {
      float t4[4];
#pragma unroll
      for (int k = 0; k < 4; ++k) { const float snd = b0 ? ga[k] : ga[4 + k]; const float keep = b0 ? ga[4 + k] : ga[k]; t4[k] = keep + wshfl_xor(snd, 1, lane); }
      float t2[2];
#pragma unroll
      for (int k = 0; k < 2; ++k) { const float snd = b1 ? t4[k] : t4[2 + k]; const float keep = b1 ? t4[2 + k] : t4[k]; t2[k] = keep + wshfl_xor(snd, 2, lane); }
      float t1; { const float snd = b2 ? t2[0] : t2[1]; const float keep = b2 ? t2[1] : t2[0]; t1 = keep + wshfl_xor(snd, 4, lane); }
      t1 += wshfl_xor(t1, 8, lane); t1 += wshfl_xor(t1, 16, lane); t1 += wshfl_xor(t1, 32, lane);
      if (lane < 8) {
        const float val = t1 + gbias;
        if (gq < 4) IG[(size_t)r * 4 + gq] = val;
        else LF[(size_t)r * 4 + gq - 4] = fminf(val, 0.f) - log1p_f(__expf(-fabsf(val)));
      }
    }
  }
  __syncthreads();
}

DI float gate_e(float g) { return __expf(-fmaxf(g, -30.f)); }
struct EpiInproj {
  static constexpr bool PERM = true; static constexpr int MID = 0;
  bf16_t* P; float* out; int l;
  DI void operator()(const f32x4 (&acc)[2][2][4][2], const pg8::Unit& u, int wr, int wc, int fr, int fq) const {
    const int row0 = u.pm * 256 + wr * 64 + fr, colt = u.pn * 256, cb = colt >> 9;
    const int col0 = colt + wc * 32 + 8 * fq;
    const bool kv = (cb == CB_KA || cb == CB_VA), gate = cb >= CB_G0;
#pragma unroll
    for (int ai = 0; ai < 2; ++ai)
#pragma unroll
      for (int m = 0; m < 4; ++m) {
        const int r = row0 + ai * 128 + m * 16;
        bf16_t* rowp = P + PIX(r, cb) + (col0 - cb * 512);
#pragma unroll
        for (int bj = 0; bj < 2; ++bj) {
          f32x4 v0 = acc[ai][bj][m][0], v1 = acc[ai][bj][m][1];
          if (gate) {
#pragma unroll
            for (int j = 0; j < 4; ++j) { v0[j] = 1.0f + gate_e(v0[j]); v1[j] = 1.0f + gate_e(v1[j]); }
          }
          u32x4 w; w.x = pk2(v0[0], v0[1]); w.y = pk2(v0[2], v0[3]); w.z = pk2(v1[0], v1[1]); w.w = pk2(v1[2], v1[3]);
          NT_STORE((u32x4*)(rowp + bj * 128), w);
          if (kv) {
            const int cc = col0 + bj * 128 - cb * 512;
            float* o = (r < TP) ? out + (cb == CB_KA ? O_PK : O_PV) + ((size_t)l * TP + r) * W + cc
                                : out + (cb == CB_KA ? O_SK : O_SV) + ((size_t)l * TS + (r - TP)) * W + cc;
            *(f32x4*)o = v0; *(f32x4*)(o + 4) = v1;
          }
        }
      }
  }
};
struct EpiMergeH {
  static constexpr bool PERM = true; static constexpr int MID = 8;
  const bf16_t* P; bf16_t* MG;
  DI void mid(f32x4 (&acc)[2][2][4][2], const pg8::Unit& u, int seg, int wr, int wc, int fr, int fq) const {
    const int row0 = u.pm * 256 + wr * 64 + fr, col0 = u.pn * 256 + wc * 32 + 8 * fq;
#pragma unroll
    for (int ai = 0; ai < 2; ++ai) {
      u32x4 qa[4][2], qb[4][2];
#pragma unroll
      for (int m = 0; m < 4; ++m) {
        const bf16_t* gp = P + PIX(row0 + ai * 128 + m * 16, CB_G0 + seg * 4 + (u.pn >> 1)) + (col0 & 511);
#pragma unroll
        for (int bj = 0; bj < 2; ++bj) { qa[m][bj] = *(const u32x4*)(gp + bj * 128); qb[m][bj] = *(const u32x4*)(gp + (size_t)4 * T * 512 + bj * 128); }
      }
#pragma unroll
      for (int m = 0; m < 4; ++m)
#pragma unroll
        for (int bj = 0; bj < 2; ++bj) {
          float ga[8], gb[8]; unpack8(qa[m][bj], ga); unpack8(qb[m][bj], gb);
          float rt[8];
#pragma unroll
          for (int j = 0; j < 8; ++j) rt[j] = gb[j] * frcp(ga[j]);
          f32x4& v0 = acc[ai][bj][m][0]; f32x4& v1 = acc[ai][bj][m][1];
          v0 = (f32x4){v0[0] * rt[0], v0[1] * rt[1], v0[2] * rt[2], v0[3] * rt[3]};
          v1 = (f32x4){v1[0] * rt[4], v1[1] * rt[5], v1[2] * rt[6], v1[3] * rt[7]};
        }
      asm volatile("" ::: "memory");
    }
  }
  DI void operator()(const f32x4 (&acc)[2][2][4][2], const pg8::Unit& u, int wr, int wc, int fr, int fq) const {
    const int row0 = u.pm * 256 + wr * 64 + fr, col0 = u.pn * 256 + wc * 32 + 8 * fq;
    u32x4 q3[2][4][2];
#pragma unroll
    for (int ai = 0; ai < 2; ++ai)
#pragma unroll
      for (int m = 0; m < 4; ++m)
#pragma unroll
        for (int bj = 0; bj < 2; ++bj) q3[ai][m][bj] = *(const u32x4*)(P + PIX(row0 + ai * 128 + m * 16, CB_G0 + 12 + (u.pn >> 1)) + ((col0 + bj * 128) & 511));
#pragma unroll
    for (int ai = 0; ai < 2; ++ai)
#pragma unroll
      for (int m = 0; m < 4; ++m) {
        const int r = row0 + ai * 128 + m * 16;
#pragma unroll
        for (int bj = 0; bj < 2; ++bj) {
          const int cc = col0 + bj * 128;
          float g3[8]; unpack8(q3[ai][m][bj], g3);
          float s[8];
#pragma unroll
          for (int j = 0; j < 8; ++j) s[j] = frcp(g3[j]);
          const f32x4 v0 = acc[ai][bj][m][0], v1 = acc[ai][bj][m][1];
          u32x4 w; w.x = pk2(v0[0] * s[0], v0[1] * s[1]); w.y = pk2(v0[2] * s[2], v0[3] * s[3]); w.z = pk2(v1[0] * s[4], v1[1] * s[5]); w.w = pk2(v1[2] * s[6], v1[3] * s[7]);
          *(u32x4*)(MG + (size_t)r * D + cc) = w;
        }
      }
  }
};
struct EpiOut {
  static constexpr bool PERM = false; static constexpr int MID = 0;
  const float* xp; const float* xs; const float* xprev; float* y; int l;
  DI void operator()(const f32x4 (&acc)[2][2][4][2], const pg8::Unit& u, int wr, int wc, int fr, int fq) const {
    const int row0 = u.pm * 256 + wr * 64 + fr, col0 = u.pn * 256 + wc * 32 + 4 * fq;
#pragma unroll
    for (int ai = 0; ai < 2; ++ai) {
      f32x4 xv[4][2][2];
#pragma unroll
      for (int m = 0; m < 4; ++m) {
        const int r = row0 + ai * 128 + m * 16;
        const float* xin = (l == 0) ? (r < TP ? xp + (size_t)r * D : xs + (size_t)(r - TP) * D) : xprev + (size_t)r * D;
#pragma unroll
        for (int bj = 0; bj < 2; ++bj)
#pragma unroll
          for (int n = 0; n < 2; ++n) xv[m][bj][n] = *(const f32x4*)(xin + col0 + bj * 128 + n * 16);
      }
#pragma unroll
      for (int m = 0; m < 4; ++m) {
        float* yo = y + (size_t)(row0 + ai * 128 + m * 16) * D;
#pragma unroll
        for (int bj = 0; bj < 2; ++bj)
#pragma unroll
          for (int n = 0; n < 2; ++n) *(f32x4*)(yo + col0 + bj * 128 + n * 16) = xv[m][bj][n] + acc[ai][bj][m][n];
      }
    }
  }
};

struct ChunkGeo { int sq, c, b, h, row0, L, nch; bool sample; };
DI ChunkGeo chunk_geo(int ck) {
  ChunkGeo g;
  if (ck < NSEQ_P * NCH_P) { g.sq = ck / NCH_P; g.c = ck % NCH_P; g.b = g.sq / NH; g.h = g.sq % NH; g.row0 = g.b * SEQ + g.c * 64; g.L = 64; g.nch = NCH_P; g.sample = false; }
  else { const int s = ck - NSEQ_P * NCH_P; g.sq = NSEQ_P + s; g.c = 0; g.b = s / NH; g.h = s % NH; g.row0 = TP + g.b * DS; g.L = DS; g.nch = 1; g.sample = true; }
  return g;
}
DI int seq_pos0(const ChunkGeo& g) { return g.sample ? PAST : g.c * 64; }
DI float ret_log2gamma(int h) { return log2f(1.0f - exp2f(-5.0f - (float)h)); }
DI float wave_prefix_sum(float v, int lane) {
#pragma unroll
  for (int o = 1; o < 64; o <<= 1) { const float t = wshfl_up(v, o, lane); if (lane >= o) v += t; }
  return v;
}
DI float wave_prefix_max(float v, int lane) {
#pragma unroll
  for (int o = 1; o < 64; o <<= 1) { const float t = wshfl_up(v, o, lane); if (lane >= o) v = fmaxf(v, t); }
  return v;
}
DI void rotary_frags(bf16x8 (&f)[8], const float* rope_pos, int h) {
#pragma unroll
  for (int s = 0; s < 4; ++s) {
    float x1[8], x2[8]; unpack8(__builtin_bit_cast(u32x4, f[s]), x1); unpack8(__builtin_bit_cast(u32x4, f[s + 4]), x2);
    const float* cs = rope_pos + 2 * (16 * s + 8 * h);
    float o1[8], o2[8];
#pragma unroll
    for (int j = 0; j < 8; ++j) { const float co = cs[2 * j], si = cs[2 * j + 1]; o1[j] = x1[j] * co - x2[j] * si; o2[j] = x1[j] * si + x2[j] * co; }
    f[s] = pack8(o1[0], o1[1], o1[2], o1[3], o1[4], o1[5], o1[6], o1[7]);
    f[s + 4] = pack8(o2[0], o2[1], o2[2], o2[3], o2[4], o2[5], o2[6], o2[7]);
  }
}
DI bf16x8 tr_frag(const LAS unsigned char* tile, int stride, int row_lo, int row_hi, int col0, int lane) {
  const int q = (lane & 15) >> 2, p = lane & 3, blk = (lane >> 4) & 1;
  const int cbyte = (col0 + 16 * blk + 4 * p) * 2;
  const s16x4 lo = ds_tr16(tile + (row_lo + q) * stride + cbyte);
  const s16x4 hi = ds_tr16(tile + (row_hi + q) * stride + cbyte);
  return (bf16x8){lo[0], lo[1], lo[2], lo[3], hi[0], hi[1], hi[2], hi[3]};
}

constexpr int OT_STRIDE = 132;
DI void o_to_lds(const f32x16* acc, LAS float* tile, int r, int h) {
#pragma unroll
  for (int i = 0; i < 16; ++i)
#pragma unroll
    for (int cc = 0; cc < 4; ++cc) tile[crow(i, h) * OT_STRIDE + 32 * cc + r] = acc[cc][i];
}
DI void conv_pass(const Ctx& c, int l, const LAS float* cw, int s0, int t0, int nt, bool sample, int b, const float (&bias)[8], const float (&lg)[8], const float (&lb)[8]) {
  const bf16_t* P = (const bf16_t*)(c.ws + WS_P);
  bf16_t* YC = (bf16_t*)(c.ws + WS_YCAT);
  const int lane = c.lane, c0 = 8 * lane;
  float acc[8][8];
#pragma unroll
  for (int t = 0; t < 8; ++t)
#pragma unroll
    for (int j = 0; j < 8; ++j) acc[t][j] = bias[j];
  const int nrows = nt + 30;
  for (int jj0 = 0; jj0 < nrows; jj0 += 8) {
    u32x4 ud[8], gd[8];
#pragma unroll
    for (int q = 0; q < 8; ++q) {
      int rr = t0 - 30 + jj0 + q; rr = rr < 0 ? 0 : (rr > t0 + nt - 1 ? t0 + nt - 1 : rr);
      ud[q] = *(const u32x4*)(P + PIX(s0 + rr, CB_UD) + c0); gd[q] = *(const u32x4*)(P + PIX(s0 + rr, CB_GD) + c0);
    }
#pragma unroll
    for (int q = 0; q < 8; ++q) {
      const int jj = jj0 + q, rr = t0 - 30 + jj;
      if (jj < nrows) {
        float glu[8];
        if (rr >= 0) {
          float u[8], g[8]; unpack8(ud[q], u); unpack8(gd[q], g);
#pragma unroll
          for (int j = 0; j < 8; ++j) glu[j] = u[j] * sigmoid_f(g[j]);
        } else if (sample) {
          const float* hp = c.in[IN_CONV] + (((size_t)l * DB + b) * 30 + (30 + rr)) * W + c0;
          const f32x4 a = *(const f32x4*)hp, bb = *(const f32x4*)(hp + 4);
          glu[0] = a.x; glu[1] = a.y; glu[2] = a.z; glu[3] = a.w; glu[4] = bb.x; glu[5] = bb.y; glu[6] = bb.z; glu[7] = bb.w;
        } else {
#pragma unroll
          for (int j = 0; j < 8; ++j) glu[j] = 0.f;
        }
        if (sample) {
          const int xi = 30 + rr;
          if (xi >= 16 && (rr >= t0 || (rr < 0 && t0 == 0))) { float* o = c.out + O_SCONV + (((size_t)l * DB + b) * 30 + (xi - 16)) * W + c0;
            *(f32x4*)o = (f32x4){glu[0], glu[1], glu[2], glu[3]}; *(f32x4*)(o + 4) = (f32x4){glu[4], glu[5], glu[6], glu[7]}; }
        } else if (rr >= t0 && rr >= SEQ - 30) {
          float* o = c.out + O_PCONV + (((size_t)l * NBATCH + b) * 30 + (rr - (SEQ - 30))) * W + c0;
          *(f32x4*)o = (f32x4){glu[0], glu[1], glu[2], glu[3]}; *(f32x4*)(o + 4) = (f32x4){glu[4], glu[5], glu[6], glu[7]};
        }
#pragma unroll
        for (int t = 0; t < 8; ++t) {
          const int j = jj - t;
          if (j >= 0 && j <= 30 && t < nt) {
            const f32x4 w0 = *(const LAS f32x4*)(cw + j * W + c0), w1 = *(const LAS f32x4*)(cw + j * W + c0 + 4);
            acc[t][0] += w0.x * glu[0]; acc[t][1] += w0.y * glu[1]; acc[t][2] += w0.z * glu[2]; acc[t][3] += w0.w * glu[3];
            acc[t][4] += w1.x * glu[4]; acc[t][5] += w1.y * glu[5]; acc[t][6] += w1.z * glu[6]; acc[t][7] += w1.w * glu[7];
          }
        }
      }
    }
  }
#pragma unroll
  for (int t = 0; t < 8; ++t) {
    if (t < nt) {
      float s1 = 0.f;
#pragma unroll
      for (int j = 0; j < 8; ++j) s1 += acc[t][j];
      const float mean = wave_sum(s1, lane) * (1.0f / W);
      float s2 = 0.f;
#pragma unroll
      for (int j = 0; j < 8; ++j) { const float d = acc[t][j] - mean; s2 += d * d; }
      const float rstd = 1.0f / sqrtf(wave_sum(s2, lane) * (1.0f / W) + 1e-5f);
      const int r = s0 + t0 + t;
      float zd[8]; unpack8(*(const u32x4*)(P + PIX(r, CB_ZD) + c0), zd);
      float o[8];
#pragma unroll
      for (int j = 0; j < 8; ++j) o[j] = silu_f((acc[t][j] - mean) * rstd * lg[j] + lb[j]) * silu_f(zd[j]);
      u32x4 w; w.x = pk2(o[0], o[1]); w.y = pk2(o[2], o[3]); w.z = pk2(o[4], o[5]); w.w = pk2(o[6], o[7]);
      *(u32x4*)(YC + (size_t)r * D + 3 * W + c0) = w;
    }
  }
}
DI void phase_conv(const Ctx& c, int l) {
  LAS float* cw = (LAS float*)c.lds;
  const float* cwg = c.in[IN_CWT] + (size_t)l * CW * W;
  for (int i = c.tid; i < CW * W; i += NTHREADS) cw[i] = cwg[i];
  __syncthreads();
  const int c0 = 8 * c.lane;
  const int gwv = c.bid * NWAVES + c.wave, NGW = c.G * NWAVES;
  float bias[8], lg[8], lb[8];
#pragma unroll
  for (int j = 0; j < 8; ++j) { bias[j] = c.in[IN_CB][l * W + c0 + j]; lg[j] = c.in[IN_LNG][l * W + c0 + j]; lb[j] = c.in[IN_LNB][l * W + c0 + j]; }
  constexpr int NPP = TP / 8;
  for (int p0 = 2 * gwv; p0 < NPP; p0 += 2 * NGW)
    for (int p = p0; p < p0 + 2 && p < NPP; ++p) { const int b = p / (SEQ / 8), t0 = (p % (SEQ / 8)) * 8; conv_pass(c, l, cw, b * SEQ, t0, 8, false, b, bias, lg, lb); }
  for (int q = NGW - 1 - gwv; q < DB * (DS / 2); q += NGW) { const int b = q / (DS / 2), t0 = (q % (DS / 2)) * 2; conv_pass(c, l, cw, TP + b * DS, t0, 2, true, b, bias, lg, lb); }
  __syncthreads();
}

constexpr int NUP = NSEQ_P * (SEQ / 32), NUA = NUP + NSEQ_S;
constexpr int NLONGW = (NSEQ_P * 129 + NSEQ_P * 128 + 1) / 2;
constexpr float SB_C2 = 0.08838834764831845f * 1.4426950408889634f;
constexpr float SB_RSTOP = 140.0f;
DI void attn_unit(const Ctx& c, int l, int u) {
  int lane_ = c.lane; OPAQUE_V(lane_);
  const int lane = lane_, r = lane & 31, h = lane >> 5;
  const bf16_t* P = (const bf16_t*)(c.ws + WS_P);
  int b, head, qrow0, qpos0, nq, kstart; bool sample;
  if (u < NUP) { const int sq = u / (SEQ / 32), qb = u % (SEQ / 32); b = sq / NH; head = sq % NH; qrow0 = b * SEQ + qb * 32; qpos0 = qb * 32; nq = 32; kstart = qb * 32; sample = false; }
  else { const int s = u - NUP; b = s / NH; head = s % NH; qrow0 = TP + b * DS; qpos0 = PAST; nq = DS; kstart = PAST; sample = true; }
  const int qrow = qrow0 + (r < nq ? r : nq - 1);
  const int qpos = qpos0 + r;
  bf16x8 qf[8];
#pragma unroll
  for (int s = 0; s < 8; ++s) qf[s] = *(const bf16x8*)(P + PIX(qrow, CB_QA) + head * HD + 16 * s + 8 * h);
  f32x16 o[4];
#pragma unroll
  for (int cc = 0; cc < 4; ++cc)
#pragma unroll
    for (int i = 0; i < 16; ++i) o[cc][i] = 0.f;
  float R = 0.f;
  LAS unsigned char* vt = c.scr;
  const float* ck = c.in[IN_CK]; const float* cv = c.in[IN_CV];
  for (int k0 = kstart; k0 >= 0; k0 -= 32) {
    const bool from_cache = sample && k0 < PAST;
    bf16x8 kf[8];
    if (!from_cache) {
      const int krow = sample ? TP + b * DS + (r < DS ? r : DS - 1) : b * SEQ + k0 + r;
#pragma unroll
      for (int s = 0; s < 8; ++s) kf[s] = *(const bf16x8*)(P + PIX(krow, CB_KA) + head * HD + 16 * s + 8 * h);
#pragma unroll
      for (int i = 0; i < 8; ++i) { const int n = lane + 64 * i, vr = n >> 4, ch = n & 15;
        const int vrow = sample ? TP + b * DS + (vr < DS ? vr : DS - 1) : b * SEQ + k0 + vr;
        *(LAS u32x4*)(vt + vr * TS272 + ch * 16) = *(const u32x4*)(P + PIX(vrow, CB_VA) + head * HD + ch * 8); }
    } else {
      const float* kp = ck + ((((size_t)l * DB + b) * PAST + (k0 + r)) * NH + head) * HD;
#pragma unroll
      for (int s = 0; s < 8; ++s) { const f32x4 a = *(const f32x4*)(kp + 16 * s + 8 * h), bb = *(const f32x4*)(kp + 16 * s + 8 * h + 4); kf[s] = pack8(a.x, a.y, a.z, a.w, bb.x, bb.y, bb.z, bb.w); }
#pragma unroll
      for (int i = 0; i < 8; ++i) { const int n = lane + 64 * i, vr = n >> 4, ch = n & 15;
        const float* vp = cv + ((((size_t)l * DB + b) * PAST + (k0 + vr)) * NH + head) * HD + ch * 8;
        const f32x4 a = *(const f32x4*)vp, bb = *(const f32x4*)(vp + 4);
        *(LAS bf16x8*)(vt + vr * TS272 + ch * 16) = pack8(a.x, a.y, a.z, a.w, bb.x, bb.y, bb.z, bb.w); }
    }
    f32x16 sacc;
#pragma unroll
    for (int i = 0; i < 16; ++i) sacc[i] = 0.f;
#pragma unroll
    for (int s = 0; s < 8; ++s) sacc = mfma32(kf[s], qf[s], sacc);
    float z2[16], sp[16];
#pragma unroll
    for (int i = 0; i < 16; ++i) {
      const bool ok = (k0 + crow(i, h)) < qpos;
      z2[i] = fminf(sacc[i] * SB_C2, 126.0f);
      sp[i] = ok ? lg2(1.0f + ex2(z2[i])) : 0.0f;
      z2[i] = ok ? z2[i] : -1e30f;
    }
    float gs[4], pg[4];
#pragma unroll
    for (int j = 0; j < 4; ++j) { gs[j] = (sp[4 * j] + sp[4 * j + 1]) + (sp[4 * j + 2] + sp[4 * j + 3]); pg[j] = wshfl_xor(gs[j], 32, lane); }
    float after = 0.f, wgt[16];
#pragma unroll
    for (int j = 3; j >= 0; --j) {
      float run = after + (h == 0 ? pg[j] : 0.f) + R;
#pragma unroll
      for (int ii = 3; ii >= 0; --ii) { run += sp[4 * j + ii]; wgt[4 * j + ii] = ex2(z2[4 * j + ii] - run); }
      after += (h == 0) ? (gs[j] + pg[j]) : (pg[j] + gs[j]);
    }
    R += after;
    const bf16x8 pf0 = pack8(wgt[0], wgt[1], wgt[2], wgt[3], wgt[4], wgt[5], wgt[6], wgt[7]);
    const bf16x8 pf1 = pack8(wgt[8], wgt[9], wgt[10], wgt[11], wgt[12], wgt[13], wgt[14], wgt[15]);
    LDS_WAIT();
#pragma unroll
    for (int cc = 0; cc < 4; ++cc) {
      const bf16x8 v0 = tr_frag(vt, TS272, 4 * h, 8 + 4 * h, 32 * cc, lane);
      const bf16x8 v1 = tr_frag(vt, TS272, 16 + 4 * h, 24 + 4 * h, 32 * cc, lane);
      o[cc] = mfma32(pf0, v0, o[cc]);
      o[cc] = mfma32(pf1, v1, o[cc]);
    }
    const float rmin = wave_min(r < nq ? R : 1e30f, lane);
    if (rmin >= SB_RSTOP) break;
  }
  bf16_t* YC = (bf16_t*)(c.ws + WS_YCAT);
  LAS float* ot = (LAS float*)c.scr;
  LDS_WAIT();
  o_to_lds(o, ot, r, h);
  LDS_WAIT();
#pragma unroll
  for (int i = 0; i < 8; ++i) {
    const int q = lane + 64 * i, t = q >> 4, ch = q & 15;
    if (t < nq) {
      const size_t row = (size_t)(qrow0 + t);
      const int col = head * HD + 8 * ch;
      const f32x4 x0 = *(const LAS f32x4*)(ot + t * OT_STRIDE + 8 * ch), x1 = *(const LAS f32x4*)(ot + t * OT_STRIDE + 8 * ch + 4);
      float za[8]; unpack8(*(const u32x4*)(P + PIX(row, CB_ZA) + col), za);
      u32x4 w; w.x = pk2(x0.x * silu_f(za[0]), x0.y * silu_f(za[1])); w.y = pk2(x0.z * silu_f(za[2]), x0.w * silu_f(za[3]));
      w.z = pk2(x1.x * silu_f(za[4]), x1.y * silu_f(za[5])); w.w = pk2(x1.z * silu_f(za[6]), x1.w * silu_f(za[7]));
      *(u32x4*)(YC + row * D + col) = w;
    }
  }
  LDS_WAIT();
}

DI bf16_t* st_ptr(const Ctx& c, int br, int ck) { return (bf16_t*)(c.ws + WS_ST + ((size_t)br * NCHUNK + ck) * ST_BYTES); }
DI bf16_t* st2_ptr(const Ctx& c, int br, int ck) { return (bf16_t*)(c.ws + WS_ST2 + ((size_t)br * NCHUNK + ck) * ST_BYTES); }
template <int BR> DI void scan_local_unit(const Ctx& c, int l, int ck, int eb) {
  int lane_ = c.lane; OPAQUE_V(lane_);
  const int lane = lane_, r = lane & 31, h = lane >> 5;
  const ChunkGeo g = chunk_geo(ck);
  const bf16_t* P = (const bf16_t*)(c.ws + WS_P);
  LAS unsigned char* kt = c.scr;
  LAS unsigned char* vtl = c.scr + 64 * 144;
  LAS float* wtab = (LAS float*)(c.scr + 64 * 144 + 64 * 80);
  constexpr int KS = 144, VS = 80;
  const int kcb = BR == 0 ? CB_KB : CB_KC, vcb = BR == 0 ? CB_VB : CB_VC;
  const float* rope = (const float*)(c.ws + WS_ROPE);
  u32x4 kx1[8], kx2[8], vv[4];
#pragma unroll
  for (int i = 0; i < 8; ++i) {
    const int n = lane + 64 * i, s = n >> 3, ch = n & 7;
    const bf16_t* kp = P + PIX(g.row0 + (s < g.L ? s : g.L - 1), kcb) + g.h * HD;
    kx1[i] = *(const u32x4*)(kp + ch * 8); kx2[i] = *(const u32x4*)(kp + 64 + ch * 8);
  }
#pragma unroll
  for (int i = 0; i < 4; ++i) {
    const int n = lane + 64 * i, s = n >> 2, ch = n & 3;
    const int row = g.row0 + (s < g.L ? s : g.L - 1);
    if (eb < 4) vv[i] = *(const u32x4*)(P + PIX(row, vcb) + g.h * HD + eb * 32 + ch * 8);
    else vv[i] = (u32x4){ch == 0 ? 0x00003F80u : 0u, 0u, 0u, 0u};
  }
  {
    const int s = lane; float w;
    if (BR == 0) {
      const float* LFp = (const float*)(c.ws + WS_LF); const float* IGp = (const float*)(c.ws + WS_IG);
      const float lf = s < g.L ? LFp[(size_t)(g.row0 + s) * 4 + g.h] : 0.f;
      const float ig = s < g.L ? IGp[(size_t)(g.row0 + s) * 4 + g.h] : -1e30f;
      const float bcum = wave_prefix_sum(lf, lane);
      const float Bc = wshfl(bcum, 63);
      const float gg = Bc - bcum + ig;
      const float G = wave_max(gg, lane);
      w = s < g.L ? __expf(gg - G) : 0.f;
      if (eb == 0 && lane == 0) { ((float*)(c.ws + WS_SCB))[ck] = Bc; ((float*)(c.ws + WS_SCG))[ck] = G; }
    } else {
      w = s < g.L ? exp2f(ret_log2gamma(g.h) * (float)(g.L - 1 - s)) : 0.f;
    }
    wtab[s] = w * 0.08838834764831845f;
  }
#pragma unroll
  for (int i = 0; i < 4; ++i) { const int n = lane + 64 * i, s = n >> 2, ch = n & 3; *(LAS u32x4*)(vtl + s * VS + ch * 16) = vv[i]; }
  LDS_WAIT();
  f32x16 acc[4];
#pragma unroll
  for (int cc = 0; cc < 4; ++cc)
#pragma unroll
    for (int i = 0; i < 16; ++i) acc[cc][i] = 0.f;
  bf16x8 af[4];
#pragma unroll
  for (int ks = 0; ks < 4; ++ks) af[ks] = tr_frag(vtl, VS, 16 * ks + 8 * h, 16 * ks + 8 * h + 4, 0, lane);
#pragma unroll
  for (int dh = 0; dh < 2; ++dh) {
#pragma unroll
    for (int i = 0; i < 8; ++i) {
      const int n = lane + 64 * i, s = n >> 3, ch = n & 7;
      float o[8];
      if (BR == 0) { unpack8(dh == 0 ? kx1[i] : kx2[i], o); }
      else {
        float x1[8], x2[8]; unpack8(kx1[i], x1); unpack8(kx2[i], x2);
        const float* cs = rope + ((size_t)(seq_pos0(g) + (s < g.L ? s : g.L - 1)) * 64 + ch * 8) * 2;
#pragma unroll
        for (int j = 0; j < 8; ++j) { const float co = cs[2 * j], si = cs[2 * j + 1]; o[j] = dh == 0 ? x1[j] * co - x2[j] * si : x1[j] * si + x2[j] * co; }
      }
      const float w = wtab[s];
      *(LAS bf16x8*)(kt + s * KS + ch * 16) = pack8(o[0] * w, o[1] * w, o[2] * w, o[3] * w, o[4] * w, o[5] * w, o[6] * w, o[7] * w);
      if (BR == 1 && (i & 1)) asm volatile("" ::: "memory");
    }
    LDS_WAIT();
#pragma unroll
    for (int ks = 0; ks < 4; ++ks)
#pragma unroll
      for (int cc = 0; cc < 2; ++cc) {
        const bf16x8 bfr = tr_frag(kt, KS, 16 * ks + 8 * h, 16 * ks + 8 * h + 4, 32 * cc, lane);
        acc[2 * dh + cc] = mfma32(af[ks], bfr, acc[2 * dh + cc]);
      }
    LDS_WAIT();
  }
  LAS float* ot = (LAS float*)c.scr;
  o_to_lds(acc, ot, r, h);
  LDS_WAIT();
  bf16_t* st = st_ptr(c, BR, ck);
#pragma unroll
  for (int i = 0; i < 8; ++i) {
    const int q = lane + 64 * i, t = q >> 4, ch = q & 15, e = 32 * eb + t;
    if (e <= 128) {
      const f32x4 x0 = *(const LAS f32x4*)(ot + t * OT_STRIDE + 8 * ch), x1 = *(const LAS f32x4*)(ot + t * OT_STRIDE + 8 * ch + 4);
      u32x4 w; w.x = pk2(x0.x, x0.y); w.y = pk2(x0.z, x0.w); w.z = pk2(x1.x, x1.y); w.w = pk2(x1.z, x1.w);
      *(u32x4*)(st + (size_t)e * HD + 8 * ch) = w;
    }
  }
  LDS_WAIT();
}

DI void scan_prop_item(const Ctx& c, int l, int it) {
  constexpr int NLP = NSEQ_P * 129 + NSEQ_P * 128, NTOT = NSEQ * 129 + NSEQ * 128;
  const bool live = it < NTOT;
  if (!live) it = NTOT - 1;
  int br, sq, e;
  if (it < NLP) { if (it < NSEQ_P * 129) { br = 0; sq = it / 129; e = it % 129; } else { const int j = it - NSEQ_P * 129; br = 1; sq = j / 128; e = j % 128; } }
  else { const int j = it - NLP; if (j < NSEQ_S * 129) { br = 0; sq = NSEQ_P + j / 129; e = j % 129; } else { const int k = j - NSEQ_S * 129; br = 1; sq = NSEQ_P + k / 128; e = k % 128; } }
  const int d0 = 4 * (c.lane & 31);
  const bool sample = sq >= NSEQ_P;
  const int b = sample ? (sq - NSEQ_P) / NH : sq / NH, h = sample ? (sq - NSEQ_P) % NH : sq % NH;
  const int nch = sample ? 1 : NCH_P, ck0 = sample ? NSEQ_P * NCH_P + (sq - NSEQ_P) : sq * NCH_P;
  const int L = sample ? DS : 64;
  float s[4] = {0.f, 0.f, 0.f, 0.f}; float m = 0.f;
  if (sample) {
    if (br == 0) {
      if (e < 128) { const float* C0 = c.in[IN_MC] + (((size_t)l * DB + b) * NH + h) * HD * HD;
#pragma unroll
        for (int j = 0; j < 4; ++j) s[j] = C0[(size_t)(d0 + j) * HD + e]; }
      else { const float* n0 = c.in[IN_MN] + (((size_t)l * DB + b) * NH + h) * HD;
#pragma unroll
        for (int j = 0; j < 4; ++j) s[j] = n0[d0 + j]; }
      m = c.in[IN_MM][((size_t)l * DB + b) * NH + h];
    } else { const float* S0 = c.in[IN_RS] + (((size_t)l * DB + b) * NH + h) * HD * HD;
#pragma unroll
      for (int j = 0; j < 4; ++j) s[j] = S0[(size_t)(d0 + j) * HD + e]; }
  }
  const float* SCB = (const float*)(c.ws + WS_SCB); const float* SCG = (const float*)(c.ws + WS_SCG); float* MCp = (float*)(c.ws + WS_MC);
  const float cdec = br == 1 ? exp2f(ret_log2gamma(h) * (float)L) : 0.f;
  constexpr int PB = 32;
  const int hl = c.lane & 31, hbase = c.lane & 32;
  LAS float* tab = (LAS float*)c.scr + 2 * hbase;
  for (int ci0 = 0; ci0 < nch; ci0 += PB) {
    u32x2 dv[PB];
#pragma unroll
    for (int j = 0; j < PB; ++j) {
      const int ck = ck0 + (ci0 + j < nch ? ci0 + j : nch - 1);
      dv[j] = *(const u32x2*)(st_ptr(c, br, ck) + (size_t)e * HD + d0);
    }
    if (br == 0) {
      const bool okc = ci0 + hl < nch;
      const int ckl = ck0 + (okc ? ci0 + hl : nch - 1);
      const float Bl = okc ? SCB[ckl] : 0.f, Gl = okc ? SCG[ckl] : -1e30f;
      float BB = Bl, GG = Gl;
#pragma unroll
      for (int o = 1; o < 32; o <<= 1) {
        const float pb = wshfl(BB, hbase + (hl >= o ? hl - o : hl)), pg = wshfl(GG, hbase + (hl >= o ? hl - o : hl));
        if (hl >= o) { GG = fmaxf(pg + BB, GG); BB = pb + BB; }
      }
      const float m_out = fmaxf(m + BB, GG);
      float m_in = wshfl(m_out, hbase + (hl > 0 ? hl - 1 : 0)); if (hl == 0) m_in = m;
      tab[2 * hl] = __expf(m_in + Bl - m_out); tab[2 * hl + 1] = __expf(Gl - m_out);
      if (live && okc && e == 0) MCp[ckl] = m_in;
      m = wshfl(m_out, hbase + 31);
      LDS_WAIT();
    }
#pragma unroll
    for (int j = 0; j < PB; ++j) {
      if (ci0 + j < nch) {
        const int ck = ck0 + ci0 + j;
        const float q0 = bits_f(dv[j].x << 16), q1 = bits_f(dv[j].x & 0xffff0000u), q2 = bits_f(dv[j].y << 16), q3 = bits_f(dv[j].y & 0xffff0000u);
        if (live) *(u32x2*)(st2_ptr(c, br, ck) + (size_t)e * HD + d0) = (u32x2){pk2(s[0], s[1]), pk2(s[2], s[3])};
        if (br == 0) { const float dec = tab[2 * j], inj = tab[2 * j + 1];
          s[0] = dec * s[0] + inj * q0; s[1] = dec * s[1] + inj * q1; s[2] = dec * s[2] + inj * q2; s[3] = dec * s[3] + inj * q3; }
        else { s[0] = cdec * s[0] + q0; s[1] = cdec * s[1] + q1; s[2] = cdec * s[2] + q2; s[3] = cdec * s[3] + q3; }
      }
    }
    LDS_WAIT();
  }
  if (!live) return;
  if (br == 0) {
    if (e < 128) { float* o = c.out + (sample ? O_SC + (((size_t)l * DB + b) * NH + h) * HD * HD : O_PC + (((size_t)l * NBATCH + b) * NH + h) * HD * HD);
#pragma unroll
      for (int j = 0; j < 4; ++j) o[(size_t)(d0 + j) * HD + e] = s[j]; }
    else { float* o = c.out + (sample ? O_SN + (((size_t)l * DB + b) * NH + h) * HD : O_PN + (((size_t)l * NBATCH + b) * NH + h) * HD); *(f32x4*)(o + d0) = (f32x4){s[0], s[1], s[2], s[3]}; }
    if (e == 0 && (c.lane & 31) == 0) c.out[(sample ? O_SM + ((size_t)l * DB + b) * NH + h : O_PM + ((size_t)l * NBATCH + b) * NH + h)] = m;
  } else {
    float* o = c.out + (sample ? O_SS + (((size_t)l * DB + b) * NH + h) * HD * HD : O_PS + (((size_t)l * NBATCH + b) * NH + h) * HD * HD);
#pragma unroll
    for (int j = 0; j < 4; ++j) o[(size_t)(d0 + j) * HD + e] = s[j];
  }
}

template <int BR> DI void scan_apply_unit(const Ctx& c, int l, int ck, int th) {
  int lane_ = c.lane; OPAQUE_V(lane_);
  const int lane = lane_, r = lane & 31, h = lane >> 5;
  const ChunkGeo g = chunk_geo(ck);
  if (32 * th >= g.L) return;
  const bf16_t* P = (const bf16_t*)(c.ws + WS_P);
  LAS unsigned char* vt = c.scr;
  LAS float* tb = (LAS float*)(c.scr + 64 * TS272);
  LAS float* t_a = tb; LAS float* t_w = tb + 64; LAS float* t_0 = tb + 128; LAS float* t_1 = tb + 160; LAS float* t_2 = tb + 192;
  const int qcb = BR == 0 ? CB_QB : CB_QC, kcb = BR == 0 ? CB_KB : CB_KC, vcb = BR == 0 ? CB_VB : CB_VC;
  const float* rope = (const float*)(c.ws + WS_ROPE);
  const int pos0 = seq_pos0(g);
  const float l2g = ret_log2gamma(g.h);
  const int tq = 32 * th + r, tqc = tq < g.L ? tq : g.L - 1;
  bf16x8 qf[8];
  u32x4 vreg[16];
#pragma unroll
  for (int s = 0; s < 8; ++s) qf[s] = *(const bf16x8*)(P + PIX(g.row0 + tqc, qcb) + g.h * HD + 16 * s + 8 * h);
#pragma unroll
  for (int i = 0; i < 16; ++i) { const int n = lane + 64 * i, s = n >> 4, ch = n & 15; const int row = g.row0 + (s < g.L ? s : g.L - 1);
    vreg[i] = *(const u32x4*)(P + PIX(row, vcb) + g.h * HD + ch * 8); }
  float Mt = 0.f;
  {
    const int s = lane;
    if (BR == 0) {
      const float* LFp = (const float*)(c.ws + WS_LF); const float* IGp = (const float*)(c.ws + WS_IG);
      const float lf = s < g.L ? LFp[(size_t)(g.row0 + s) * 4 + g.h] : 0.f;
      const float ig = s < g.L ? IGp[(size_t)(g.row0 + s) * 4 + g.h] : -1e30f;
      const float bcum = wave_prefix_sum(lf, lane);
      const float a = ig - bcum;
      const float pm = wave_prefix_max(a, lane);
      const float mc = ((const float*)(c.ws + WS_MC))[ck];
      const float M = fmaxf(mc, pm);
      t_a[s] = a;
      if ((s >> 5) == th) { t_0[s & 31] = __expf(mc - M); t_1[s & 31] = __expf(-(bcum + M)); }
      Mt = wshfl(M, 32 * th + r);
    } else {
      t_w[s] = exp2f(-l2g * (float)s);
      if ((s >> 5) == th) t_0[s & 31] = exp2f(l2g * (float)(s + 1));
    }
  }
  if (BR == 1) rotary_frags(qf, rope + (size_t)(pos0 + tqc) * 128, h);
#pragma unroll
  for (int i = 0; i < 16; ++i) { const int n = lane + 64 * i, s = n >> 4, ch = n & 15; *(LAS u32x4*)(vt + s * TS272 + ch * 16) = vreg[i]; }
  LDS_WAIT();
  constexpr int NB = BR == 0 ? 5 : 4;
  f32x16 acc[NB];
  const bf16_t* st = st2_ptr(c, BR, ck);
#pragma unroll
  for (int cc = 0; cc < NB; ++cc) {
#pragma unroll
    for (int i = 0; i < 16; ++i) acc[cc][i] = 0.f;
#pragma unroll
    for (int s = 0; s < 8; ++s) { const bf16x8 bfr = *(const bf16x8*)(st + (size_t)(32 * cc + r) * HD + 16 * s + 8 * h); acc[cc] = mfma32(qf[s], bfr, acc[cc]); }
  }
  {
    float sc[16];
#pragma unroll
    for (int i = 0; i < 16; ++i) sc[i] = t_0[crow(i, h)];
#pragma unroll
    for (int cc = 0; cc < NB; ++cc)
#pragma unroll
      for (int i = 0; i < 16; ++i) acc[cc][i] *= sc[i];
  }
  const float gt = BR == 1 ? exp2f(l2g * (float)tq) : 0.f;
  for (int kb = 0; kb <= th; ++kb) {
    bf16x8 kf[8];
    const int sk = 32 * kb + r, skc = sk < g.L ? sk : g.L - 1;
#pragma unroll
    for (int s = 0; s < 8; ++s) kf[s] = *(const bf16x8*)(P + PIX(g.row0 + skc, kcb) + g.h * HD + 16 * s + 8 * h);
    if (BR == 1) rotary_frags(kf, rope + (size_t)(pos0 + skc) * 128, h);
    f32x16 sacc;
#pragma unroll
    for (int i = 0; i < 16; ++i) sacc[i] = 0.f;
#pragma unroll
    for (int s = 0; s < 8; ++s) sacc = mfma32(kf[s], qf[s], sacc);
    float wv[16];
#pragma unroll
    for (int i = 0; i < 16; ++i) {
      const int s = 32 * kb + crow(i, h);
      const bool ok = s <= tq && s < g.L;
      float w;
      if (BR == 0) w = __expf(fminf(t_a[s] - Mt, 0.f)) * sacc[i] * 0.08838834764831845f;
      else w = sacc[i] * 0.08838834764831845f * gt * t_w[s];
      wv[i] = ok ? w : 0.f;
    }
    const bf16x8 pf0 = pack8(wv[0], wv[1], wv[2], wv[3], wv[4], wv[5], wv[6], wv[7]);
    const bf16x8 pf1 = pack8(wv[8], wv[9], wv[10], wv[11], wv[12], wv[13], wv[14], wv[15]);
#pragma unroll
    for (int cc = 0; cc < 4; ++cc) {
      const bf16x8 v0 = tr_frag(vt, TS272, 32 * kb + 4 * h, 32 * kb + 8 + 4 * h, 32 * cc, lane);
      const bf16x8 v1 = tr_frag(vt, TS272, 32 * kb + 16 + 4 * h, 32 * kb + 24 + 4 * h, 32 * cc, lane);
      acc[cc] = mfma32(pf0, v0, acc[cc]);
      acc[cc] = mfma32(pf1, v1, acc[cc]);
    }
    if (BR == 0) {
      const bf16x8 ones = r == 0 ? (bf16x8){0x3F80, 0x3F80, 0x3F80, 0x3F80, 0x3F80, 0x3F80, 0x3F80, 0x3F80} : (bf16x8){0, 0, 0, 0, 0, 0, 0, 0};
      acc[NB - 1] = mfma32(pf0, ones, acc[NB - 1]);
      acc[NB - 1] = mfma32(pf1, ones, acc[NB - 1]);
    }
  }
  if (BR == 0) {
    if (r == 0) {
#pragma unroll
      for (int i = 0; i < 16; ++i) t_2[crow(i, h)] = acc[NB - 1][i];
    }
    LDS_WAIT();
#pragma unroll
    for (int i = 0; i < 16; ++i) {
      const int t = crow(i, h);
      const float dn = fmaxf(fabsf(t_2[t]), t_1[t]);
      const float inv = 1.0f / dn;
#pragma unroll
      for (int cc = 0; cc < 4; ++cc) acc[cc][i] *= inv;
    }
  }
  bf16_t* YC = (bf16_t*)(c.ws + WS_YCAT);
  LAS float* ot = (LAS float*)c.scr;
  LDS_WAIT();
  o_to_lds(acc, ot, r, h);
  LDS_WAIT();
  {
    const LAS float* rp = ot + r * OT_STRIDE + 64 * h;
    float s1 = 0.f, s2 = 0.f;
#pragma unroll
    for (int k = 0; k < 16; ++k) { const f32x4 x = *(const LAS f32x4*)(rp + 4 * k); s1 += (x.x + x.y) + (x.z + x.w); s2 += (x.x * x.x + x.y * x.y) + (x.z * x.z + x.w * x.w); }
    s1 += wshfl_xor(s1, 32, lane); s2 += wshfl_xor(s2, 32, lane);
    const float mean = s1 * (1.0f / HD), var = fmaxf(s2 * (1.0f / HD) - mean * mean, 0.f);
    if (h == 0) { t_0[r] = mean; t_1[r] = 1.0f / sqrtf(var + 1e-5f); }
  }
  LDS_WAIT();
#pragma unroll
  for (int i = 0; i < 8; ++i) {
    const int q = lane + 64 * i, t = q >> 4, ch = q & 15;
    if (32 * th + t < g.L) {
      const size_t row = (size_t)(g.row0 + 32 * th + t);
      const int col = g.h * HD + 8 * ch;
      const f32x4 x0 = *(const LAS f32x4*)(ot + t * OT_STRIDE + 8 * ch), x1 = *(const LAS f32x4*)(ot + t * OT_STRIDE + 8 * ch + 4);
      const float mean = t_0[t], rstd = t_1[t];
      float y[8] = {(x0.x - mean) * rstd, (x0.y - mean) * rstd, (x0.z - mean) * rstd, (x0.w - mean) * rstd, (x1.x - mean) * rstd, (x1.y - mean) * rstd, (x1.z - mean) * rstd, (x1.w - mean) * rstd};
      if (BR == 0) {
        float ob[8], zb[8]; unpack8(*(const u32x4*)(P + PIX(row, CB_OB) + col), ob); unpack8(*(const u32x4*)(P + PIX(row, CB_ZB) + col), zb);
#pragma unroll
        for (int j = 0; j < 8; ++j) y[j] *= sigmoid_f(ob[j]) * silu_f(zb[j]);
      } else {
        float zc[8]; unpack8(*(const u32x4*)(P + PIX(row, CB_ZC) + col), zc);
#pragma unroll
        for (int j = 0; j < 8; ++j) y[j] *= silu_f(zc[j]);
      }
      u32x4 w; w.x = pk2(y[0], y[1]); w.y = pk2(y[2], y[3]); w.z = pk2(y[4], y[5]); w.w = pk2(y[6], y[7]);
      *(u32x4*)(YC + row * D + (BR == 0 ? 1 : 2) * W + col) = w;
    }
  }
  LDS_WAIT();
}

template <int MODE> DI void sample_tail_gemm(const Ctx& c, int l, const bf16_t* Wt  , const bf16_t* Act  ) {
  int lane_ = c.lane; OPAQUE_V(lane_);
  const int lane = lane_, r = lane & 31, h = lane >> 5, wv = c.wave, tw = wv & 3, kh = wv >> 2;
  const bf16_t* P = (const bf16_t*)(c.ws + WS_P);
  constexpr int NTILE = (TS / 32) * (D / 32);
  LAS float* xch = (LAS float*)(c.lds) + tw * 1024;
  for (int tb = c.bid; tb * 4 < NTILE; tb += c.G) {
    const int tile = tb * 4 + tw, tt = tile / (D / 32), nn = tile % (D / 32);
    const int t0 = 32 * tt, n0 = 32 * nn;
    const bf16_t* ap = Wt + (size_t)(n0 + r) * D + kh * 1024 + 8 * h;
    const bf16_t* bp = Act + (size_t)(t0 + r) * D + kh * 1024 + 8 * h;
    f32x16 acc;
#pragma unroll
    for (int i = 0; i < 16; ++i) acc[i] = 0.f;
    const size_t grow = (size_t)(TP + t0 + r);
#pragma unroll 1
    for (int sg = 0; sg < 2; ++sg) {
#pragma unroll 1
      for (int k0 = 0; k0 < 32; k0 += 8) {
        bf16x8 af[8], bf[8];
#pragma unroll
        for (int q = 0; q < 8; ++q) { af[q] = *(const bf16x8*)(ap + (sg * 32 + k0 + q) * 16); bf[q] = *(const bf16x8*)(bp + (sg * 32 + k0 + q) * 16); }
#pragma unroll
        for (int q = 0; q < 8; ++q) acc = mfma32(af[q], bf[q], acc);
      }
      if (MODE == 0) {
        const int br = 2 * kh + sg;
#pragma unroll
        for (int g4 = 0; g4 < 4; ++g4) {
          const int n = n0 + 8 * g4 + 4 * h;
          const u32x2 ea = *(const u32x2*)(P + PIX(grow, CB_G0 + 4 * br + (n >> 9)) + (n & 511));
          float e0[4] = {bits_f(ea.x << 16), bits_f(ea.x & 0xffff0000u), bits_f(ea.y << 16), bits_f(ea.y & 0xffff0000u)};
          float sc[4];
          if (sg == 0) {
            const u32x2 eb = *(const u32x2*)(P + PIX(grow, CB_G0 + 4 * (br + 1) + (n >> 9)) + (n & 511));
            const float e1[4] = {bits_f(eb.x << 16), bits_f(eb.x & 0xffff0000u), bits_f(eb.y << 16), bits_f(eb.y & 0xffff0000u)};
#pragma unroll
            for (int j = 0; j < 4; ++j) sc[j] = e1[j] * frcp(e0[j]);
          } else {
#pragma unroll
            for (int j = 0; j < 4; ++j) sc[j] = frcp(e0[j]);
          }
#pragma unroll
          for (int j = 0; j < 4; ++j) acc[4 * g4 + j] *= sc[j];
        }
      }
    }
    if (kh == 1) {
#pragma unroll
      for (int i = 0; i < 16; ++i) xch[i * 64 + lane] = acc[i];
    }
    __syncthreads();
    if (kh == 0) {
#pragma unroll
      for (int i = 0; i < 16; ++i) acc[i] += xch[i * 64 + lane];
#pragma unroll
      for (int g4 = 0; g4 < 4; ++g4) {
        const int n = n0 + 8 * g4 + 4 * h;
        if (MODE == 0) {
          bf16_t* o = (bf16_t*)(c.ws + WS_MG) + grow * D + n;
          *(u32x2*)o = (u32x2){pk2(acc[4 * g4], acc[4 * g4 + 1]), pk2(acc[4 * g4 + 2], acc[4 * g4 + 3])};
        } else {
          const float* xin = (l == 0) ? c.in[IN_XS] + (size_t)(t0 + r) * D + n : c.out + O_Y + grow * D + n;
          const f32x4 xv = *(const f32x4*)xin;
          *(f32x4*)(c.out + O_Y + grow * D + n) = (f32x4){xv.x + acc[4 * g4], xv.y + acc[4 * g4 + 1], xv.z + acc[4 * g4 + 2], xv.w + acc[4 * g4 + 3]};
        }
      }
    }
    __syncthreads();
  }
}

DI void phase_final(const Ctx& c) {
  const float* fg = c.in[IN_FG];
  const int gwv = c.bid * NWAVES + c.wave, NGW = c.G * NWAVES, lane = c.lane;
  f32x4 gv[8];
#pragma unroll
  for (int j = 0; j < 8; ++j) gv[j] = *(const f32x4*)(fg + 256 * j + 4 * lane);
  for (int r = gwv; r < T; r += NGW) {
    float* xr = c.out + O_Y + (size_t)r * D;
    f32x4 v[8]; float ss = 0.f;
#pragma unroll
    for (int j = 0; j < 8; ++j) { v[j] = *(const f32x4*)(xr + 256 * j + 4 * lane); ss += (v[j].x * v[j].x + v[j].y * v[j].y) + (v[j].z * v[j].z + v[j].w * v[j].w); }
    const float rstd = 1.0f / sqrtf(wave_sum(ss, lane) * (1.0f / D) + 1e-6f);
#pragma unroll
    for (int j = 0; j < 8; ++j) *(f32x4*)(xr + 256 * j + 4 * lane) = v[j] * rstd * gv[j];
  }
}

constexpr int PH_PRO = 0, PH_PER_LAYER = 7, PH_FINAL = 1 + DEPTH * PH_PER_LAYER, PH_COUNT = PH_FINAL + 1;
constexpr int CW_BAR = 4096;

__global__ void __launch_bounds__(NTHREADS, 2) fwd(Args args) {
  DYN_LDS(lds);
  Ctx c;
  c.lds = lds; c.tid = threadIdx.x; c.lane = c.tid & 63; c.wave = rfl(c.tid >> 6); c.G = gridDim.x; c.bid = blockIdx.x;
  const int wave_s = c.wave; (void)wave_s;
  c.scr = lds + c.wave * WSCR;
#pragma unroll
  for (int i = 0; i < 20; ++i) c.in[i] = args.in[i];
  c.out = args.out; c.ws = args.ws;
  const int lo = args.ph_lo, hi = args.ph_hi;
#ifndef EMU
  if (c.tid < 16) ((LAS unsigned*)(lds + LDSCTL_OFF))[c.tid] = 0u;
  __syncthreads();
  XcdBarrier bar = xcd_barrier_post((unsigned*)(c.ws + WS_CTL) + CW_BAR, (volatile LAS unsigned*)(lds + LDSCTL_OFF));
#define GRID_BAR() xcd_barrier(bar)
#else
#define GRID_BAR() do {} while (0)
#endif
#ifndef PHMASK
#define PHMASK 0x1FF
#endif
#define KIND(kk) ((PHMASK >> (kk)) & 1)
#ifndef REP_NORM
#define REP_NORM 1
#endif
#ifndef REP_INPROJ
#define REP_INPROJ 1
#endif
#ifndef REP_MIX1
#define REP_MIX1 1
#endif
#ifndef REP_MIX3
#define REP_MIX3 1
#endif
#ifndef REP_MERGE
#define REP_MERGE 1
#endif
#ifdef EMU
#define LAUNDER() do {} while (0)
#else
#define LAUNDER() do { unsigned m_ = ~0u; int w_ = wave_s; asm volatile("" : "+s"(m_), "+s"(w_));   \
    c.lane = (int)__builtin_amdgcn_mbcnt_hi(m_, __builtin_amdgcn_mbcnt_lo(m_, 0u)); c.wave = w_; c.tid = w_ * 64 + c.lane; c.scr = lds + w_ * WSCR; } while (0)
#endif
#define IN(k) (lo <= (k) && (k) < hi)
#define SEAM(k) do { if (hi > (k) + 1) GRID_BAR(); } while (0)

  #ifndef REP_PRO
#define REP_PRO 1
#endif
  if (KIND(0) && IN(PH_PRO)) { _Pragma("unroll 1") for (int rp = 0; rp < REP_PRO; ++rp) { LAUNDER(); phase_prologue(c); } __syncthreads();   }

  for (int l = 0; l < DEPTH; ++l) {
    const int pb = 1 + l * PH_PER_LAYER;
    if (KIND(1) && IN(pb + 0)) { _Pragma("unroll 1") for (int rep = 0; rep < REP_NORM; ++rep) { LAUNDER(); phase_norm(c, l); SEAM(pb + 0); } }
    if (KIND(2) && IN(pb + 1)) _Pragma("unroll 1") for (int rep = 0; rep < REP_INPROJ; ++rep) { LAUNDER();
      pg8::Gemm g{(const bf16_t*)(c.ws + WS_HIN), (const bf16_t*)(c.ws + WS_WIN) + (size_t)l * NP * D, T, NP, D, D, D, 0, 0};
      pg8::StaticOrder S; S.init(T, NP, c.G, c.bid);
      EpiInproj E{(bf16_t*)(c.ws + WS_P), c.out, l};
      pg8::gemm_phase<EpiInproj, pg8::StaticOrder, true>(lds, g, S, E, c.tid);
      SEAM(pb + 1);
    }
    if (KIND(3) && IN(pb + 2)) _Pragma("unroll 1") for (int rep = 0; rep < REP_MIX1; ++rep) { LAUNDER();
#ifndef SUBMASK
#define SUBMASK 15
#endif
#ifndef REP_CONV
#define REP_CONV 1
#endif
#ifndef REP_ATTN
#define REP_ATTN 1
#endif
#ifndef REP_LOC
#define REP_LOC 1
#endif
      _Pragma("unroll 1") for (int rp = 0; rp < REP_CONV; ++rp) phase_conv(c, l);
      const int gwv = c.bid * NWAVES + c.wave, NGW = c.G * NWAVES;
      { const int NF = NGW > NLONGW ? NGW - NLONGW : 0, ND = NF < NUA / 2 ? NF : NUA / 2;
        _Pragma("unroll 1") for (int rp = 0; rp < REP_ATTN; ++rp) for (int u = gwv; u < NUA - ND; u += NGW) attn_unit(c, l, u); }
      _Pragma("unroll 1") for (int rp = 0; rp < REP_LOC; ++rp) {
      for (int u = (gwv + (NGW * 9) / 16) % NGW; u < NCHUNK * 5; u += NGW) scan_local_unit<0>(c, l, u / 5, u % 5);
      for (int u = (gwv + (NGW * 14) / 16) % NGW; u < NCHUNK * 4; u += NGW) scan_local_unit<1>(c, l, u >> 2, u & 3); }
      SEAM(pb + 2);
    }
    #ifndef REP_MIX2
#define REP_MIX2 1
#endif
    if (KIND(4) && IN(pb + 3)) _Pragma("unroll 1") for (int rp = 0; rp < REP_MIX2; ++rp) { LAUNDER();
      const int wv = c.wave * c.G + c.bid, NGW = c.G * NWAVES;
      constexpr int NIT = NSEQ * 129 + NSEQ * 128;
      for (int wi = wv; 2 * wi < NIT; wi += NGW) scan_prop_item(c, l, 2 * wi + (c.lane >> 5));
      { const int NF = NGW > NLONGW ? NGW - NLONGW : 0, ND = NF < NUA / 2 ? NF : NUA / 2;
        if (wv >= NLONGW && wv - NLONGW < ND) attn_unit(c, l, NUA - ND + (wv - NLONGW)); }
      SEAM(pb + 3);
    }
    if (KIND(5) && IN(pb + 4)) _Pragma("unroll 1") for (int rep = 0; rep < REP_MIX3; ++rep) { LAUNDER();
      const int gwv = c.bid * NWAVES + c.wave, NGW = c.G * NWAVES;
      for (int u = gwv; u < NCHUNK * 2; u += NGW) scan_apply_unit<0>(c, l, u >> 1, u & 1);
      for (int u = (gwv + NGW / 2) % NGW; u < NCHUNK * 2; u += NGW) scan_apply_unit<1>(c, l, u >> 1, u & 1);
      SEAM(pb + 4);
    }
    if (KIND(6) && IN(pb + 5)) _Pragma("unroll 1") for (int rep = 0; rep < REP_MERGE; ++rep) { LAUNDER();
      pg8::Gemm g{(const bf16_t*)(c.ws + WS_YCAT), (const bf16_t*)(c.ws + WS_WBR) + (size_t)l * D * D, TP, D, D, D, D, 0, 0};
      pg8::StaticOrder S; S.init(TP, D, c.G, c.bid);
      EpiMergeH E{(const bf16_t*)(c.ws + WS_P), (bf16_t*)(c.ws + WS_MG)};
      pg8::gemm_phase<EpiMergeH, pg8::StaticOrder, true>(lds, g, S, E, c.tid);
      sample_tail_gemm<0>(c, l, (const bf16_t*)(c.ws + WS_WBR) + (size_t)l * D * D, (const bf16_t*)(c.ws + WS_YCAT) + (size_t)TP * D);
      SEAM(pb + 5);
    }
    #ifndef REP_OUT0
#define REP_OUT0 1
#endif
    if (KIND(7) && IN(pb + 6)) _Pragma("unroll 1") for (int rp = 0; rp < (l == 0 ? REP_OUT0 : 1); ++rp) { LAUNDER();
      pg8::Gemm g{(const bf16_t*)(c.ws + WS_MG), (const bf16_t*)(c.ws + WS_WOUT) + (size_t)l * D * D, TP, D, D, D, D, 0, 0};
      pg8::StaticOrder S; S.init(TP, D, c.G, c.bid);
      EpiOut E{c.in[IN_XP], c.in[IN_XS], c.out + O_Y, c.out + O_Y, l};
      pg8::gemm_phase<EpiOut, pg8::StaticOrder, true>(lds, g, S, E, c.tid);
      sample_tail_gemm<1>(c, l, (const bf16_t*)(c.ws + WS_WOUT) + (size_t)l * D * D, (const bf16_t*)(c.ws + WS_MG) + (size_t)TP * D);
      SEAM(pb + 6);
    }
  }
  if (KIND(8) && IN(PH_FINAL)) { LAUNDER(); phase_final(c); }
#undef IN
#undef SEAM
}

#ifndef N_LAUNCHES
#define N_LAUNCHES 1
#endif
#ifdef EMU
void emu_after_phase(int p, unsigned char* ws, float* out);
#endif
extern "C" void kernel_launch(void* const* d_in, const int* in_sizes, int n_in, void* d_out, int out_size, void* d_ws, size_t ws_size, hipStream_t stream) {
  (void)in_sizes; (void)n_in; (void)out_size; (void)ws_size;
  Args a;
  memset(&a, 0, sizeof(a));
  for (int i = 0; i < 20; ++i) a.in[i] = (const float*)d_in[i];
  a.out = (float*)d_out; a.ws = (unsigned char*)d_ws;
#ifdef EMU
  int grid = EMU_GRID;
  for (int p = 0; p < PH_COUNT; ++p) { a.ph_lo = p; a.ph_hi = p + 1; emu_launch(fwd, grid, NTHREADS, LDS_BYTES, a); emu_after_phase(p, a.ws, a.out); }
#else
  static int grid = 0;
  if (grid == 0) {
    int dev = 0, cus = 0;
    if (hipGetDevice(&dev) != hipSuccess || hipDeviceGetAttribute(&cus, hipDeviceAttributeMultiprocessorCount, dev) != hipSuccess) { grid = -1; return; }
    if (hipFuncSetAttribute((const void*)fwd, hipFuncAttributeMaxDynamicSharedMemorySize, LDS_BYTES) != hipSuccess) { grid = -1; return; }
    int per_cu = 0;
    (void)hipOccupancyMaxActiveBlocksPerMultiprocessor(&per_cu, (const void*)fwd, NTHREADS, LDS_BYTES);
    (void)hipGetLastError();
    grid = cus;
  }
  if (grid < 0) return;
  (void)hipMemsetAsync((char*)d_ws + WS_CTL, 0, CTL_BYTES, stream);
  if (N_LAUNCHES == 1) { a.ph_lo = 0; a.ph_hi = PH_COUNT; hipLaunchKernelGGL(fwd, dim3(grid), dim3(NTHREADS), LDS_BYTES, stream, a); }
  else for (int p = 0; p < PH_COUNT; ++p) { a.ph_lo = p; a.ph_hi = p + 1; hipLaunchKernelGGL(fwd, dim3(grid), dim3(NTHREADS), LDS_BYTES, stream, a); }
#endif
}
```

```cpp
#ifndef EMU
#include <hip/hip_runtime.h>
#include <cstdio>
#include <cstdint>
#include <cstring>
#endif

typedef unsigned short bf16_t;
typedef short bf16x8 __attribute__((ext_vector_type(8)));
typedef short s16x4 __attribute__((ext_vector_type(4)));
typedef float f32x4 __attribute__((ext_vector_type(4)));
typedef float f32x16 __attribute__((ext_vector_type(16)));
typedef unsigned u32x4 __attribute__((ext_vector_type(4)));
typedef unsigned u32x2 __attribute__((ext_vector_type(2)));

#ifdef EMU
#define DI inline
#define LAS
#define GAS
DI unsigned f_bits(float f) { unsigned u; memcpy(&u, &f, 4); return u; }
DI float bits_f(unsigned u) { float f; memcpy(&f, &u, 4); return f; }
DI float ex2(float x) { return exp2f(x); }
DI float lg2(float x) { return log2f(x); }
DI float frcp(float x) { return 1.0f / x; }
DI float wshfl(float v, int src) { auto s = emu::wave_exchange(&v, 4); float r; memcpy(&r, s[src & 63], 4); return r; }
DI float wshfl_xor(float v, int m, int lane) { return wshfl(v, lane ^ m); }
DI float wshfl_up(float v, int d, int lane) { return wshfl(v, lane >= d ? lane - d : lane); }
DI int rfl(int v) { return v; }
DI float bf2f(bf16_t b) { return bits_f((unsigned)b << 16); }
DI f32x16 mfma32(bf16x8 a, bf16x8 b, f32x16 c) {
  struct { bf16x8 a, b; } d{a, b};
  auto s = emu::wave_exchange(&d, 32);
  int lane = emu::tid() & 63, r = lane & 31, h = lane >> 5;
  f32x16 o = c;
  for (int i = 0; i < 16; ++i) {
    int row = (i & 3) + 8 * (i >> 2) + 4 * h; double acc = 0;
    for (int k = 0; k < 16; ++k) {
      bf16x8 av, bv; memcpy(&av, s[row + 32 * (k >> 3)], 16); memcpy(&bv, (char*)s[r + 32 * (k >> 3)] + 16, 16);
      acc += (double)bf2f((bf16_t)av[k & 7]) * (double)bf2f((bf16_t)bv[k & 7]);
    }
    o[i] = c[i] + (float)acc;
  }
  return o;
}
DI s16x4 ds_tr16(const void* p) {
  auto s = emu::wave_exchange(&p, 8);
  int lane = emu::tid() & 63, g = lane & ~15, i = lane & 15;
  s16x4 o;
  for (int q = 0; q < 4; ++q) { const short* a; memcpy(&a, s[g + 4 * q + (i >> 2)], 8); o[q] = a[i & 3]; }
  return o;
}
#define OPAQUE_V(x) do {} while (0)
#define NT_STORE(ptr, val) (*(ptr) = (val))
#define VM_WAIT() do {} while (0)
#define LDS_WAIT() do { int _z = 0; (void)emu::wave_exchange(&_z, 4); } while (0)
#define DYN_LDS(name) unsigned char* name = emu::g_blk->lds
DI float log1p_f(float x) { return log1pf(x); }
#else
#define DI __device__ __forceinline__
#define LAS __attribute__((address_space(3)))
#define GAS __attribute__((address_space(1)))
DI unsigned f_bits(float f) { return __builtin_bit_cast(unsigned, f); }
DI float bits_f(unsigned u) { return __builtin_bit_cast(float, u); }
DI float ex2(float x) { return __builtin_amdgcn_exp2f(x); }
DI float lg2(float x) { return __builtin_amdgcn_logf(x); }
DI float frcp(float x) { return __builtin_amdgcn_rcpf(x); }
DI float wshfl(float v, int src) { return bits_f((unsigned)__builtin_amdgcn_ds_bpermute(src << 2, (int)f_bits(v))); }
DI float wshfl_xor(float v, int m, int lane) { return wshfl(v, lane ^ m); }
DI float wshfl_up(float v, int d, int lane) { return wshfl(v, lane >= d ? lane - d : lane); }
DI int rfl(int v) { return __builtin_amdgcn_readfirstlane(v); }
DI float bf2f(bf16_t b) { return bits_f((unsigned)b << 16); }
DI f32x16 mfma32(bf16x8 a, bf16x8 b, f32x16 c) { return __builtin_amdgcn_mfma_f32_32x32x16_bf16(a, b, c, 0, 0, 0); }
DI s16x4 ds_tr16(const LAS void* p) { return __builtin_amdgcn_ds_read_tr16_b64_v4i16((LAS s16x4*)p); }
#define OPAQUE_V(x) asm volatile("" : "+v"(x))
#define NT_STORE(ptr, val) __builtin_nontemporal_store((val), (ptr))
#define VM_WAIT() asm volatile("s_waitcnt vmcnt(0)" ::: "memory")
#define LDS_WAIT() asm volatile("s_waitcnt lgkmcnt(0)" ::: "memory")
#define DYN_LDS(name) extern __shared__ __attribute__((aligned(16))) unsigned char name##_raw[]; LAS unsigned char* name = (LAS unsigned char*)name##_raw
DI float log1p_f(float x) { return x < 1e-4f ? x * (1.0f - 0.5f * x) : __builtin_amdgcn_logf(1.0f + x) * 0.6931471805599453f; }
#endif

DI bf16_t f2bf(float f) { unsigned u = f_bits(f); return (bf16_t)((u + 0x7fffu + ((u >> 16) & 1u)) >> 16); }
#ifdef EMU
DI unsigned pk2(float lo, float hi) { return (unsigned)f2bf(lo) | ((unsigned)f2bf(hi) << 16); }
#else
typedef float f32x2_t __attribute__((ext_vector_type(2))); typedef __bf16 bf16x2_t __attribute__((ext_vector_type(2)));
DI unsigned pk2(float lo, float hi) { f32x2_t v = {lo, hi}; bf16x2_t b = __builtin_convertvector(v, bf16x2_t); return __builtin_bit_cast(unsigned, b); }
#endif
DI bf16x8 pack8(float a0, float a1, float a2, float a3, float a4, float a5, float a6, float a7) {
  u32x4 p; p.x = pk2(a0, a1); p.y = pk2(a2, a3); p.z = pk2(a4, a5); p.w = pk2(a6, a7); return __builtin_bit_cast(bf16x8, p);
}
DI void unpack8(const u32x4 g, float (&o)[8]) {
#pragma unroll
  for (int j = 0; j < 4; ++j) { o[2 * j] = bits_f(g[j] << 16); o[2 * j + 1] = bits_f(g[j] & 0xffff0000u); }
}
DI float wave_sum(float v, int lane) {
#pragma unroll
  for (int o = 1; o < 64; o <<= 1) v += wshfl_xor(v, o, lane);
  return v;
}
DI float wave_max(float v, int lane) {
#pragma unroll
  for (int o = 1; o < 64; o <<= 1) v = fmaxf(v, wshfl_xor(v, o, lane));
  return v;
}
DI float wave_min(float v, int lane) {
#pragma unroll
  for (int o = 1; o < 64; o <<= 1) v = fminf(v, wshfl_xor(v, o, lane));
  return v;
}
DI float half_sum(float v, int lane) {
#pragma unroll
  for (int o = 1; o < 32; o <<= 1) v += wshfl_xor(v, o, lane);
  return v;
}
DI float sigmoid_f(float x) { return 1.0f / (1.0f + __expf(-x)); }
DI float silu_f(float x) { return x * sigmoid_f(x); }
DI int crow(int i, int h) { return (i & 3) + 8 * (i >> 2) + 4 * h; }


#ifdef EMU
constexpr int SEQ = EMU_SEQ, PAST = EMU_PAST;
#else
constexpr int SEQ = 16384, PAST = 4096;
#endif
constexpr int D = 2048, NBATCH = 2, DEPTH = 2, DB = 32, DS = 16, W = 512, NH = 4, HD = 128, CW = 31;
constexpr int TP = NBATCH * SEQ, TS = DB * DS, T = TP + TS;
constexpr int NP = 16384, N_IN = 16392, GATE_COL = 4608;
#define PIX(row, cb) (((size_t)(cb) * T + (size_t)(row)) * 512)
constexpr int NCH_P = SEQ / 64, NSEQ_P = NBATCH * NH, NSEQ_S = DB * NH, NSEQ = NSEQ_P + NSEQ_S;
constexpr int NCHUNK = NSEQ_P * NCH_P + NSEQ_S;
constexpr int NWAVES = 8, NTHREADS = 512;
static_assert(T % 256 == 0 && SEQ % 64 == 0 && PAST % 32 == 0 && PAST + DS <= SEQ, "shapes");
constexpr int CB_QA = 0, CB_KA = 1, CB_VA = 2, CB_ZA = 3, CB_QB = 4, CB_KB = 5, CB_VB = 6, CB_OB = 7, CB_ZB = 8, CB_QC = 9, CB_KC = 10, CB_VC = 11, CB_ZC = 12,
              CB_UD = 13, CB_GD = 14, CB_ZD = 15, CB_G0 = 16;
constexpr size_t O_Y = 0;
constexpr size_t O_PK = O_Y + (size_t)T * D;
constexpr size_t O_PV = O_PK + (size_t)DEPTH * TP * W;
constexpr size_t O_PC = O_PV + (size_t)DEPTH * TP * W;
constexpr size_t O_PN = O_PC + (size_t)DEPTH * NBATCH * NH * HD * HD;
constexpr size_t O_PM = O_PN + (size_t)DEPTH * NBATCH * NH * HD;
constexpr size_t O_PS = O_PM + (size_t)DEPTH * NBATCH * NH;
constexpr size_t O_PCONV = O_PS + (size_t)DEPTH * NBATCH * NH * HD * HD;
constexpr size_t O_SK = O_PCONV + (size_t)DEPTH * NBATCH * 30 * W;
constexpr size_t O_SV = O_SK + (size_t)DEPTH * TS * W;
constexpr size_t O_SC = O_SV + (size_t)DEPTH * TS * W;
constexpr size_t O_SN = O_SC + (size_t)DEPTH * DB * NH * HD * HD;
constexpr size_t O_SM = O_SN + (size_t)DEPTH * DB * NH * HD;
constexpr size_t O_SS = O_SM + (size_t)DEPTH * DB * NH;
constexpr size_t O_SCONV = O_SS + (size_t)DEPTH * DB * NH * HD * HD;
constexpr size_t O_END = O_SCONV + (size_t)DEPTH * DB * 30 * W;
constexpr size_t MiB = 1u << 20;
constexpr size_t al(size_t x) { return (x + 4095) & ~(size_t)4095; }
constexpr size_t WS_CTL = 0, CTL_BYTES = 1 * MiB;
constexpr size_t WS_WIN = WS_CTL + CTL_BYTES;
constexpr size_t WS_WBR = WS_WIN + al((size_t)DEPTH * NP * D * 2);
constexpr size_t WS_WOUT = WS_WBR + al((size_t)DEPTH * 4 * D * W * 2);
constexpr size_t WS_ROPE = WS_WOUT + al((size_t)DEPTH * D * D * 2);
constexpr size_t WS_IG = WS_ROPE + al((size_t)SEQ * 64 * 8);
constexpr size_t WS_LF = WS_IG + al((size_t)T * 4 * 4);
constexpr size_t WS_SCB = WS_LF + al((size_t)T * 4 * 4);
constexpr size_t WS_SCG = WS_SCB + al((size_t)NCHUNK * 4);
constexpr size_t WS_MC = WS_SCG + al((size_t)NCHUNK * 4);
constexpr size_t WS_HIN = WS_MC + al((size_t)NCHUNK * 4);
constexpr int ST_ROWS = 160;
constexpr size_t ST_BYTES = (size_t)ST_ROWS * HD * 2;
constexpr size_t WS_ST = WS_HIN + al((size_t)T * D * 2);
constexpr size_t WS_ST2 = WS_ST + al((size_t)2 * NCHUNK * ST_BYTES);
constexpr size_t WS_P = WS_ST2 + al((size_t)2 * NCHUNK * ST_BYTES);
constexpr size_t WS_YCAT = WS_P + al((size_t)T * NP * 2);
constexpr size_t WS_MG = WS_YCAT + al((size_t)T * D * 2);
constexpr size_t WS_END = WS_MG + al((size_t)T * D * 2);
constexpr int WSCR = 18304;
constexpr int LDSCTL_OFF = NWAVES * WSCR;
constexpr int LDS_BYTES = 147456;
static_assert(LDSCTL_OFF + 64 <= LDS_BYTES && LDSCTL_OFF % 16 == 0, "lds map");
constexpr int TS272 = 272;

struct Args {
  const float* in[20]; float* out; unsigned char* ws; int ph_lo, ph_hi;
};

namespace pg8 {
constexpr int BM = 256, BK = 64, HALF = 128, HTB = HALF * BK * 2, STAGE_BYTES = 8 * HTB, NXCD = 8, WGM = 4;
__host__ __device__ inline int lds_byte(int r, int c) { const int st = (r >> 4) * 2 + (c >> 5), rr = r & 15, cc = c & 31, ob = rr * 64 + cc * 2; return st * 1024 + (ob ^ (((ob >> 9) & 1) << 5)); }
__host__ __device__ inline void stage_rc(int b, int& R, int& C) { const int st = b / 1024, sb = b % 1024, swz = sb ^ (((sb >> 9) & 1) << 5); R = (st >> 1) * 16 + swz / 64; C = (st & 1) * 32 + (swz % 64) / 2; }
__host__ __device__ inline int perm32(int rho) { const int n = rho >> 4, i = rho & 15; return 8 * (i >> 2) + 4 * n + (i & 3); }
struct Unit { int pm, pn, kb; };
struct Gemm { const bf16_t* A; const bf16_t* Bt; int M, N, K, lda, ldb; size_t kbA, kbB; };
struct StaticOrder {
  int nM, nN, nwg, G, c;
  __host__ __device__ void init(int M, int N, int G_, int c_) { nM = M / BM; nN = N / BM; nwg = nM * nN; G = G_; c = c_; }
  __host__ __device__ bool tile(long L, Unit& u) const {
    if (L >= nwg) return false;
    int wgid = (int)L; { const int q = nwg / NXCD, r = nwg % NXCD, xcd = wgid % NXCD, off = wgid / NXCD; wgid = (xcd < r ? xcd * (q + 1) : r * (q + 1) + (xcd - r) * q) + off; }
    const int nig = WGM * nN, gid = wgid / nig, fm = gid * WGM, gsz = (nM - fm) < WGM ? (nM - fm) : WGM;
    u.pm = fm + ((wgid % nig) % gsz); u.pn = (wgid % nig) / gsz; u.kb = 0; return true;
  }
  __host__ __device__ bool next(int i, Unit& u) const { return tile((long)i * G + c, u); }
};
#ifndef EMU
template <class Epi, class Sched, bool ALIGN_EPI>
__device__ __forceinline__ void gemm_phase(LAS unsigned char* lds, const Gemm g, const Sched& S, const Epi& E, const int tid) {
  const int wid = __builtin_amdgcn_readfirstlane(tid >> 6), lane = tid & 63, wr = wid >> 2, wc = wid & 3, fr = lane & 15, fq = lane >> 4;
  const int nt = g.K / BK;
  unsigned voffA[2], voffB[2];
#pragma unroll
  for (int i = 0; i < 2; ++i) { int R, C; stage_rc(tid * 16 + i * 8192, R, C); const int Rb = Epi::PERM ? ((R & ~31) + perm32(R & 31)) : R;
    voffA[i] = (unsigned)(R * g.lda + C) * 2u; voffB[i] = (unsigned)(Rb * g.ldb + C) * 2u; }
  const size_t kstep = (size_t)(BK * 2);
  const size_t hstepA = (size_t)HALF * g.lda * 2, hstepB = (size_t)HALF * g.ldb * 2;
  const unsigned ldsw = (unsigned)wid * 1024u;
  const int aoff = lds_byte(wr * 64 + fr, fq * 8), boff = lds_byte(wc * 32 + fr, fq * 8);
#define PG8_SA(b, h) (((b) * 2 + (h)) * HTB)
#define PG8_SB(b, h) ((4 + (b) * 2 + (h)) * HTB)
#define PG8_STAGE(bufoff, gbase, voff) do { _Pragma("unroll") for (int _i = 0; _i < 2; ++_i) \
    __builtin_amdgcn_global_load_lds((const unsigned*)((const char*)(gbase) + (voff)[_i]), (LAS unsigned*)(lds + (bufoff) + ldsw + _i * 8192), 16, 0, 0); } while (0)
#define PG8_LDA(dst, b, h) do { _Pragma("unroll") for (int m = 0; m < 4; ++m) _Pragma("unroll") for (int k = 0; k < 2; ++k) dst[m][k] = *(const LAS bf16x8*)(lds + PG8_SA(b, h) + aoff + m * 2048 + k * 1024); } while (0)
#define PG8_LDB(dst, b, h) do { _Pragma("unroll") for (int n = 0; n < 2; ++n) _Pragma("unroll") for (int k = 0; k < 2; ++k) dst[n][k] = *(const LAS bf16x8*)(lds + PG8_SB(b, h) + boff + n * 2048 + k * 1024); } while (0)
#define PG8_MMA(ai, bj, At, Bt) do { __builtin_amdgcn_s_setprio(1); _Pragma("unroll") for (int m = 0; m < 4; ++m) _Pragma("unroll") for (int n = 0; n < 2; ++n) _Pragma("unroll") for (int k = 0; k < 2; ++k) \
    acc[ai][bj][m][n] = __builtin_amdgcn_mfma_f32_16x16x32_bf16(Bt[n][k], At[m][k], acc[ai][bj][m][n], 0, 0, 0); __builtin_amdgcn_s_setprio(0); } while (0)
#define PG8_WAIT_V(n) asm volatile("s_waitcnt vmcnt(" #n ")" ::: "memory")
#define PG8_WAIT_L(n) asm volatile("s_waitcnt lgkmcnt(" #n ")" ::: "memory")
#define PG8_BAR __builtin_amdgcn_s_barrier()
#define PG8_SCHED __builtin_amdgcn_sched_barrier(0)
  Unit cur, nxt; int ui = 0;
  if (!S.next(0, cur)) return;
  f32x4 acc[2][2][4][2];
#pragma unroll
  for (int a = 0; a < 2; ++a)
#pragma unroll
    for (int b = 0; b < 2; ++b)
#pragma unroll
      for (int m = 0; m < 4; ++m)
#pragma unroll
        for (int n = 0; n < 2; ++n) acc[a][b][m][n] = (f32x4){0.f, 0.f, 0.f, 0.f};
  bf16x8 At[4][2], B0[2][2], B1[2][2];
  const char* cA = (const char*)g.A + (size_t)cur.pm * 2 * hstepA + (size_t)cur.kb * g.kbA;
  const char* cB = (const char*)g.Bt + (size_t)cur.pn * 2 * hstepB + (size_t)cur.kb * g.kbB;
  PG8_STAGE(PG8_SB(0, 0), cB, voffB); PG8_STAGE(PG8_SB(0, 1), cB + hstepB, voffB); PG8_STAGE(PG8_SA(0, 0), cA, voffA); PG8_STAGE(PG8_SA(0, 1), cA + hstepA, voffA);
  if (wr == 1) PG8_BAR;
  PG8_WAIT_V(2); PG8_BAR;
  PG8_STAGE(PG8_SB(1, 0), cB + kstep, voffB); PG8_STAGE(PG8_SA(1, 0), cA + kstep, voffA); PG8_STAGE(PG8_SB(1, 1), cB + hstepB + kstep, voffB);
  PG8_WAIT_V(6); PG8_BAR;
  for (;;) {
    const bool has_next = S.next(ui + 1, nxt);
    const char* nA = has_next ? (const char*)g.A + (size_t)nxt.pm * 2 * hstepA + (size_t)nxt.kb * g.kbA : cA;
    const char* nB = has_next ? (const char*)g.Bt + (size_t)nxt.pn * 2 * hstepB + (size_t)nxt.kb * g.kbB : cB;
    for (int t = 0; t < nt; t += 2) {
      const bool last = (t == nt - 2);
      const char* a1 = cA + (size_t)(t + 1) * kstep;
      const char* a2 = last ? nA : cA + (size_t)(t + 2) * kstep; const char* b2 = last ? nB : cB + (size_t)(t + 2) * kstep;
      const char* a3 = a2 + kstep; const char* b3 = b2 + kstep;
      PG8_LDB(B0, 0, 0); PG8_LDB(B1, 0, 1); PG8_SCHED; PG8_LDA(At, 0, 0); PG8_STAGE(PG8_SA(1, 1), a1 + hstepA, voffA);
      PG8_WAIT_V(8); PG8_WAIT_L(0); PG8_BAR; PG8_MMA(0, 0, At, B0); PG8_MMA(0, 1, At, B1); PG8_BAR; PG8_SCHED;
      PG8_LDA(At, 0, 1); PG8_STAGE(PG8_SB(0, 0), b2, voffB); PG8_STAGE(PG8_SB(0, 1), b2 + hstepB, voffB); PG8_STAGE(PG8_SA(0, 0), a2, voffA);
      PG8_WAIT_V(8); PG8_WAIT_L(0); PG8_BAR; PG8_MMA(1, 0, At, B0); PG8_MMA(1, 1, At, B1); PG8_BAR; PG8_SCHED;
      PG8_LDB(B0, 1, 0); PG8_LDB(B1, 1, 1); PG8_SCHED; PG8_LDA(At, 1, 0); PG8_STAGE(PG8_SA(0, 1), a2 + hstepA, voffA);
      PG8_WAIT_V(8); PG8_WAIT_L(0); PG8_BAR; PG8_MMA(0, 0, At, B0); PG8_MMA(0, 1, At, B1); PG8_BAR; PG8_SCHED;
      PG8_LDA(At, 1, 1); PG8_STAGE(PG8_SB(1, 0), b3, voffB); PG8_STAGE(PG8_SB(1, 1), b3 + hstepB, voffB); PG8_STAGE(PG8_SA(1, 0), a3, voffA);
      PG8_WAIT_V(8); PG8_WAIT_L(0); PG8_BAR; PG8_MMA(1, 0, At, B0); PG8_MMA(1, 1, At, B1); PG8_BAR; PG8_SCHED;
      if constexpr (Epi::MID > 0) { if (((t + 2) % Epi::MID) == 0 && (t + 2) < nt) E.mid(acc, cur, (t + 2) / Epi::MID - 1, wr, wc, fr, fq); }
    }
    if constexpr (ALIGN_EPI) { if (wr == 0) PG8_BAR; }
    E(acc, cur, wr, wc, fr, fq);
    if (!has_next) break;
#pragma unroll
    for (int a = 0; a < 2; ++a)
#pragma unroll
      for (int b = 0; b < 2; ++b)
#pragma unroll
        for (int m = 0; m < 4; ++m)
#pragma unroll
          for (int n = 0; n < 2; ++n) acc[a][b][m][n] = (f32x4){0.f, 0.f, 0.f, 0.f};
    cur = nxt; cA = nA; cB = nB; ++ui;
    if constexpr (ALIGN_EPI) { if (wr == 1) PG8_BAR; }
  }
  PG8_WAIT_V(0);
  if constexpr (!ALIGN_EPI) { if (wr == 0) PG8_BAR; }
  PG8_BAR;
#undef PG8_SA
#undef PG8_SB
#undef PG8_STAGE
#undef PG8_LDA
#undef PG8_LDB
#undef PG8_MMA
#undef PG8_WAIT_V
#undef PG8_WAIT_L
#undef PG8_BAR
#undef PG8_SCHED
}
#else
template <class Epi, class Sched, bool ALIGN_EPI>
inline void gemm_phase(unsigned char* lds, const Gemm g, const Sched& S, const Epi& E, const int tid) {
  (void)lds;
  const int wid = tid >> 6, lane = tid & 63, wr = wid >> 2, wc = wid & 3, fr = lane & 15, fq = lane >> 4;
  emu::Block* blk = emu::g_blk;
  Unit u;
  for (int ui = 0; S.next(ui, u); ++ui) {
    __syncthreads();
    if (tid == 0) { blk->fa.resize((size_t)256 * g.K); blk->fb.resize((size_t)256 * g.K); }
    __syncthreads();
    const bf16_t* A = (const bf16_t*)((const char*)g.A + (size_t)u.kb * g.kbA) + (size_t)u.pm * 256 * g.lda;
    const bf16_t* B = (const bf16_t*)((const char*)g.Bt + (size_t)u.kb * g.kbB) + (size_t)u.pn * 256 * g.ldb;
    for (int i = tid; i < 256; i += NTHREADS) for (int k = 0; k < g.K; ++k) { blk->fa[(size_t)i * g.K + k] = bf2f(A[(size_t)i * g.lda + k]); blk->fb[(size_t)i * g.K + k] = bf2f(B[(size_t)i * g.ldb + k]); }
    __syncthreads();
    f32x4 acc[2][2][4][2];
    const int nseg = Epi::MID > 0 ? g.K / (Epi::MID * BK) : 1, segk = g.K / nseg;
    for (int ai = 0; ai < 2; ++ai) for (int bj = 0; bj < 2; ++bj) for (int m = 0; m < 4; ++m) for (int n = 0; n < 2; ++n) for (int j = 0; j < 4; ++j) acc[ai][bj][m][n][j] = 0.f;
    for (int sg = 0; sg < nseg; ++sg) {
      for (int ai = 0; ai < 2; ++ai) for (int bj = 0; bj < 2; ++bj) for (int m = 0; m < 4; ++m) for (int n = 0; n < 2; ++n) for (int j = 0; j < 4; ++j) {
        const int row = 128 * ai + 64 * wr + 16 * m + fr;
        const int col = Epi::PERM ? 128 * bj + 32 * wc + 8 * fq + 4 * n + j : 128 * bj + 32 * wc + 16 * n + 4 * fq + j;
        const float* a = &blk->fa[(size_t)row * g.K + sg * segk]; const float* b = &blk->fb[(size_t)col * g.K + sg * segk];
        float s = 0.f; for (int k = 0; k < segk; ++k) s += a[k] * b[k];
        acc[ai][bj][m][n][j] += s;
      }
      if constexpr (Epi::MID > 0) { if (sg + 1 < nseg) E.mid(acc, u, sg, wr, wc, fr, fq); }
    }
    E(acc, u, wr, wc, fr, fq);
  }
  __syncthreads();
}
#endif
}

#ifndef EMU
#define XB_TMO      128
#define XB_XCNT(j)  (256  + 64 * (j))
#define XB_XSUB(j)  (1280 + 64 * (j))
#define XB_XGEN(j)  (2304 + 64 * (j))
#define XB_TOP      3328
#define XB_TOPGEN   3392
#define XCD_BAR_WORDS 3456
#define XB_SPIN_CAP (1u << 18)
__device__ __forceinline__ unsigned xb_ld(unsigned* p)              { return __hip_atomic_load(p, __ATOMIC_RELAXED, __HIP_MEMORY_SCOPE_AGENT); }
__device__ __forceinline__ unsigned xb_add(unsigned* p, unsigned v) { return __hip_atomic_fetch_add(p, v, __ATOMIC_RELAXED, __HIP_MEMORY_SCOPE_AGENT); }
__device__ __forceinline__ unsigned xb_xcc_id() { return (unsigned)__builtin_amdgcn_s_getreg((3 << 11) | 20) & 0xFu; }
#define XB_SPIN(cond, bar) do { unsigned _sp = 0; while (cond) { __builtin_amdgcn_s_sleep(1); \
    if ((++_sp & 255u) == 0u) { if (xb_ld(&(bar)[XB_TMO])) break; if (_sp > XB_SPIN_CAP) { atomicAdd(&(bar)[XB_TMO], 1u); break; } } } } while (0)
struct XcdBarrier { unsigned* bar; unsigned x; volatile LAS unsigned* st; };
__device__ __forceinline__ XcdBarrier xcd_barrier_post(unsigned* bar, volatile LAS unsigned* st) {
  XcdBarrier b; b.bar = bar; b.x = xb_xcc_id(); b.st = st;
  if (threadIdx.x == 0) (void)xb_add(&bar[XB_XCNT(b.x)], 1u);
  return b;
}
__device__ __forceinline__ void xcd_barrier_complete(unsigned* bar, unsigned x, unsigned& nloc, unsigned& nx) {
  const unsigned G = gridDim.x * gridDim.y * gridDim.z;
  unsigned sum, cnt, mine, sp = 0u;
  for (;;) {
    sum = 0u; cnt = 0u; mine = 0u;
#pragma unroll
    for (unsigned j = 0; j < 16; ++j) { const unsigned c = xb_ld(&bar[XB_XCNT(j)]); sum += c; cnt += (c > 0u) ? 1u : 0u; mine = (j == x) ? c : mine; }
    if (sum == G) break;
    __builtin_amdgcn_s_sleep(1);
    if ((++sp & 255u) == 0u) { if (xb_ld(&bar[XB_TMO])) break; if (sp > XB_SPIN_CAP) { atomicAdd(&bar[XB_TMO], 1u); break; } }
  }
  nloc = mine > 0u ? mine : 1u; nx = cnt > 0u ? cnt : 1u;
}
__device__ __forceinline__ void xcd_barrier(const XcdBarrier& b) {
  asm volatile("s_waitcnt vmcnt(0)" ::: "memory");
  __syncthreads();
  if (threadIdx.x == 0) {
    unsigned* bar = b.bar;
    __builtin_amdgcn_s_waitcnt(0);
    unsigned nloc = b.st[0], nx = b.st[1];
    if (nloc == 0u) { xcd_barrier_complete(bar, b.x, nloc, nx); b.st[0] = nloc; b.st[1] = nx; }
    const unsigned old = xb_add(&bar[XB_XSUB(b.x)], 1u);
    const unsigned gen = old / nloc;
    if (old + 1u == (gen + 1u) * nloc) {
      __builtin_amdgcn_fence(__ATOMIC_RELEASE, "agent");
      asm volatile("s_waitcnt vmcnt(0)" ::: "memory");
      const unsigned og = xb_add(&bar[XB_TOP], 1u);
      const unsigned tg = og / nx;
      if (og + 1u == (tg + 1u) * nx) xb_add(&bar[XB_TOPGEN], 1u);
      else XB_SPIN(xb_ld(&bar[XB_TOPGEN]) == tg, bar);
      __builtin_amdgcn_fence(__ATOMIC_ACQUIRE, "agent");
      xb_add(&bar[XB_XGEN(b.x)], 1u);
      asm volatile("s_waitcnt vmcnt(0)" ::: "memory");
    } else {
      XB_SPIN(xb_ld(&bar[XB_XGEN(b.x)]) == gen, bar);
      __builtin_amdgcn_fence(__ATOMIC_ACQUIRE, "agent");
      asm volatile("s_waitcnt vmcnt(0)" ::: "memory");
    }
  }
  __syncthreads();
}
#endif

struct Ctx {
  LAS unsigned char* lds;
  LAS unsigned char* scr;
  int tid, lane, wave, G, bid;
  const float* in[20]; float* out; unsigned char* ws;
};
enum { IN_XP = 0, IN_XS, IN_CK, IN_CV, IN_MC, IN_MN, IN_MM, IN_RS, IN_CONV, IN_NG, IN_WIN, IN_BI, IN_BF, IN_CWT, IN_CB, IN_LNG, IN_LNB, IN_WBR, IN_WOUT, IN_FG };

DI const float* x_row_in(const Ctx& c, int r) { return r < TP ? c.in[IN_XP] + (size_t)r * D : c.in[IN_XS] + (size_t)(r - TP) * D; }

#ifdef EMU
static const float ROPE_INV[64] = {1.000000000e+00f, 8.659643531e-01f, 7.498942614e-01f, 6.493816376e-01f, 5.623413324e-01f, 4.869675338e-01f, 4.216965139e-01f, 3.651741147e-01f, 3.162277639e-01f, 2.738419771e-01f, 2.371373773e-01f, 2.053525001e-01f, 1.778279394e-01f, 1.539926529e-01f, 1.333521307e-01f, 1.154782027e-01f, 1.000000015e-01f, 8.659642935e-02f, 7.498941571e-02f, 6.493816525e-02f, 5.623413250e-02f, 4.869675264e-02f, 4.216965288e-02f, 3.651741147e-02f, 3.162277490e-02f, 2.738419734e-02f, 2.371373773e-02f, 2.053525113e-02f, 1.778279431e-02f, 1.539926510e-02f, 1.333521493e-02f, 1.154782064e-02f, 9.999999776e-03f, 8.659643121e-03f, 7.498941850e-03f, 6.493816152e-03f, 5.623413250e-03f, 4.869675264e-03f, 4.216964822e-03f, 3.651741194e-03f, 3.162277630e-03f, 2.738419687e-03f, 2.371373586e-03f, 2.053524833e-03f, 1.778279431e-03f, 1.539926510e-03f, 1.333521446e-03f, 1.154781901e-03f, 1.000000047e-03f, 8.659643354e-04f, 7.498942432e-04f, 6.493816618e-04f, 5.623413017e-04f, 4.869675322e-04f, 4.216965172e-04f, 3.651741426e-04f, 3.162277571e-04f, 2.738419571e-04f, 2.371373703e-04f, 2.053525095e-04f, 1.778279402e-04f, 1.539926452e-04f, 1.333521504e-04f, 1.154782003e-04f};
#else
__constant__ float ROPE_INV[64] = {1.000000000e+00f, 8.659643531e-01f, 7.498942614e-01f, 6.493816376e-01f, 5.623413324e-01f, 4.869675338e-01f, 4.216965139e-01f, 3.651741147e-01f, 3.162277639e-01f, 2.738419771e-01f, 2.371373773e-01f, 2.053525001e-01f, 1.778279394e-01f, 1.539926529e-01f, 1.333521307e-01f, 1.154782027e-01f, 1.000000015e-01f, 8.659642935e-02f, 7.498941571e-02f, 6.493816525e-02f, 5.623413250e-02f, 4.869675264e-02f, 4.216965288e-02f, 3.651741147e-02f, 3.162277490e-02f, 2.738419734e-02f, 2.371373773e-02f, 2.053525113e-02f, 1.778279431e-02f, 1.539926510e-02f, 1.333521493e-02f, 1.154782064e-02f, 9.999999776e-03f, 8.659643121e-03f, 7.498941850e-03f, 6.493816152e-03f, 5.623413250e-03f, 4.869675264e-03f, 4.216964822e-03f, 3.651741194e-03f, 3.162277630e-03f, 2.738419687e-03f, 2.371373586e-03f, 2.053524833e-03f, 1.778279431e-03f, 1.539926510e-03f, 1.333521446e-03f, 1.154781901e-03f, 1.000000047e-03f, 8.659643354e-04f, 7.498942432e-04f, 6.493816618e-04f, 5.623413017e-04f, 4.869675322e-04f, 4.216965172e-04f, 3.651741426e-04f, 3.162277571e-04f, 2.738419571e-04f, 2.371373703e-04f, 2.053525095e-04f, 1.778279402e-04f, 1.539926452e-04f, 1.333521504e-04f, 1.154782003e-04f};
#endif
DI void transpose_item(const float* Wsrc, int ldn, int K, bf16_t* WT, LAS float* scr, int kb, int srccol  , int n0dst, int lane, int koff = 0) {
  const int k0 = 64 * kb;
#pragma unroll 8
  for (int i = 0; i < 32; ++i) { const int kk = 2 * i + (lane >> 5); scr[kk * 33 + (lane & 31)] = Wsrc[(size_t)(k0 + kk) * ldn + srccol]; }
  LDS_WAIT();
  const int ch = lane & 7;
#pragma unroll
  for (int j = 0; j < 4; ++j) { const int n = (lane >> 3) + 8 * j; const LAS float* s = scr + (8 * ch) * 33 + n;
    u32x4 o; o.x = pk2(s[0 * 33], s[1 * 33]); o.y = pk2(s[2 * 33], s[3 * 33]); o.z = pk2(s[4 * 33], s[5 * 33]); o.w = pk2(s[6 * 33], s[7 * 33]);
    *(u32x4*)(WT + (size_t)(n0dst + n) * K + koff + k0 + 8 * ch) = o; }
  LDS_WAIT();
}
DI void phase_prologue(const Ctx& c) {
  LAS float* scr = (LAS float*)c.scr;
  const int gw = c.bid * NWAVES + c.wave, NGW = c.G * NWAVES;
  constexpr int I_IN = (D / 64) * (NP / 32), I_BR = 4 * (W / 64) * (D / 32), I_OUT = (D / 64) * (D / 32), I_L = I_IN + I_BR + I_OUT;
  for (int it = gw; it < DEPTH * I_L; it += NGW) {
    const int l = it / I_L; int r = it % I_L;
    if (r < I_IN) { const int nblk = NP / 32, kb = r / nblk, nb = r % nblk, n0 = 32 * nb;
      const int np = n0 + (c.lane & 31);
      int src = np < GATE_COL ? np : np + 8;
      if (np >= CB_UD * 512 && np < (CB_GD + 1) * 512) { const int g = (np - CB_UD * 512) >> 3, q = np & 7; src = (q < 4 ? CB_UD * 512 + 8 : CB_GD * 512 + 8) + 4 * g + (q & 3); }
      transpose_item(c.in[IN_WIN] + (size_t)l * D * N_IN, N_IN, D, (bf16_t*)(c.ws + WS_WIN) + (size_t)l * NP * D, scr, kb, src, n0, c.lane); continue; }
    r -= I_IN;
    if (r < I_BR) { const int per = (W / 64) * (D / 32), br = r / per, rr = r % per, nblk = D / 32, kb = rr / nblk, nb = rr % nblk;
      transpose_item(c.in[IN_WBR] + ((size_t)l * 4 + br) * W * D, D, D, (bf16_t*)(c.ws + WS_WBR) + (size_t)l * D * D, scr, kb, 32 * nb + (c.lane & 31), 32 * nb, c.lane, br * W); continue; }
    r -= I_BR;
    { const int nblk = D / 32, kb = r / nblk, nb = r % nblk;
      transpose_item(c.in[IN_WOUT] + (size_t)l * D * D, D, D, (bf16_t*)(c.ws + WS_WOUT) + (size_t)l * D * D, scr, kb, 32 * nb + (c.lane & 31), 32 * nb, c.lane); }
  }
  float* rope = (float*)(c.ws + WS_ROPE);
  for (int i = c.bid * NTHREADS + c.tid; i < SEQ * 64; i += c.G * NTHREADS) {
    const int pos = i >> 6, j = i & 63;
    const float inv = ROPE_INV[j];
    const float ang = (float)pos * inv;
    const double a = (double)ang, n = rint(a * 0.15915494309189535), red = (a - n * 6.283185307179586) ;
    const float rr = (float)(red - n * 2.4492935982947064e-16);
    rope[2 * i] = cosf(rr); rope[2 * i + 1] = sinf(rr);
  }
}

DI void phase_norm(const Ctx& c, int l) {
  LAS float* gw = (LAS float*)c.lds;
  const float* win = c.in[IN_WIN] + (size_t)l * D * N_IN + GATE_COL;
  for (int i = c.tid; i < D * 8; i += NTHREADS) { const int k = i >> 3, q = i & 7;
    gw[((((k >> 8) * 4 + (k & 3)) * 2 + (q >> 2)) * 64 + ((k >> 2) & 63)) * 4 + (q & 3)] = win[(size_t)k * N_IN + q]; }
  __syncthreads();
  const float* ng = c.in[IN_NG] + (size_t)l * D;
  bf16_t* HIN = (bf16_t*)(c.ws + WS_HIN);
  float* IG = (float*)(c.ws + WS_IG); float* LF = (float*)(c.ws + WS_LF);
  const int gwv = c.bid * NWAVES + c.wave, NGW = c.G * NWAVES, lane = c.lane;
  const int gq = (lane & 1) * 4 + ((lane >> 1) & 1) * 2 + ((lane >> 2) & 1);
  const float gbias = gq < 4 ? c.in[IN_BI][l * NH + gq] : c.in[IN_BF][l * NH + gq - 4];
  const bool b0 = lane & 1, b1 = lane & 2, b2 = lane & 4;
  const int loff = 4 * lane;
  f32x4 vn[8];
  {
    const float* xr = (l == 0) ? x_row_in(c, gwv < T ? gwv : 0) : c.out + O_Y + (size_t)(gwv < T ? gwv : 0) * D;
#pragma unroll
    for (int j = 0; j < 8; ++j) vn[j] = *(const f32x4*)(xr + loff + 256 * j);
  }
  for (int r = gwv; r < T; r += NGW) {
    f32x4 v[8]; float ss = 0.f;
#pragma unroll
    for (int j = 0; j < 8; ++j) { v[j] = vn[j]; ss += (v[j].x * v[j].x + v[j].y * v[j].y) + (v[j].z * v[j].z + v[j].w * v[j].w); }
    {
      const int rn = r + NGW < T ? r + NGW : r;
      const float* xr = (l == 0) ? x_row_in(c, rn) : c.out + O_Y + (size_t)rn * D;
#pragma unroll
      for (int j = 0; j < 8; ++j) vn[j] = *(const f32x4*)(xr + loff + 256 * j);
    }
    const float rstd = 1.0f / sqrtf(wave_sum(ss, lane) * (1.0f / D) + 1e-6f);
    float ga[8];
#pragma unroll
    for (int k = 0; k < 8; ++k) ga[k] = 0.f;
    bf16_t* hrow = HIN + (size_t)r * D + loff;
#pragma unroll
    for (int j = 0; j < 8; ++j) {
      const LAS float* gp = gw + (j * 8 * 64 + lane) * 4;
      const f32x4 gvj = *(const f32x4*)(ng + 256 * j + loff);
      v[j] = v[j] * rstd * gvj;
      *(u32x2*)(hrow + 256 * j) = (u32x2){pk2(v[j].x, v[j].y), pk2(v[j].z, v[j].w)};
#pragma unroll
      for (int e = 0; e < 4; ++e) {
        const f32x4 w0 = *(const LAS f32x4*)(gp + e * 512), w1 = *(const LAS f32x4*)(gp + e * 512 + 256);
        const float xv = v[j][e];
        ga[0] += xv * w0.x; ga[1] += xv * w0.y; ga[2] += xv * w0.z; ga[3] += xv * w0.w;
        ga[4] += xv * w1.x; ga[5] += xv * w1.y; ga[6] += xv * w1.z; ga[7] += xv * w1.w;
      }
      asm volatile("" ::: "memory");
    }
    {
      float t4[4];
#pragma unroll
      for (int k = 0; k < 4; ++k) { const float snd = b0 ? ga[k] : ga[4 + k]; const float keep = b0 ? ga[4 + k] : ga[k]; t4[k] = keep + wshfl_xor(snd, 1, lane); }
      float t2[2];
#pragma unroll
      for (int k = 0; k < 2; ++k) { const float snd = b1 ? t4[k] : t4[2 + k]; const float keep = b1 ? t4[2 + k] : t4[k]; t2[k] = keep + wshfl_xor(snd, 2, lane); }
      float t1; { const float snd = b2 ? t2[0] : t2[1]; const float keep = b2 ? t2[1] : t2[0]; t1 = keep + wshfl_xor(snd, 4, lane); }
      t1 += wshfl_xor(t1, 8, lane); t1 += wshfl_xor(t1, 16, lane); t1 += wshfl_xor(t1, 32, lane);
      if (lane < 8) {
        const float val = t1 + gbias;
        if (gq < 4) IG[(size_t)r * 4 + gq] = val;
        else LF[(size_t)r * 4 + gq - 4] = fminf(val, 0.f) - log1p_f(__expf(-fabsf(val)));
      }
    }
  }
  __syncthreads();
}

DI float gate_e(float g) { return __expf(-fmaxf(g, -30.f)); }
struct EpiInproj {
  static constexpr bool PERM = true; static constexpr int MID = 0;
  bf16_t* P; float* out; int l;
  DI void operator()(const f32x4 (&acc)[2][2][4][2], const pg8::Unit& u, int wr, int wc, int fr, int fq) const {
    const int row0 = u.pm * 256 + wr * 64 + fr, colt = u.pn * 256, cb = colt >> 9;
    const int col0 = colt + wc * 32 + 8 * fq;
    const bool kv = (cb == CB_KA || cb == CB_VA), gate = cb >= CB_G0, glu = (cb == CB_UD || cb == CB_GD);
    if (glu) {
#pragma unroll
      for (int ai = 0; ai < 2; ++ai)
#pragma unroll
        for (int m = 0; m < 4; ++m) {
          const int r = row0 + ai * 128 + m * 16;
#pragma unroll
          for (int bj = 0; bj < 2; ++bj) {
            const f32x4 v0 = acc[ai][bj][m][0], v1 = acc[ai][bj][m][1];
            const int chb = (col0 + bj * 128 - CB_UD * 512) >> 1;
            const float g0 = v0[0] * sigmoid_f(v1[0]), g1 = v0[1] * sigmoid_f(v1[1]), g2 = v0[2] * sigmoid_f(v1[2]), g3 = v0[3] * sigmoid_f(v1[3]);
            *(u32x2*)(P + PIX(r, CB_UD) + chb) = (u32x2){pk2(g0, g1), pk2(g2, g3)};
          }
        }
      return;
    }
#pragma unroll
    for (int ai = 0; ai < 2; ++ai)
#pragma unroll
      for (int m = 0; m < 4; ++m) {
        const int r = row0 + ai * 128 + m * 16;
        bf16_t* rowp = P + PIX(r, cb) + (col0 - cb * 512);
#pragma unroll
        for (int bj = 0; bj < 2; ++bj) {
          f32x4 v0 = acc[ai][bj][m][0], v1 = acc[ai][bj][m][1];
          if (gate) {
#pragma unroll
            for (int j = 0; j < 4; ++j) { v0[j] = 1.0f + gate_e(v0[j]); v1[j] = 1.0f + gate_e(v1[j]); }
          }
          u32x4 w; w.x = pk2(v0[0], v0[1]); w.y = pk2(v0[2], v0[3]); w.z = pk2(v1[0], v1[1]); w.w = pk2(v1[2], v1[3]);
          NT_STORE((u32x4*)(rowp + bj * 128), w);
          if (kv) {
            const int cc = col0 + bj * 128 - cb * 512;
            float* o = (r < TP) ? out + (cb == CB_KA ? O_PK : O_PV) + ((size_t)l * TP + r) * W + cc
                                : out + (cb == CB_KA ? O_SK : O_SV) + ((size_t)l * TS + (r - TP)) * W + cc;
            *(f32x4*)o = v0; *(f32x4*)(o + 4) = v1;
          }
        }
      }
  }
};
struct EpiMergeH {
  static constexpr bool PERM = true; static constexpr int MID = 8;
  const bf16_t* P; bf16_t* MG;
  DI void mid(f32x4 (&acc)[2][2][4][2], const pg8::Unit& u, int seg, int wr, int wc, int fr, int fq) const {
    const int row0 = u.pm * 256 + wr * 64 + fr, col0 = u.pn * 256 + wc * 32 + 8 * fq;
#pragma unroll
    for (int ai = 0; ai < 2; ++ai) {
      u32x4 qa[4][2], qb[4][2];
#pragma unroll
      for (int m = 0; m < 4; ++m) {
        const bf16_t* gp = P + PIX(row0 + ai * 128 + m * 16, CB_G0 + seg * 4 + (u.pn >> 1)) + (col0 & 511);
#pragma unroll
        for (int bj = 0; bj < 2; ++bj) { qa[m][bj] = *(const u32x4*)(gp + bj * 128); qb[m][bj] = *(const u32x4*)(gp + (size_t)4 * T * 512 + bj * 128); }
      }
#pragma unroll
      for (int m = 0; m < 4; ++m)
#pragma unroll
        for (int bj = 0; bj < 2; ++bj) {
          float ga[8], gb[8]; unpack8(qa[m][bj], ga); unpack8(qb[m][bj], gb);
          float rt[8];
#pragma unroll
          for (int j = 0; j < 8; ++j) rt[j] = gb[j] * frcp(ga[j]);
          f32x4& v0 = acc[ai][bj][m][0]; f32x4& v1 = acc[ai][bj][m][1];
          v0 = (f32x4){v0[0] * rt[0], v0[1] * rt[1], v0[2] * rt[2], v0[3] * rt[3]};
          v1 = (f32x4){v1[0] * rt[4], v1[1] * rt[5], v1[2] * rt[6], v1[3] * rt[7]};
        }
      asm volatile("" ::: "memory");
    }
  }
  DI void operator()(const f32x4 (&acc)[2][2][4][2], const pg8::Unit& u, int wr, int wc, int fr, int fq) const {
    const int row0 = u.pm * 256 + wr * 64 + fr, col0 = u.pn * 256 + wc * 32 + 8 * fq;
    u32x4 q3[2][4][2];
#pragma unroll
    for (int ai = 0; ai < 2; ++ai)
#pragma unroll
      for (int m = 0; m < 4; ++m)
#pragma unroll
        for (int bj = 0; bj < 2; ++bj) q3[ai][m][bj] = *(const u32x4*)(P + PIX(row0 + ai * 128 + m * 16, CB_G0 + 12 + (u.pn >> 1)) + ((col0 + bj * 128) & 511));
#pragma unroll
    for (int ai = 0; ai < 2; ++ai)
#pragma unroll
      for (int m = 0; m < 4; ++m) {
        const int r = row0 + ai * 128 + m * 16;
#pragma unroll
        for (int bj = 0; bj < 2; ++bj) {
          const int cc = col0 + bj * 128;
          float g3[8]; unpack8(q3[ai][m][bj], g3);
          float s[8];
#pragma unroll
          for (int j = 0; j < 8; ++j) s[j] = frcp(g3[j]);
          const f32x4 v0 = acc[ai][bj][m][0], v1 = acc[ai][bj][m][1];
          u32x4 w; w.x = pk2(v0[0] * s[0], v0[1] * s[1]); w.y = pk2(v0[2] * s[2], v0[3] * s[3]); w.z = pk2(v1[0] * s[4], v1[1] * s[5]); w.w = pk2(v1[2] * s[6], v1[3] * s[7]);
          *(u32x4*)(MG + (size_t)r * D + cc) = w;
        }
      }
  }
};
struct EpiOut {
  static constexpr bool PERM = false; static constexpr int MID = 0;
  const float* xp; const float* xs; const float* xprev; float* y; int l;
  DI void operator()(const f32x4 (&acc)[2][2][4][2], const pg8::Unit& u, int wr, int wc, int fr, int fq) const {
    const int row0 = u.pm * 256 + wr * 64 + fr, col0 = u.pn * 256 + wc * 32 + 4 * fq;
#pragma unroll
    for (int ai = 0; ai < 2; ++ai) {
      f32x4 xv[4][2][2];
#pragma unroll
      for (int m = 0; m < 4; ++m) {
        const int r = row0 + ai * 128 + m * 16;
        const float* xin = (l == 0) ? (r < TP ? xp + (size_t)r * D : xs + (size_t)(r - TP) * D) : xprev + (size_t)r * D;
#pragma unroll
        for (int bj = 0; bj < 2; ++bj)
#pragma unroll
          for (int n = 0; n < 2; ++n) xv[m][bj][n] = *(const f32x4*)(xin + col0 + bj * 128 + n * 16);
      }
#pragma unroll
      for (int m = 0; m < 4; ++m) {
        float* yo = y + (size_t)(row0 + ai * 128 + m * 16) * D;
#pragma unroll
        for (int bj = 0; bj < 2; ++bj)
#pragma unroll
          for (int n = 0; n < 2; ++n) *(f32x4*)(yo + col0 + bj * 128 + n * 16) = xv[m][bj][n] + acc[ai][bj][m][n];
      }
    }
  }
};

struct ChunkGeo { int sq, c, b, h, row0, L, nch; bool sample; };
DI ChunkGeo chunk_geo(int ck) {
  ChunkGeo g;
  if (ck < NSEQ_P * NCH_P) { g.sq = ck / NCH_P; g.c = ck % NCH_P; g.b = g.sq / NH; g.h = g.sq % NH; g.row0 = g.b * SEQ + g.c * 64; g.L = 64; g.nch = NCH_P; g.sample = false; }
  else { const int s = ck - NSEQ_P * NCH_P; g.sq = NSEQ_P + s; g.c = 0; g.b = s / NH; g.h = s % NH; g.row0 = TP + g.b * DS; g.L = DS; g.nch = 1; g.sample = true; }
  return g;
}
DI int seq_pos0(const ChunkGeo& g) { return g.sample ? PAST : g.c * 64; }
DI float ret_log2gamma(int h) { return log2f(1.0f - exp2f(-5.0f - (float)h)); }
DI float wave_prefix_sum(float v, int lane) {
#pragma unroll
  for (int o = 1; o < 64; o <<= 1) { const float t = wshfl_up(v, o, lane); if (lane >= o) v += t; }
  return v;
}
DI float wave_prefix_max(float v, int lane) {
#pragma unroll
  for (int o = 1; o < 64; o <<= 1) { const float t = wshfl_up(v, o, lane); if (lane >= o) v = fmaxf(v, t); }
  return v;
}
DI void rotary_frags(bf16x8 (&f)[8], const float* rope_pos, int h) {
#pragma unroll
  for (int s = 0; s < 4; ++s) {
    float x1[8], x2[8]; unpack8(__builtin_bit_cast(u32x4, f[s]), x1); unpack8(__builtin_bit_cast(u32x4, f[s + 4]), x2);
    const float* cs = rope_pos + 2 * (16 * s + 8 * h);
    float o1[8], o2[8];
#pragma unroll
    for (int j = 0; j < 8; ++j) { const float co = cs[2 * j], si = cs[2 * j + 1]; o1[j] = x1[j] * co - x2[j] * si; o2[j] = x1[j] * si + x2[j] * co; }
    f[s] = pack8(o1[0], o1[1], o1[2], o1[3], o1[4], o1[5], o1[6], o1[7]);
    f[s + 4] = pack8(o2[0], o2[1], o2[2], o2[3], o2[4], o2[5], o2[6], o2[7]);
  }
}
DI bf16x8 tr_frag(const LAS unsigned char* tile, int stride, int row_lo, int row_hi, int col0, int lane) {
  const int q = (lane & 15) >> 2, p = lane & 3, blk = (lane >> 4) & 1;
  const int cbyte = (col0 + 16 * blk + 4 * p) * 2;
  const s16x4 lo = ds_tr16(tile + (row_lo + q) * stride + cbyte);
  const s16x4 hi = ds_tr16(tile + (row_hi + q) * stride + cbyte);
  return (bf16x8){lo[0], lo[1], lo[2], lo[3], hi[0], hi[1], hi[2], hi[3]};
}

constexpr int OT_STRIDE = 132;
DI void o_to_lds(const f32x16* acc, LAS float* tile, int r, int h) {
#pragma unroll
  for (int i = 0; i < 16; ++i)
#pragma unroll
    for (int cc = 0; cc < 4; ++cc) tile[crow(i, h) * OT_STRIDE + 32 * cc + r] = acc[cc][i];
}
DI void conv_pass(const Ctx& c, int l, const LAS float* cw, int s0, int t0, int nt, bool sample, int b, const float (&bias)[8], const float (&lg)[8], const float (&lb)[8]) {
  const bf16_t* P = (const bf16_t*)(c.ws + WS_P);
  bf16_t* YC = (bf16_t*)(c.ws + WS_YCAT);
  const int lane = c.lane, c0 = 8 * lane;
  float acc[8][8];
#pragma unroll
  for (int t = 0; t < 8; ++t)
#pragma unroll
    for (int j = 0; j < 8; ++j) acc[t][j] = bias[j];
  const int nrows = nt + 30;
#define CONV_ROW(idx) (*(const u32x4*)(P + PIX(s0 + ((t0 - 30 + (idx)) < 0 ? 0 : ((t0 - 30 + (idx)) > t0 + nt - 1 ? t0 + nt - 1 : (t0 - 30 + (idx)))), CB_UD) + c0))
  u32x4 p0 = CONV_ROW(0), p1 = CONV_ROW(1), p2 = CONV_ROW(2), p3 = CONV_ROW(3), p4 = CONV_ROW(4), p5 = CONV_ROW(5);
#pragma unroll 1
  for (int jj = 0; jj < nrows; ++jj) {
    const u32x4 cur = p0; p0 = p1; p1 = p2; p2 = p3; p3 = p4; p4 = p5; p5 = CONV_ROW(jj + 6);
    const int rr = t0 - 30 + jj;
    float glu[8];
    if (rr >= 0) {
      unpack8(cur, glu);
    } else if (sample) {
      const float* hp = c.in[IN_CONV] + (((size_t)l * DB + b) * 30 + (30 + rr)) * W + c0;
      const f32x4 a = *(const f32x4*)hp, bb = *(const f32x4*)(hp + 4);
      glu[0] = a.x; glu[1] = a.y; glu[2] = a.z; glu[3] = a.w; glu[4] = bb.x; glu[5] = bb.y; glu[6] = bb.z; glu[7] = bb.w;
    } else {
#pragma unroll
      for (int j = 0; j < 8; ++j) glu[j] = 0.f;
    }
    if (sample) {
      const int xi = 30 + rr;
      if (xi >= 16 && (rr >= t0 || (rr < 0 && t0 == 0))) { float* o = c.out + O_SCONV + (((size_t)l * DB + b) * 30 + (xi - 16)) * W + c0;
        *(f32x4*)o = (f32x4){glu[0], glu[1], glu[2], glu[3]}; *(f32x4*)(o + 4) = (f32x4){glu[4], glu[5], glu[6], glu[7]}; }
    } else if (rr >= t0 && rr >= SEQ - 30) {
      float* o = c.out + O_PCONV + (((size_t)l * NBATCH + b) * 30 + (rr - (SEQ - 30))) * W + c0;
      *(f32x4*)o = (f32x4){glu[0], glu[1], glu[2], glu[3]}; *(f32x4*)(o + 4) = (f32x4){glu[4], glu[5], glu[6], glu[7]};
    }
#pragma unroll
    for (int t = 0; t < 8; ++t) {
      const int j = jj - t;
      if (j >= 0 && j <= 30 && t < nt) {
        const f32x4 w0 = *(const LAS f32x4*)(cw + j * W + 4 * lane), w1 = *(const LAS f32x4*)(cw + j * W + 256 + 4 * lane);
        acc[t][0] += w0.x * glu[0]; acc[t][1] += w0.y * glu[1]; acc[t][2] += w0.z * glu[2]; acc[t][3] += w0.w * glu[3];
        acc[t][4] += w1.x * glu[4]; acc[t][5] += w1.y * glu[5]; acc[t][6] += w1.z * glu[6]; acc[t][7] += w1.w * glu[7];
      }
    }
  }
#undef CONV_ROW
#pragma unroll
  for (int t = 0; t < 8; ++t) {
    if (t < nt) {
      float s1 = 0.f;
#pragma unroll
      for (int j = 0; j < 8; ++j) s1 += acc[t][j];
      const float mean = wave_sum(s1, lane) * (1.0f / W);
      float s2 = 0.f;
#pragma unroll
      for (int j = 0; j < 8; ++j) { const float d = acc[t][j] - mean; s2 += d * d; }
      const float rstd = 1.0f / sqrtf(wave_sum(s2, lane) * (1.0f / W) + 1e-5f);
      const int r = s0 + t0 + t;
      float zd[8]; unpack8(*(const u32x4*)(P + PIX(r, CB_ZD) + c0), zd);
      float o[8];
#pragma unroll
      for (int j = 0; j < 8; ++j) o[j] = silu_f((acc[t][j] - mean) * rstd * lg[j] + lb[j]) * silu_f(zd[j]);
      u32x4 w; w.x = pk2(o[0], o[1]); w.y = pk2(o[2], o[3]); w.z = pk2(o[4], o[5]); w.w = pk2(o[6], o[7]);
      *(u32x4*)(YC + (size_t)r * D + 3 * W + c0) = w;
    }
  }
}
DI void phase_conv(const Ctx& c, int l) {
  LAS float* cw = (LAS float*)c.lds;
  const float* cwg = c.in[IN_CWT] + (size_t)l * CW * W;
  for (int i = c.tid; i < CW * W; i += NTHREADS) { const int j = i / W, ch = i % W; cw[j * W + ((ch >> 2) & 1) * 256 + (ch >> 3) * 4 + (ch & 3)] = cwg[i]; }
  __syncthreads();
  const int c0 = 8 * c.lane;
  const int gwv = c.bid * NWAVES + c.wave, NGW = c.G * NWAVES;
  float bias[8], lg[8], lb[8];
#pragma unroll
  for (int j = 0; j < 8; ++j) { bias[j] = c.in[IN_CB][l * W + c0 + j]; lg[j] = c.in[IN_LNG][l * W + c0 + j]; lb[j] = c.in[IN_LNB][l * W + c0 + j]; }
  constexpr int NPP = TP / 8;
  for (int p0 = 2 * gwv; p0 < NPP; p0 += 2 * NGW)
    for (int p = p0; p < p0 + 2 && p < NPP; ++p) { const int b = p / (SEQ / 8), t0 = (p % (SEQ / 8)) * 8; conv_pass(c, l, cw, b * SEQ, t0, 8, false, b, bias, lg, lb); }
  for (int q = NGW - 1 - gwv; q < DB * (DS / 2); q += NGW) { const int b = q / (DS / 2), t0 = (q % (DS / 2)) * 2; conv_pass(c, l, cw, TP + b * DS, t0, 2, true, b, bias, lg, lb); }
  __syncthreads();
}

constexpr int NUP = NSEQ_P * (SEQ / 32), NUA = NUP + NSEQ_S;
constexpr int NLONGW = (NSEQ_P * 129 + NSEQ_P * 128 + 1) / 2;
constexpr float SB_C2 = 0.08838834764831845f * 1.4426950408889634f;
constexpr float SB_RSTOP = 140.0f;
DI void attn_unit(const Ctx& c, int l, int u) {
  int lane_ = c.lane; OPAQUE_V(lane_);
  const int lane = lane_, r = lane & 31, h = lane >> 5;
  const bf16_t* P = (const bf16_t*)(c.ws + WS_P);
  int b, head, qrow0, qpos0, nq, kstart; bool sample;
  if (u < NUP) { const int sq = u / (SEQ / 32), qb = u % (SEQ / 32); b = sq / NH; head = sq % NH; qrow0 = b * SEQ + qb * 32; qpos0 = qb * 32; nq = 32; kstart = qb * 32; sample = false; }
  else { const int s = u - NUP; b = s / NH; head = s % NH; qrow0 = TP + b * DS; qpos0 = PAST; nq = DS; kstart = PAST; sample = true; }
  const int qrow = qrow0 + (r < nq ? r : nq - 1);
  const int qpos = qpos0 + r;
  bf16x8 qf[8];
#pragma unroll
  for (int s = 0; s < 8; ++s) qf[s] = *(const bf16x8*)(P + PIX(qrow, CB_QA) + head * HD + 16 * s + 8 * h);
  f32x16 o[4];
#pragma unroll
  for (int cc = 0; cc < 4; ++cc)
#pragma unroll
    for (int i = 0; i < 16; ++i) o[cc][i] = 0.f;
  float R = 0.f;
  LAS unsigned char* vt = c.scr;
  const float* ck = c.in[IN_CK]; const float* cv = c.in[IN_CV];
  for (int k0 = kstart; k0 >= 0; k0 -= 32) {
    const bool from_cache = sample && k0 < PAST;
    bf16x8 kf[8];
    if (!from_cache) {
      const int krow = sample ? TP + b * DS + (r < DS ? r : DS - 1) : b * SEQ + k0 + r;
#pragma unroll
      for (int s = 0; s < 8; ++s) kf[s] = *(const bf16x8*)(P + PIX(krow, CB_KA) + head * HD + 16 * s + 8 * h);
#pragma unroll
      for (int i = 0; i < 8; ++i) { const int n = lane + 64 * i, vr = n >> 4, ch = n & 15;
        const int vrow = sample ? TP + b * DS + (vr < DS ? vr : DS - 1) : b * SEQ + k0 + vr;
        *(LAS u32x4*)(vt + vr * TS272 + ch * 16) = *(const u32x4*)(P + PIX(vrow, CB_VA) + head * HD + ch * 8); }
    } else {
      const float* kp = ck + ((((size_t)l * DB + b) * PAST + (k0 + r)) * NH + head) * HD;
#pragma unroll
      for (int s = 0; s < 8; ++s) { const f32x4 a = *(const f32x4*)(kp + 16 * s + 8 * h), bb = *(const f32x4*)(kp + 16 * s + 8 * h + 4); kf[s] = pack8(a.x, a.y, a.z, a.w, bb.x, bb.y, bb.z, bb.w); }
#pragma unroll
      for (int i = 0; i < 8; ++i) { const int n = lane + 64 * i, vr = n >> 4, ch = n & 15;
        const float* vp = cv + ((((size_t)l * DB + b) * PAST + (k0 + vr)) * NH + head) * HD + ch * 8;
        const f32x4 a = *(const f32x4*)vp, bb = *(const f32x4*)(vp + 4);
        *(LAS bf16x8*)(vt + vr * TS272 + ch * 16) = pack8(a.x, a.y, a.z, a.w, bb.x, bb.y, bb.z, bb.w); }
    }
    f32x16 sacc;
#pragma unroll
    for (int i = 0; i < 16; ++i) sacc[i] = 0.f;
#pragma unroll
    for (int s = 0; s < 8; ++s) sacc = mfma32(kf[s], qf[s], sacc);
    float z2[16], sp[16];
#pragma unroll
    for (int i = 0; i < 16; ++i) {
      const bool ok = (k0 + crow(i, h)) < qpos;
      z2[i] = fminf(sacc[i] * SB_C2, 126.0f);
      sp[i] = ok ? lg2(1.0f + ex2(z2[i])) : 0.0f;
      z2[i] = ok ? z2[i] : -1e30f;
    }
    float gs[4], pg[4];
#pragma unroll
    for (int j = 0; j < 4; ++j) { gs[j] = (sp[4 * j] + sp[4 * j + 1]) + (sp[4 * j + 2] + sp[4 * j + 3]); pg[j] = wshfl_xor(gs[j], 32, lane); }
    float after = 0.f, wgt[16];
#pragma unroll
    for (int j = 3; j >= 0; --j) {
      float run = after + (h == 0 ? pg[j] : 0.f) + R;
#pragma unroll
      for (int ii = 3; ii >= 0; --ii) { run += sp[4 * j + ii]; wgt[4 * j + ii] = ex2(z2[4 * j + ii] - run); }
      after += (h == 0) ? (gs[j] + pg[j]) : (pg[j] + gs[j]);
    }
    R += after;
    const bf16x8 pf0 = pack8(wgt[0], wgt[1], wgt[2], wgt[3], wgt[4], wgt[5], wgt[6], wgt[7]);
    const bf16x8 pf1 = pack8(wgt[8], wgt[9], wgt[10], wgt[11], wgt[12], wgt[13], wgt[14], wgt[15]);
    LDS_WAIT();
#pragma unroll
    for (int cc = 0; cc < 4; ++cc) {
      const bf16x8 v0 = tr_frag(vt, TS272, 4 * h, 8 + 4 * h, 32 * cc, lane);
      const bf16x8 v1 = tr_frag(vt, TS272, 16 + 4 * h, 24 + 4 * h, 32 * cc, lane);
      o[cc] = mfma32(pf0, v0, o[cc]);
      o[cc] = mfma32(pf1, v1, o[cc]);
    }
    const float rmin = wave_min(r < nq ? R : 1e30f, lane);
    if (rmin >= SB_RSTOP) break;
  }
  bf16_t* YC = (bf16_t*)(c.ws + WS_YCAT);
  LAS float* ot = (LAS float*)c.scr;
  LDS_WAIT();
  o_to_lds(o, ot, r, h);
  LDS_WAIT();
#pragma unroll
  for (int i = 0; i < 8; ++i) {
    const int q = lane + 64 * i, t = q >> 4, ch = q & 15;
    if (t < nq) {
      const size_t row = (size_t)(qrow0 + t);
      const int col = head * HD + 8 * ch;
      const f32x4 x0 = *(const LAS f32x4*)(ot + t * OT_STRIDE + 8 * ch), x1 = *(const LAS f32x4*)(ot + t * OT_STRIDE + 8 * ch + 4);
      float za[8]; unpack8(*(const u32x4*)(P + PIX(row, CB_ZA) + col), za);
      u32x4 w; w.x = pk2(x0.x * silu_f(za[0]), x0.y * silu_f(za[1])); w.y = pk2(x0.z * silu_f(za[2]), x0.w * silu_f(za[3]));
      w.z = pk2(x1.x * silu_f(za[4]), x1.y * silu_f(za[5])); w.w = pk2(x1.z * silu_f(za[6]), x1.w * silu_f(za[7]));
      *(u32x4*)(YC + row * D + col) = w;
    }
  }
  LDS_WAIT();
}

DI bf16_t* st_ptr(const Ctx& c, int br, int ck) { return (bf16_t*)(c.ws + WS_ST + ((size_t)br * NCHUNK + ck) * ST_BYTES); }
DI bf16_t* st2_ptr(const Ctx& c, int br, int ck) { return (bf16_t*)(c.ws + WS_ST2 + ((size_t)br * NCHUNK + ck) * ST_BYTES); }
template <int BR> DI void scan_local_unit(const Ctx& c, int l, int ck, int eb) {
  int lane_ = c.lane; OPAQUE_V(lane_);
  const int lane = lane_, r = lane & 31, h = lane >> 5;
  const ChunkGeo g = chunk_geo(ck);
  const bf16_t* P = (const bf16_t*)(c.ws + WS_P);
  LAS unsigned char* kt = c.scr;
  LAS unsigned char* vtl = c.scr + 64 * 144;
  LAS float* wtab = (LAS float*)(c.scr + 64 * 144 + 64 * 80);
  constexpr int KS = 144, VS = 80;
  const int kcb = BR == 0 ? CB_KB : CB_KC, vcb = BR == 0 ? CB_VB : CB_VC;
  const float* rope = (const float*)(c.ws + WS_ROPE);
  u32x4 kx1[8], kx2[8], vv[4];
#pragma unroll
  for (int i = 0; i < 8; ++i) {
    const int n = lane + 64 * i, s = n >> 3, ch = n & 7;
    const bf16_t* kp = P + PIX(g.row0 + (s < g.L ? s : g.L - 1), kcb) + g.h * HD;
    kx1[i] = *(const u32x4*)(kp + ch * 8); kx2[i] = *(const u32x4*)(kp + 64 + ch * 8);
  }
#pragma unroll
  for (int i = 0; i < 4; ++i) {
    const int n = lane + 64 * i, s = n >> 2, ch = n & 3;
    const int row = g.row0 + (s < g.L ? s : g.L - 1);
    if (eb < 4) vv[i] = *(const u32x4*)(P + PIX(row, vcb) + g.h * HD + eb * 32 + ch * 8);
    else vv[i] = (u32x4){ch == 0 ? 0x00003F80u : 0u, 0u, 0u, 0u};
  }
  {
    const int s = lane; float w;
    if (BR == 0) {
      const float* LFp = (const float*)(c.ws + WS_LF); const float* IGp = (const float*)(c.ws + WS_IG);
      const float lf = s < g.L ? LFp[(size_t)(g.row0 + s) * 4 + g.h] : 0.f;
      const float ig = s < g.L ? IGp[(size_t)(g.row0 + s) * 4 + g.h] : -1e30f;
      const float bcum = wave_prefix_sum(lf, lane);
      const float Bc = wshfl(bcum, 63);
      const float gg = Bc - bcum + ig;
      const float G = wave_max(gg, lane);
      w = s < g.L ? __expf(gg - G) : 0.f;
      if (eb == 0 && lane == 0) { ((float*)(c.ws + WS_SCB))[ck] = Bc; ((float*)(c.ws + WS_SCG))[ck] = G; }
    } else {
      w = s < g.L ? exp2f(ret_log2gamma(g.h) * (float)(g.L - 1 - s)) : 0.f;
    }
    wtab[s] = w * 0.08838834764831845f;
  }
#pragma unroll
  for (int i = 0; i < 4; ++i) { const int n = lane + 64 * i, s = n >> 2, ch = n & 3; *(LAS u32x4*)(vtl + s * VS + ch * 16) = vv[i]; }
  LDS_WAIT();
  f32x16 acc[4];
#pragma unroll
  for (int cc = 0; cc < 4; ++cc)
#pragma unroll
    for (int i = 0; i < 16; ++i) acc[cc][i] = 0.f;
  bf16x8 af[4];
#pragma unroll
  for (int ks = 0; ks < 4; ++ks) af[ks] = tr_frag(vtl, VS, 16 * ks + 8 * h, 16 * ks + 8 * h + 4, 0, lane);
#pragma unroll
  for (int dh = 0; dh < 2; ++dh) {
#pragma unroll
    for (int i = 0; i < 8; ++i) {
      const int n = lane + 64 * i, s = n >> 3, ch = n & 7;
      float o[8];
      if (BR == 0) { unpack8(dh == 0 ? kx1[i] : kx2[i], o); }
      else {
        float x1[8], x2[8]; unpack8(kx1[i], x1); unpack8(kx2[i], x2);
        const float* cs = rope + ((size_t)(seq_pos0(g) + (s < g.L ? s : g.L - 1)) * 64 + ch * 8) * 2;
#pragma unroll
        for (int j = 0; j < 8; ++j) { const float co = cs[2 * j], si = cs[2 * j + 1]; o[j] = dh == 0 ? x1[j] * co - x2[j] * si : x1[j] * si + x2[j] * co; }
      }
      const float w = wtab[s];
      *(LAS bf16x8*)(kt + s * KS + ch * 16) = pack8(o[0] * w, o[1] * w, o[2] * w, o[3] * w, o[4] * w, o[5] * w, o[6] * w, o[7] * w);
      if (BR == 1 && (i & 1)) asm volatile("" ::: "memory");
    }
    LDS_WAIT();
#pragma unroll
    for (int ks = 0; ks < 4; ++ks)
#pragma unroll
      for (int cc = 0; cc < 2; ++cc) {
        const bf16x8 bfr = tr_frag(kt, KS, 16 * ks + 8 * h, 16 * ks + 8 * h + 4, 32 * cc, lane);
        acc[2 * dh + cc] = mfma32(af[ks], bfr, acc[2 * dh + cc]);
      }
    LDS_WAIT();
  }
  LAS float* ot = (LAS float*)c.scr;
  o_to_lds(acc, ot, r, h);
  LDS_WAIT();
  bf16_t* st = st_ptr(c, BR, ck);
#pragma unroll
  for (int i = 0; i < 8; ++i) {
    const int q = lane + 64 * i, t = q >> 4, ch = q & 15, e = 32 * eb + t;
    if (e <= 128) {
      const f32x4 x0 = *(const LAS f32x4*)(ot + t * OT_STRIDE + 8 * ch), x1 = *(const LAS f32x4*)(ot + t * OT_STRIDE + 8 * ch + 4);
      u32x4 w; w.x = pk2(x0.x, x0.y); w.y = pk2(x0.z, x0.w); w.z = pk2(x1.x, x1.y); w.w = pk2(x1.z, x1.w);
      *(u32x4*)(st + (size_t)e * HD + 8 * ch) = w;
    }
  }
  LDS_WAIT();
}

DI void scan_prop_item(const Ctx& c, int l, int it) {
  constexpr int NLP = NSEQ_P * 129 + NSEQ_P * 128, NTOT = NSEQ * 129 + NSEQ * 128;
  const bool live = it < NTOT;
  if (!live) it = NTOT - 1;
  int br, sq, e;
  if (it < NLP) { if (it < NSEQ_P * 129) { br = 0; sq = it / 129; e = it % 129; } else { const int j = it - NSEQ_P * 129; br = 1; sq = j / 128; e = j % 128; } }
  else { const int j = it - NLP; if (j < NSEQ_S * 129) { br = 0; sq = NSEQ_P + j / 129; e = j % 129; } else { const int k = j - NSEQ_S * 129; br = 1; sq = NSEQ_P + k / 128; e = k % 128; } }
  const int d0 = 4 * (c.lane & 31);
  const bool sample = sq >= NSEQ_P;
  const int b = sample ? (sq - NSEQ_P) / NH : sq / NH, h = sample ? (sq - NSEQ_P) % NH : sq % NH;
  const int nch = sample ? 1 : NCH_P, ck0 = sample ? NSEQ_P * NCH_P + (sq - NSEQ_P) : sq * NCH_P;
  const int L = sample ? DS : 64;
  float s[4] = {0.f, 0.f, 0.f, 0.f}; float m = 0.f;
  if (sample) {
    if (br == 0) {
      if (e < 128) { const float* C0 = c.in[IN_MC] + (((size_t)l * DB + b) * NH + h) * HD * HD;
#pragma unroll
        for (int j = 0; j < 4; ++j) s[j] = C0[(size_t)(d0 + j) * HD + e]; }
      else { const float* n0 = c.in[IN_MN] + (((size_t)l * DB + b) * NH + h) * HD;
#pragma unroll
        for (int j = 0; j < 4; ++j) s[j] = n0[d0 + j]; }
      m = c.in[IN_MM][((size_t)l * DB + b) * NH + h];
    } else { const float* S0 = c.in[IN_RS] + (((size_t)l * DB + b) * NH + h) * HD * HD;
#pragma unroll
      for (int j = 0; j < 4; ++j) s[j] = S0[(size_t)(d0 + j) * HD + e]; }
  }
  const float* SCB = (const float*)(c.ws + WS_SCB); const float* SCG = (const float*)(c.ws + WS_SCG); float* MCp = (float*)(c.ws + WS_MC);
  const float cdec = br == 1 ? exp2f(ret_log2gamma(h) * (float)L) : 0.f;
  constexpr int PB = 32;
  const int hl = c.lane & 31, hbase = c.lane & 32;
  LAS float* tab = (LAS float*)c.scr + 2 * hbase;
  for (int ci0 = 0; ci0 < nch; ci0 += PB) {
    u32x2 dv[PB];
#pragma unroll
    for (int j = 0; j < PB; ++j) {
      const int ck = ck0 + (ci0 + j < nch ? ci0 + j : nch - 1);
      dv[j] = *(const u32x2*)(st_ptr(c, br, ck) + (size_t)e * HD + d0);
    }
    if (br == 0) {
      const bool okc = ci0 + hl < nch;
      const int ckl = ck0 + (okc ? ci0 + hl : nch - 1);
      const float Bl = okc ? SCB[ckl] : 0.f, Gl = okc ? SCG[ckl] : -1e30f;
      float BB = Bl, GG = Gl;
#pragma unroll
      for (int o = 1; o < 32; o <<= 1) {
        const float pb = wshfl(BB, hbase + (hl >= o ? hl - o : hl)), pg = wshfl(GG, hbase + (hl >= o ? hl - o : hl));
        if (hl >= o) { GG = fmaxf(pg + BB, GG); BB = pb + BB; }
      }
      const float m_out = fmaxf(m + BB, GG);
      float m_in = wshfl(m_out, hbase + (hl > 0 ? hl - 1 : 0)); if (hl == 0) m_in = m;
      tab[2 * hl] = __expf(m_in + Bl - m_out); tab[2 * hl + 1] = __expf(Gl - m_out);
      if (live && okc && e == 0) MCp[ckl] = m_in;
      m = wshfl(m_out, hbase + 31);
      LDS_WAIT();
    }
#pragma unroll
    for (int j = 0; j < PB; ++j) {
      if (ci0 + j < nch) {
        const int ck = ck0 + ci0 + j;
        const float q0 = bits_f(dv[j].x << 16), q1 = bits_f(dv[j].x & 0xffff0000u), q2 = bits_f(dv[j].y << 16), q3 = bits_f(dv[j].y & 0xffff0000u);
        if (live) *(u32x2*)(st2_ptr(c, br, ck) + (size_t)e * HD + d0) = (u32x2){pk2(s[0], s[1]), pk2(s[2], s[3])};
        if (br == 0) { const float dec = tab[2 * j], inj = tab[2 * j + 1];
          s[0] = dec * s[0] + inj * q0; s[1] = dec * s[1] + inj * q1; s[2] = dec * s[2] + inj * q2; s[3] = dec * s[3] + inj * q3; }
        else { s[0] = cdec * s[0] + q0; s[1] = cdec * s[1] + q1; s[2] = cdec * s[2] + q2; s[3] = cdec * s[3] + q3; }
      }
    }
    LDS_WAIT();
  }
  if (!live) return;
  if (br == 0) {
    if (e < 128) { float* o = c.out + (sample ? O_SC + (((size_t)l * DB + b) * NH + h) * HD * HD : O_PC + (((size_t)l * NBATCH + b) * NH + h) * HD * HD);
#pragma unroll
      for (int j = 0; j < 4; ++j) o[(size_t)(d0 + j) * HD + e] = s[j]; }
    else { float* o = c.out + (sample ? O_SN + (((size_t)l * DB + b) * NH + h) * HD : O_PN + (((size_t)l * NBATCH + b) * NH + h) * HD); *(f32x4*)(o + d0) = (f32x4){s[0], s[1], s[2], s[3]}; }
    if (e == 0 && (c.lane & 31) == 0) c.out[(sample ? O_SM + ((size_t)l * DB + b) * NH + h : O_PM + ((size_t)l * NBATCH + b) * NH + h)] = m;
  } else {
    float* o = c.out + (sample ? O_SS + (((size_t)l * DB + b) * NH + h) * HD * HD : O_PS + (((size_t)l * NBATCH + b) * NH + h) * HD * HD);
#pragma unroll
    for (int j = 0; j < 4; ++j) o[(size_t)(d0 + j) * HD + e] = s[j];
  }
}

template <int BR> DI void scan_apply_unit(const Ctx& c, int l, int ck, int th) {
  int lane_ = c.lane; OPAQUE_V(lane_);
  const int lane = lane_, r = lane & 31, h = lane >> 5;
  const ChunkGeo g = chunk_geo(ck);
  if (32 * th >= g.L) return;
  const bf16_t* P = (const bf16_t*)(c.ws + WS_P);
  LAS unsigned char* vt = c.scr;
  LAS float* tb = (LAS float*)(c.scr + 64 * TS272);
  LAS float* t_a = tb; LAS float* t_w = tb + 64; LAS float* t_0 = tb + 128; LAS float* t_1 = tb + 160; LAS float* t_2 = tb + 192;
  const int qcb = BR == 0 ? CB_QB : CB_QC, kcb = BR == 0 ? CB_KB : CB_KC, vcb = BR == 0 ? CB_VB : CB_VC;
  const float* rope = (const float*)(c.ws + WS_ROPE);
  const int pos0 = seq_pos0(g);
  const float l2g = ret_log2gamma(g.h);
  const int tq = 32 * th + r, tqc = tq < g.L ? tq : g.L - 1;
  bf16x8 qf[8];
  u32x4 vreg[16];
#pragma unroll
  for (int s = 0; s < 8; ++s) qf[s] = *(const bf16x8*)(P + PIX(g.row0 + tqc, qcb) + g.h * HD + 16 * s + 8 * h);
#pragma unroll
  for (int i = 0; i < 16; ++i) { const int n = lane + 64 * i, s = n >> 4, ch = n & 15; const int row = g.row0 + (s < g.L ? s : g.L - 1);
    vreg[i] = *(const u32x4*)(P + PIX(row, vcb) + g.h * HD + ch * 8); }
  float Mt = 0.f;
  {
    const int s = lane;
    if (BR == 0) {
      const float* LFp = (const float*)(c.ws + WS_LF); const float* IGp = (const float*)(c.ws + WS_IG);
      const float lf = s < g.L ? LFp[(size_t)(g.row0 + s) * 4 + g.h] : 0.f;
      const float ig = s < g.L ? IGp[(size_t)(g.row0 + s) * 4 + g.h] : -1e30f;
      const float bcum = wave_prefix_sum(lf, lane);
      const float a = ig - bcum;
      const float pm = wave_prefix_max(a, lane);
      const float mc = ((const float*)(c.ws + WS_MC))[ck];
      const float M = fmaxf(mc, pm);
      t_a[s] = a;
      if ((s >> 5) == th) { t_0[s & 31] = __expf(mc - M); t_1[s & 31] = __expf(-(bcum + M)); }
      Mt = wshfl(M, 32 * th + r);
    } else {
      t_w[s] = exp2f(-l2g * (float)s);
      if ((s >> 5) == th) t_0[s & 31] = exp2f(l2g * (float)(s + 1));
    }
  }
  if (BR == 1) rotary_frags(qf, rope + (size_t)(pos0 + tqc) * 128, h);
#pragma unroll
  for (int i = 0; i < 16; ++i) { const int n = lane + 64 * i, s = n >> 4, ch = n & 15; *(LAS u32x4*)(vt + s * TS272 + ch * 16) = vreg[i]; }
  LDS_WAIT();
  constexpr int NB = BR == 0 ? 5 : 4;
  f32x16 acc[NB];
  const bf16_t* st = st2_ptr(c, BR, ck);
#pragma unroll
  for (int cc = 0; cc < NB; ++cc) {
#pragma unroll
    for (int i = 0; i < 16; ++i) acc[cc][i] = 0.f;
#pragma unroll
    for (int s = 0; s < 8; ++s) { const bf16x8 bfr = *(const bf16x8*)(st + (size_t)(32 * cc + r) * HD + 16 * s + 8 * h); acc[cc] = mfma32(qf[s], bfr, acc[cc]); }
  }
  {
    float sc[16];
#pragma unroll
    for (int i = 0; i < 16; ++i) sc[i] = t_0[crow(i, h)];
#pragma unroll
    for (int cc = 0; cc < NB; ++cc)
#pragma unroll
      for (int i = 0; i < 16; ++i) acc[cc][i] *= sc[i];
  }
  const float gt = BR == 1 ? exp2f(l2g * (float)tq) : 0.f;
  for (int kb = 0; kb <= th; ++kb) {
    bf16x8 kf[8];
    const int sk = 32 * kb + r, skc = sk < g.L ? sk : g.L - 1;
#pragma unroll
    for (int s = 0; s < 8; ++s) kf[s] = *(const bf16x8*)(P + PIX(g.row0 + skc, kcb) + g.h * HD + 16 * s + 8 * h);
    if (BR == 1) rotary_frags(kf, rope + (size_t)(pos0 + skc) * 128, h);
    f32x16 sacc;
#pragma unroll
    for (int i = 0; i < 16; ++i) sacc[i] = 0.f;
#pragma unroll
    for (int s = 0; s < 8; ++s) sacc = mfma32(kf[s], qf[s], sacc);
    float wv[16];
#pragma unroll
    for (int i = 0; i < 16; ++i) {
      const int s = 32 * kb + crow(i, h);
      const bool ok = s <= tq && s < g.L;
      float w;
      if (BR == 0) w = __expf(fminf(t_a[s] - Mt, 0.f)) * sacc[i] * 0.08838834764831845f;
      else w = sacc[i] * 0.08838834764831845f * gt * t_w[s];
      wv[i] = ok ? w : 0.f;
    }
    const bf16x8 pf0 = pack8(wv[0], wv[1], wv[2], wv[3], wv[4], wv[5], wv[6], wv[7]);
    const bf16x8 pf1 = pack8(wv[8], wv[9], wv[10], wv[11], wv[12], wv[13], wv[14], wv[15]);
#pragma unroll
    for (int cc = 0; cc < 4; ++cc) {
      const bf16x8 v0 = tr_frag(vt, TS272, 32 * kb + 4 * h, 32 * kb + 8 + 4 * h, 32 * cc, lane);
      const bf16x8 v1 = tr_frag(vt, TS272, 32 * kb + 16 + 4 * h, 32 * kb + 24 + 4 * h, 32 * cc, lane);
      acc[cc] = mfma32(pf0, v0, acc[cc]);
      acc[cc] = mfma32(pf1, v1, acc[cc]);
    }
    if (BR == 0) {
      const bf16x8 ones = r == 0 ? (bf16x8){0x3F80, 0x3F80, 0x3F80, 0x3F80, 0x3F80, 0x3F80, 0x3F80, 0x3F80} : (bf16x8){0, 0, 0, 0, 0, 0, 0, 0};
      acc[NB - 1] = mfma32(pf0, ones, acc[NB - 1]);
      acc[NB - 1] = mfma32(pf1, ones, acc[NB - 1]);
    }
  }
  if (BR == 0) {
    if (r == 0) {
#pragma unroll
      for (int i = 0; i < 16; ++i) t_2[crow(i, h)] = acc[NB - 1][i];
    }
    LDS_WAIT();
#pragma unroll
    for (int i = 0; i < 16; ++i) {
      const int t = crow(i, h);
      const float dn = fmaxf(fabsf(t_2[t]), t_1[t]);
      const float inv = 1.0f / dn;
#pragma unroll
      for (int cc = 0; cc < 4; ++cc) acc[cc][i] *= inv;
    }
  }
  bf16_t* YC = (bf16_t*)(c.ws + WS_YCAT);
  LAS float* ot = (LAS float*)c.scr;
  LDS_WAIT();
  o_to_lds(acc, ot, r, h);
  LDS_WAIT();
  {
    const LAS float* rp = ot + r * OT_STRIDE + 64 * h;
    float s1 = 0.f, s2 = 0.f;
#pragma unroll
    for (int k = 0; k < 16; ++k) { const f32x4 x = *(const LAS f32x4*)(rp + 4 * k); s1 += (x.x + x.y) + (x.z + x.w); s2 += (x.x * x.x + x.y * x.y) + (x.z * x.z + x.w * x.w); }
    s1 += wshfl_xor(s1, 32, lane); s2 += wshfl_xor(s2, 32, lane);
    const float mean = s1 * (1.0f / HD), var = fmaxf(s2 * (1.0f / HD) - mean * mean, 0.f);
    if (h == 0) { t_0[r] = mean; t_1[r] = 1.0f / sqrtf(var + 1e-5f); }
  }
  LDS_WAIT();
#pragma unroll
  for (int i = 0; i < 8; ++i) {
    const int q = lane + 64 * i, t = q >> 4, ch = q & 15;
    if (32 * th + t < g.L) {
      const size_t row = (size_t)(g.row0 + 32 * th + t);
      const int col = g.h * HD + 8 * ch;
      const f32x4 x0 = *(const LAS f32x4*)(ot + t * OT_STRIDE + 8 * ch), x1 = *(const LAS f32x4*)(ot + t * OT_STRIDE + 8 * ch + 4);
      const float mean = t_0[t], rstd = t_1[t];
      float y[8] = {(x0.x - mean) * rstd, (x0.y - mean) * rstd, (x0.z - mean) * rstd, (x0.w - mean) * rstd, (x1.x - mean) * rstd, (x1.y - mean) * rstd, (x1.z - mean) * rstd, (x1.w - mean) * rstd};
      if (BR == 0) {
        float ob[8], zb[8]; unpack8(*(const u32x4*)(P + PIX(row, CB_OB) + col), ob); unpack8(*(const u32x4*)(P + PIX(row, CB_ZB) + col), zb);
#pragma unroll
        for (int j = 0; j < 8; ++j) y[j] *= sigmoid_f(ob[j]) * silu_f(zb[j]);
      } else {
        float zc[8]; unpack8(*(const u32x4*)(P + PIX(row, CB_ZC) + col), zc);
#pragma unroll
        for (int j = 0; j < 8; ++j) y[j] *= silu_f(zc[j]);
      }
      u32x4 w; w.x = pk2(y[0], y[1]); w.y = pk2(y[2], y[3]); w.z = pk2(y[4], y[5]); w.w = pk2(y[6], y[7]);
      *(u32x4*)(YC + row * D + (BR == 0 ? 1 : 2) * W + col) = w;
    }
  }
  LDS_WAIT();
}

template <int MODE> DI void sample_tail_gemm(const Ctx& c, int l, const bf16_t* Wt  , const bf16_t* Act  ) {
  int lane_ = c.lane; OPAQUE_V(lane_);
  const int lane = lane_, r = lane & 31, h = lane >> 5, wv = c.wave, tw = wv & 3, kh = wv >> 2;
  const bf16_t* P = (const bf16_t*)(c.ws + WS_P);
  constexpr int NTILE = (TS / 32) * (D / 32);
  LAS float* xch = (LAS float*)(c.lds) + tw * 1024;
  for (int tb = c.bid; tb * 4 < NTILE; tb += c.G) {
    const int tile = tb * 4 + tw, tt = tile / (D / 32), nn = tile % (D / 32);
    const int t0 = 32 * tt, n0 = 32 * nn;
    const bf16_t* ap = Wt + (size_t)(n0 + r) * D + kh * 1024 + 8 * h;
    const bf16_t* bp = Act + (size_t)(t0 + r) * D + kh * 1024 + 8 * h;
    f32x16 acc;
#pragma unroll
    for (int i = 0; i < 16; ++i) acc[i] = 0.f;
    const size_t grow = (size_t)(TP + t0 + r);
#pragma unroll 1
    for (int sg = 0; sg < 2; ++sg) {
#pragma unroll 1
      for (int k0 = 0; k0 < 32; k0 += 8) {
        bf16x8 af[8], bf[8];
#pragma unroll
        for (int q = 0; q < 8; ++q) { af[q] = *(const bf16x8*)(ap + (sg * 32 + k0 + q) * 16); bf[q] = *(const bf16x8*)(bp + (sg * 32 + k0 + q) * 16); }
#pragma unroll
        for (int q = 0; q < 8; ++q) acc = mfma32(af[q], bf[q], acc);
      }
      if (MODE == 0) {
        const int br = 2 * kh + sg;
#pragma unroll
        for (int g4 = 0; g4 < 4; ++g4) {
          const int n = n0 + 8 * g4 + 4 * h;
          const u32x2 ea = *(const u32x2*)(P + PIX(grow, CB_G0 + 4 * br + (n >> 9)) + (n & 511));
          float e0[4] = {bits_f(ea.x << 16), bits_f(ea.x & 0xffff0000u), bits_f(ea.y << 16), bits_f(ea.y & 0xffff0000u)};
          float sc[4];
          if (sg == 0) {
            const u32x2 eb = *(const u32x2*)(P + PIX(grow, CB_G0 + 4 * (br + 1) + (n >> 9)) + (n & 511));
            const float e1[4] = {bits_f(eb.x << 16), bits_f(eb.x & 0xffff0000u), bits_f(eb.y << 16), bits_f(eb.y & 0xffff0000u)};
#pragma unroll
            for (int j = 0; j < 4; ++j) sc[j] = e1[j] * frcp(e0[j]);
          } else {
#pragma unroll
            for (int j = 0; j < 4; ++j) sc[j] = frcp(e0[j]);
          }
#pragma unroll
          for (int j = 0; j < 4; ++j) acc[4 * g4 + j] *= sc[j];
        }
      }
    }
    if (kh == 1) {
#pragma unroll
      for (int i = 0; i < 16; ++i) xch[i * 64 + lane] = acc[i];
    }
    __syncthreads();
    if (kh == 0) {
#pragma unroll
      for (int i = 0; i < 16; ++i) acc[i] += xch[i * 64 + lane];
#pragma unroll
      for (int g4 = 0; g4 < 4; ++g4) {
        const int n = n0 + 8 * g4 + 4 * h;
        if (MODE == 0) {
          bf16_t* o = (bf16_t*)(c.ws + WS_MG) + grow * D + n;
          *(u32x2*)o = (u32x2){pk2(acc[4 * g4], acc[4 * g4 + 1]), pk2(acc[4 * g4 + 2], acc[4 * g4 + 3])};
        } else {
          const float* xin = (l == 0) ? c.in[IN_XS] + (size_t)(t0 + r) * D + n : c.out + O_Y + grow * D + n;
          const f32x4 xv = *(const f32x4*)xin;
          *(f32x4*)(c.out + O_Y + grow * D + n) = (f32x4){xv.x + acc[4 * g4], xv.y + acc[4 * g4 + 1], xv.z + acc[4 * g4 + 2], xv.w + acc[4 * g4 + 3]};
        }
      }
    }
    __syncthreads();
  }
}

DI void phase_final(const Ctx& c) {
  const float* fg = c.in[IN_FG];
  const int gwv = c.bid * NWAVES + c.wave, NGW = c.G * NWAVES, lane = c.lane;
  f32x4 gv[8];
#pragma unroll
  for (int j = 0; j < 8; ++j) gv[j] = *(const f32x4*)(fg + 256 * j + 4 * lane);
  for (int r = gwv; r < T; r += NGW) {
    float* xr = c.out + O_Y + (size_t)r * D;
    f32x4 v[8]; float ss = 0.f;
#pragma unroll
    for (int j = 0; j < 8; ++j) { v[j] = *(const f32x4*)(xr + 256 * j + 4 * lane); ss += (v[j].x * v[j].x + v[j].y * v[j].y) + (v[j].z * v[j].z + v[j].w * v[j].w); }
    const float rstd = 1.0f / sqrtf(wave_sum(ss, lane) * (1.0f / D) + 1e-6f);
#pragma unroll
    for (int j = 0; j < 8; ++j) *(f32x4*)(xr + 256 * j + 4 * lane) = v[j] * rstd * gv[j];
  }
}

constexpr int PH_PRO = 0, PH_PER_LAYER = 7, PH_FINAL = 1 + DEPTH * PH_PER_LAYER, PH_COUNT = PH_FINAL + 1;
constexpr int CW_BAR = 4096;

__global__ void __launch_bounds__(NTHREADS, 2) fwd(Args args) {
  DYN_LDS(lds);
  Ctx c;
  c.lds = lds; c.tid = threadIdx.x; c.lane = c.tid & 63; c.wave = rfl(c.tid >> 6); c.G = gridDim.x; c.bid = blockIdx.x;
  const int wave_s = c.wave; (void)wave_s;
  c.scr = lds + c.wave * WSCR;
#pragma unroll
  for (int i = 0; i < 20; ++i) c.in[i] = args.in[i];
  c.out = args.out; c.ws = args.ws;
  const int lo = args.ph_lo, hi = args.ph_hi;
#ifndef EMU
  if (c.tid < 16) ((LAS unsigned*)(lds + LDSCTL_OFF))[c.tid] = 0u;
  __syncthreads();
  XcdBarrier bar = xcd_barrier_post((unsigned*)(c.ws + WS_CTL) + CW_BAR, (volatile LAS unsigned*)(lds + LDSCTL_OFF));
#define GRID_BAR() xcd_barrier(bar)
#else
#define GRID_BAR() do {} while (0)
#endif
#ifndef PHMASK
#define PHMASK 0x1FF
#endif
#define KIND(kk) ((PHMASK >> (kk)) & 1)
#ifndef REP_NORM
#define REP_NORM 1
#endif
#ifndef REP_INPROJ
#define REP_INPROJ 1
#endif
#ifndef REP_MIX1
#define REP_MIX1 1
#endif
#ifndef REP_MIX3
#define REP_MIX3 1
#endif
#ifndef REP_MERGE
#define REP_MERGE 1
#endif
#ifdef EMU
#define LAUNDER() do {} while (0)
#else
#define LAUNDER() do { unsigned m_ = ~0u; int w_ = wave_s; asm volatile("" : "+s"(m_), "+s"(w_));   \
    c.lane = (int)__builtin_amdgcn_mbcnt_hi(m_, __builtin_amdgcn_mbcnt_lo(m_, 0u)); c.wave = w_; c.tid = w_ * 64 + c.lane; c.scr = lds + w_ * WSCR; } while (0)
#endif
#define IN(k) (lo <= (k) && (k) < hi)
#define SEAM(k) do { if (hi > (k) + 1) GRID_BAR(); } while (0)

  #ifndef REP_PRO
#define REP_PRO 1
#endif
  if (KIND(0) && IN(PH_PRO)) { _Pragma("unroll 1") for (int rp = 0; rp < REP_PRO; ++rp) { LAUNDER(); phase_prologue(c); } __syncthreads();   }

  for (int l = 0; l < DEPTH; ++l) {
    const int pb = 1 + l * PH_PER_LAYER;
    if (KIND(1) && IN(pb + 0)) { _Pragma("unroll 1") for (int rep = 0; rep < REP_NORM; ++rep) { LAUNDER(); phase_norm(c, l); SEAM(pb + 0); } }
    if (KIND(2) && IN(pb + 1)) _Pragma("unroll 1") for (int rep = 0; rep < REP_INPROJ; ++rep) { LAUNDER();
      pg8::Gemm g{(const bf16_t*)(c.ws + WS_HIN), (const bf16_t*)(c.ws + WS_WIN) + (size_t)l * NP * D, T, NP, D, D, D, 0, 0};
      pg8::StaticOrder S; S.init(T, NP, c.G, c.bid);
      EpiInproj E{(bf16_t*)(c.ws + WS_P), c.out, l};
      pg8::gemm_phase<EpiInproj, pg8::StaticOrder, true>(lds, g, S, E, c.tid);
      SEAM(pb + 1);
    }
    if (KIND(3) && IN(pb + 2)) _Pragma("unroll 1") for (int rep = 0; rep < REP_MIX1; ++rep) { LAUNDER();
#ifndef SUBMASK
#define SUBMASK 15
#endif
#ifndef REP_CONV
#define REP_CONV 1
#endif
#ifndef REP_ATTN
#define REP_ATTN 1
#endif
#ifndef REP_LOC
#define REP_LOC 1
#endif
      _Pragma("unroll 1") for (int rp = 0; rp < REP_CONV; ++rp) phase_conv(c, l);
      const int gwv = c.bid * NWAVES + c.wave, NGW = c.G * NWAVES;
      { const int NF = NGW > NLONGW ? NGW - NLONGW : 0, ND = NF < NUA / 2 ? NF : NUA / 2;
        _Pragma("unroll 1") for (int rp = 0; rp < REP_ATTN; ++rp) for (int u = gwv; u < NUA - ND; u += NGW) attn_unit(c, l, u); }
      _Pragma("unroll 1") for (int rp = 0; rp < REP_LOC; ++rp) {
      for (int u = (gwv + (NGW * 9) / 16) % NGW; u < NCHUNK * 5; u += NGW) scan_local_unit<0>(c, l, u / 5, u % 5);
      for (int u = (gwv + (NGW * 14) / 16) % NGW; u < NCHUNK * 4; u += NGW) scan_local_unit<1>(c, l, u >> 2, u & 3); }
      SEAM(pb + 2);
    }
    #ifndef REP_MIX2
#define REP_MIX2 1
#endif
    if (KIND(4) && IN(pb + 3)) _Pragma("unroll 1") for (int rp = 0; rp < REP_MIX2; ++rp) { LAUNDER();
      const int wv = c.wave * c.G + c.bid, NGW = c.G * NWAVES;
      constexpr int NIT = NSEQ * 129 + NSEQ * 128;
      for (int wi = wv; 2 * wi < NIT; wi += NGW) scan_prop_item(c, l, 2 * wi + (c.lane >> 5));
      { const int NF = NGW > NLONGW ? NGW - NLONGW : 0, ND = NF < NUA / 2 ? NF : NUA / 2;
        if (wv >= NLONGW && wv - NLONGW < ND) attn_unit(c, l, NUA - ND + (wv - NLONGW)); }
      SEAM(pb + 3);
    }
    if (KIND(5) && IN(pb + 4)) _Pragma("unroll 1") for (int rep = 0; rep < REP_MIX3; ++rep) { LAUNDER();
      const int gwv = c.bid * NWAVES + c.wave, NGW = c.G * NWAVES;
      for (int u = gwv; u < NCHUNK * 2; u += NGW) scan_apply_unit<0>(c, l, u >> 1, u & 1);
      for (int u = (gwv + NGW / 2) % NGW; u < NCHUNK * 2; u += NGW) scan_apply_unit<1>(c, l, u >> 1, u & 1);
      SEAM(pb + 4);
    }
    if (KIND(6) && IN(pb + 5)) _Pragma("unroll 1") for (int rep = 0; rep < REP_MERGE; ++rep) { LAUNDER();
      pg8::Gemm g{(const bf16_t*)(c.ws + WS_YCAT), (const bf16_t*)(c.ws + WS_WBR) + (size_t)l * D * D, TP, D, D, D, D, 0, 0};
      pg8::StaticOrder S; S.init(TP, D, c.G, c.bid);
      EpiMergeH E{(const bf16_t*)(c.ws + WS_P), (bf16_t*)(c.ws + WS_MG)};
      pg8::gemm_phase<EpiMergeH, pg8::StaticOrder, true>(lds, g, S, E, c.tid);
      sample_tail_gemm<0>(c, l, (const bf16_t*)(c.ws + WS_WBR) + (size_t)l * D * D, (const bf16_t*)(c.ws + WS_YCAT) + (size_t)TP * D);
      SEAM(pb + 5);
    }
    #ifndef REP_OUT0
#define REP_OUT0 1
#endif
    if (KIND(7) && IN(pb + 6)) _Pragma("unroll 1") for (int rp = 0; rp < (l == 0 ? REP_OUT0 : 1); ++rp) { LAUNDER();
      pg8::Gemm g{(const bf16_t*)(c.ws + WS_MG), (const bf16_t*)(c.ws + WS_WOUT) + (size_t)l * D * D, TP, D, D, D, D, 0, 0};
      pg8::StaticOrder S; S.init(TP, D, c.G, c.bid);
      EpiOut E{c.in[IN_XP], c.in[IN_XS], c.out + O_Y, c.out + O_Y, l};
      pg8::gemm_phase<EpiOut, pg8::StaticOrder, true>(lds, g, S, E, c.tid);
      sample_tail_gemm<1>(c, l, (const bf16_t*)(c.ws + WS_WOUT) + (size_t)l * D * D, (const bf16_t*)(c.ws + WS_MG) + (size_t)TP * D);
      SEAM(pb + 6);
    }
  }
  if (KIND(8) && IN(PH_FINAL)) { LAUNDER(); phase_final(c); }
#undef IN
#undef SEAM
}

#ifndef N_LAUNCHES
#define N_LAUNCHES 1
#endif
#ifdef EMU
void emu_after_phase(int p, unsigned char* ws, float* out);
#endif
extern "C" void kernel_launch(void* const* d_in, const int* in_sizes, int n_in, void* d_out, int out_size, void* d_ws, size_t ws_size, hipStream_t stream) {
  (void)in_sizes; (void)n_in; (void)out_size; (void)ws_size;
  Args a;
  memset(&a, 0, sizeof(a));
  for (int i = 0; i < 20; ++i) a.in[i] = (const float*)d_in[i];
  a.out = (float*)d_out; a.ws = (unsigned char*)d_ws;
#ifdef EMU
  int grid = EMU_GRID;
  for (int p = 0; p < PH_COUNT; ++p) { a.ph_lo = p; a.ph_hi = p + 1; emu_launch(fwd, grid, NTHREADS, LDS_BYTES, a); emu_after_phase(p, a.ws, a.out); }
#else
  static int grid = 0;
  if (grid == 0) {
    int dev = 0, cus = 0;
    if (hipGetDevice(&dev) != hipSuccess || hipDeviceGetAttribute(&cus, hipDeviceAttributeMultiprocessorCount, dev) != hipSuccess) { grid = -1; return; }
    if (hipFuncSetAttribute((const void*)fwd, hipFuncAttributeMaxDynamicSharedMemorySize, LDS_BYTES) != hipSuccess) { grid = -1; return; }
    int per_cu = 0;
    (void)hipOccupancyMaxActiveBlocksPerMultiprocessor(&per_cu, (const void*)fwd, NTHREADS, LDS_BYTES);
    (void)hipGetLastError();
    grid = cus;
  }
  if (grid < 0) return;
  (void)hipMemsetAsync((char*)d_ws + WS_CTL, 0, CTL_BYTES, stream);
  if (N_LAUNCHES == 1) { a.ph_lo = 0; a.ph_hi = PH_COUNT; hipLaunchKernelGGL(fwd, dim3(grid), dim3(NTHREADS), LDS_BYTES, stream, a); }
  else for (int p = 0; p < PH_COUNT; ++p) { a.ph_lo = p; a.ph_hi = p + 1; hipLaunchKernelGGL(fwd, dim3(grid), dim3(NTHREADS), LDS_BYTES, stream, a); }
#endif
}
```

```cpp
#ifndef EMU
#include <hip/hip_runtime.h>
#include <cstdio>
#include <cstdint>
#include <cstring>
#endif

typedef unsigned short bf16_t;
typedef short bf16x8 __attribute__((ext_vector_type(8)));
typedef short s16x4 __attribute__((ext_vector_type(4)));
typedef float f32x4 __attribute__((ext_vector_type(4)));
typedef float f32x16 __attribute__((ext_vector_type(16)));
typedef unsigned u32x4 __attribute__((ext_vector_type(4)));
typedef unsigned u32x2 __attribute__((ext_vector_type(2)));

#ifdef EMU
#define DI inline
#define LAS
#define GAS
DI unsigned f_bits(float f) { unsigned u; memcpy(&u, &f, 4); return u; }
DI float bits_f(unsigned u) { float f; memcpy(&f, &u, 4); return f; }
DI float ex2(float x) { return exp2f(x); }
DI float lg2(float x) { return log2f(x); }
DI float frcp(float x) { return 1.0f / x; }
DI float wshfl(float v, int src) { auto s = emu::wave_exchange(&v, 4); float r; memcpy(&r, s[src & 63], 4); return r; }
DI float wshfl_xor(float v, int m, int lane) { return wshfl(v, lane ^ m); }
DI float wshfl_up(float v, int d, int lane) { return wshfl(v, lane >= d ? lane - d : lane); }
DI int rfl(int v) { return v; }
DI float bf2f(bf16_t b) { return bits_f((unsigned)b << 16); }
DI f32x16 mfma32(bf16x8 a, bf16x8 b, f32x16 c) {
  struct { bf16x8 a, b; } d{a, b};
  auto s = emu::wave_exchange(&d, 32);
  int lane = emu::tid() & 63, r = lane & 31, h = lane >> 5;
  f32x16 o = c;
  for (int i = 0; i < 16; ++i) {
    int row = (i & 3) + 8 * (i >> 2) + 4 * h; double acc = 0;
    for (int k = 0; k < 16; ++k) {
      bf16x8 av, bv; memcpy(&av, s[row + 32 * (k >> 3)], 16); memcpy(&bv, (char*)s[r + 32 * (k >> 3)] + 16, 16);
      acc += (double)bf2f((bf16_t)av[k & 7]) * (double)bf2f((bf16_t)bv[k & 7]);
    }
    o[i] = c[i] + (float)acc;
  }
  return o;
}
DI s16x4 ds_tr16(const void* p) {
  auto s = emu::wave_exchange(&p, 8);
  int lane = emu::tid() & 63, g = lane & ~15, i = lane & 15;
  s16x4 o;
  for (int q = 0; q < 4; ++q) { const short* a; memcpy(&a, s[g + 4 * q + (i >> 2)], 8); o[q] = a[i & 3]; }
  return o;
}
#define OPAQUE_V(x) do {} while (0)
#define NT_STORE(ptr, val) (*(ptr) = (val))
#define VM_WAIT() do {} while (0)
#define LDS_WAIT() do { int _z = 0; (void)emu::wave_exchange(&_z, 4); } while (0)
#define DYN_LDS(name) unsigned char* name = emu::g_blk->lds
DI float log1p_f(float x) { return log1pf(x); }
#else
#define DI __device__ __forceinline__
#define LAS __attribute__((address_space(3)))
#define GAS __attribute__((address_space(1)))
DI unsigned f_bits(float f) { return __builtin_bit_cast(unsigned, f); }
DI float bits_f(unsigned u) { return __builtin_bit_cast(float, u); }
DI float ex2(float x) { return __builtin_amdgcn_exp2f(x); }
DI float lg2(float x) { return __builtin_amdgcn_logf(x); }
DI float frcp(float x) { return __builtin_amdgcn_rcpf(x); }
DI float wshfl(float v, int src) { return bits_f((unsigned)__builtin_amdgcn_ds_bpermute(src << 2, (int)f_bits(v))); }
DI float wshfl_xor(float v, int m, int lane) { return wshfl(v, lane ^ m); }
DI float wshfl_up(float v, int d, int lane) { return wshfl(v, lane >= d ? lane - d : lane); }
DI int rfl(int v) { return __builtin_amdgcn_readfirstlane(v); }
DI float bf2f(bf16_t b) { return bits_f((unsigned)b << 16); }
DI f32x16 mfma32(bf16x8 a, bf16x8 b, f32x16 c) { return __builtin_amdgcn_mfma_f32_32x32x16_bf16(a, b, c, 0, 0, 0); }
DI s16x4 ds_tr16(const LAS void* p) { return __builtin_amdgcn_ds_read_tr16_b64_v4i16((LAS s16x4*)p); }
#define OPAQUE_V(x) asm volatile("" : "+v"(x))
#define NT_STORE(ptr, val) __builtin_nontemporal_store((val), (ptr))
#define VM_WAIT() asm volatile("s_waitcnt vmcnt(0)" ::: "memory")
#define LDS_WAIT() asm volatile("s_waitcnt lgkmcnt(0)" ::: "memory")
#define DYN_LDS(name) extern __shared__ __attribute__((aligned(16))) unsigned char name##_raw[]; LAS unsigned char* name = (LAS unsigned char*)name##_raw
DI float log1p_f(float x) { return x < 1e-4f ? x * (1.0f - 0.5f * x) : __builtin_amdgcn_logf(1.0f + x) * 0.6931471805599453f; }
#endif

DI bf16_t f2bf(float f) { unsigned u = f_bits(f); return (bf16_t)((u + 0x7fffu + ((u >> 16) & 1u)) >> 16); }
#ifdef EMU
DI unsigned pk2(float lo, float hi) { return (unsigned)f2bf(lo) | ((unsigned)f2bf(hi) << 16); }
#else
typedef float f32x2_t __attribute__((ext_vector_type(2))); typedef __bf16 bf16x2_t __attribute__((ext_vector_type(2)));
DI unsigned pk2(float lo, float hi) { f32x2_t v = {lo, hi}; bf16x2_t b = __builtin_convertvector(v, bf16x2_t); return __builtin_bit_cast(unsigned, b); }
#endif
DI bf16x8 pack8(float a0, float a1, float a2, float a3, float a4, float a5, float a6, float a7) {
  u32x4 p; p.x = pk2(a0, a1); p.y = pk2(a2, a3); p.z = pk2(a4, a5); p.w = pk2(a6, a7); return __builtin_bit_cast(bf16x8, p);
}
DI void unpack8(const u32x4 g, float (&o)[8]) {
#pragma unroll
  for (int j = 0; j < 4; ++j) { o[2 * j] = bits_f(g[j] << 16); o[2 * j + 1] = bits_f(g[j] & 0xffff0000u); }
}
DI float wave_sum(float v, int lane) {
#pragma unroll
  for (int o = 1; o < 64; o <<= 1) v += wshfl_xor(v, o, lane);
  return v;
}
DI float wave_max(float v, int lane) {
#pragma unroll
  for (int o = 1; o < 64; o <<= 1) v = fmaxf(v, wshfl_xor(v, o, lane));
  return v;
}
DI float wave_min(float v, int lane) {
#pragma unroll
  for (int o = 1; o < 64; o <<= 1) v = fminf(v, wshfl_xor(v, o, lane));
  return v;
}
DI float half_sum(float v, int lane) {
#pragma unroll
  for (int o = 1; o < 32; o <<= 1) v += wshfl_xor(v, o, lane);
  return v;
}
DI float sigmoid_f(float x) { return 1.0f / (1.0f + __expf(-x)); }
DI float silu_f(float x) { return x * sigmoid_f(x); }
DI int crow(int i, int h) { return (i & 3) + 8 * (i >> 2) + 4 * h; }


#ifdef EMU
constexpr int SEQ = EMU_SEQ, PAST = EMU_PAST;
#else
constexpr int SEQ = 16384, PAST = 4096;
#endif
constexpr int D = 2048, NBATCH = 2, DEPTH = 2, DB = 32, DS = 16, W = 512, NH = 4, HD = 128, CW = 31;
constexpr int TP = NBATCH * SEQ, TS = DB * DS, T = TP + TS;
constexpr int NP = 16384, N_IN = 16392, GATE_COL = 4608;
#define PIX(row, cb) (((size_t)(cb) * T + (size_t)(row)) * 512)
constexpr int NCH_P = SEQ / 64, NSEQ_P = NBATCH * NH, NSEQ_S = DB * NH, NSEQ = NSEQ_P + NSEQ_S;
constexpr int NCHUNK = NSEQ_P * NCH_P + NSEQ_S;
constexpr int NWAVES = 8, NTHREADS = 512;
static_assert(T % 256 == 0 && SEQ % 64 == 0 && PAST % 32 == 0 && PAST + DS <= SEQ, "shapes");
constexpr int CB_QA = 0, CB_KA = 1, CB_VA = 2, CB_ZA = 3, CB_QB = 4, CB_KB = 5, CB_VB = 6, CB_OB = 7, CB_ZB = 8, CB_QC = 9, CB_KC = 10, CB_VC = 11, CB_ZC = 12,
              CB_UD = 13, CB_GD = 14, CB_ZD = 15, CB_G0 = 16;
constexpr size_t O_Y = 0;
constexpr size_t O_PK = O_Y + (size_t)T * D;
constexpr size_t O_PV = O_PK + (size_t)DEPTH * TP * W;
constexpr size_t O_PC = O_PV + (size_t)DEPTH * TP * W;
constexpr size_t O_PN = O_PC + (size_t)DEPTH * NBATCH * NH * HD * HD;
constexpr size_t O_PM = O_PN + (size_t)DEPTH * NBATCH * NH * HD;
constexpr size_t O_PS = O_PM + (size_t)DEPTH * NBATCH * NH;
constexpr size_t O_PCONV = O_PS + (size_t)DEPTH * NBATCH * NH * HD * HD;
constexpr size_t O_SK = O_PCONV + (size_t)DEPTH * NBATCH * 30 * W;
constexpr size_t O_SV = O_SK + (size_t)DEPTH * TS * W;
constexpr size_t O_SC = O_SV + (size_t)DEPTH * TS * W;
constexpr size_t O_SN = O_SC + (size_t)DEPTH * DB * NH * HD * HD;
constexpr size_t O_SM = O_SN + (size_t)DEPTH * DB * NH * HD;
constexpr size_t O_SS = O_SM + (size_t)DEPTH * DB * NH;
constexpr size_t O_SCONV = O_SS + (size_t)DEPTH * DB * NH * HD * HD;
constexpr size_t O_END = O_SCONV + (size_t)DEPTH * DB * 30 * W;
constexpr size_t MiB = 1u << 20;
constexpr size_t al(size_t x) { return (x + 4095) & ~(size_t)4095; }
constexpr size_t WS_CTL = 0, CTL_BYTES = 1 * MiB;
constexpr size_t WS_WIN = WS_CTL + CTL_BYTES;
constexpr size_t WS_WBR = WS_WIN + al((size_t)DEPTH * NP * D * 2);
constexpr size_t WS_WOUT = WS_WBR + al((size_t)DEPTH * 4 * D * W * 2);
constexpr size_t WS_ROPE = WS_WOUT + al((size_t)DEPTH * D * D * 2);
constexpr size_t WS_IG = WS_ROPE + al((size_t)SEQ * 64 * 8);
constexpr size_t WS_LF = WS_IG + al((size_t)T * 4 * 4);
constexpr size_t WS_SCB = WS_LF + al((size_t)T * 4 * 4);
constexpr size_t WS_SCG = WS_SCB + al((size_t)NCHUNK * 4);
constexpr size_t WS_MC = WS_SCG + al((size_t)NCHUNK * 4);
constexpr size_t WS_HIN = WS_MC + al((size_t)NCHUNK * 4);
constexpr int ST_ROWS = 160;
constexpr size_t ST_BYTES = (size_t)ST_ROWS * HD * 2;
constexpr size_t WS_ST = WS_HIN + al((size_t)T * D * 2);
constexpr size_t WS_ST2 = WS_ST + al((size_t)2 * NCHUNK * ST_BYTES);
constexpr size_t WS_P = WS_ST2 + al((size_t)2 * NCHUNK * ST_BYTES);
constexpr size_t WS_YCAT = WS_P + al((size_t)T * NP * 2);
constexpr size_t WS_MG = WS_YCAT + al((size_t)T * D * 2);
constexpr size_t WS_END = WS_MG + al((size_t)T * D * 2);
constexpr int WSCR = 18304;
constexpr int LDSCTL_OFF = NWAVES * WSCR;
constexpr int LDS_BYTES = 147456;
static_assert(LDSCTL_OFF + 64 <= LDS_BYTES && LDSCTL_OFF % 16 == 0, "lds map");
constexpr int TS272 = 272;

struct Args {
  const float* in[20]; float* out; unsigned char* ws; int ph_lo, ph_hi;
};

namespace pg8 {
constexpr int BM = 256, BK = 64, HALF = 128, HTB = HALF * BK * 2, STAGE_BYTES = 8 * HTB, NXCD = 8, WGM = 4;
__host__ __device__ inline int lds_byte(int r, int c) { const int st = (r >> 4) * 2 + (c >> 5), rr = r & 15, cc = c & 31, ob = rr * 64 + cc * 2; return st * 1024 + (ob ^ (((ob >> 9) & 1) << 5)); }
__host__ __device__ inline void stage_rc(int b, int& R, int& C) { const int st = b / 1024, sb = b % 1024, swz = sb ^ (((sb >> 9) & 1) << 5); R = (st >> 1) * 16 + swz / 64; C = (st & 1) * 32 + (swz % 64) / 2; }
__host__ __device__ inline int perm32(int rho) { const int n = rho >> 4, i = rho & 15; return 8 * (i >> 2) + 4 * n + (i & 3); }
struct Unit { int pm, pn, kb; };
struct Gemm { const bf16_t* A; const bf16_t* Bt; int M, N, K, lda, ldb; size_t kbA, kbB; };
struct StaticOrder {
  int nM, nN, nwg, G, c;
  __host__ __device__ void init(int M, int N, int G_, int c_) { nM = M / BM; nN = N / BM; nwg = nM * nN; G = G_; c = c_; }
  __host__ __device__ bool tile(long L, Unit& u) const {
    if (L >= nwg) return false;
    int wgid = (int)L; { const int q = nwg / NXCD, r = nwg % NXCD, xcd = wgid % NXCD, off = wgid / NXCD; wgid = (xcd < r ? xcd * (q + 1) : r * (q + 1) + (xcd - r) * q) + off; }
    const int nig = WGM * nN, gid = wgid / nig, fm = gid * WGM, gsz = (nM - fm) < WGM ? (nM - fm) : WGM;
    u.pm = fm + ((wgid % nig) % gsz); u.pn = (wgid % nig) / gsz; u.kb = 0; return true;
  }
  __host__ __device__ bool next(int i, Unit& u) const { return tile((long)i * G + c, u); }
};
#ifndef EMU
template <class Epi, class Sched, bool ALIGN_EPI>
__device__ __forceinline__ void gemm_phase(LAS unsigned char* lds, const Gemm g, const Sched& S, const Epi& E, const int tid) {
  const int wid = __builtin_amdgcn_readfirstlane(tid >> 6), lane = tid & 63, wr = wid >> 2, wc = wid & 3, fr = lane & 15, fq = lane >> 4;
  const int nt = g.K / BK;
  unsigned voffA[2], voffB[2];
#pragma unroll
  for (int i = 0; i < 2; ++i) { int R, C; stage_rc(tid * 16 + i * 8192, R, C); const int Rb = Epi::PERM ? ((R & ~31) + perm32(R & 31)) : R;
    voffA[i] = (unsigned)(R * g.lda + C) * 2u; voffB[i] = (unsigned)(Rb * g.ldb + C) * 2u; }
  const size_t kstep = (size_t)(BK * 2);
  const size_t hstepA = (size_t)HALF * g.lda * 2, hstepB = (size_t)HALF * g.ldb * 2;
  const unsigned ldsw = (unsigned)wid * 1024u;
  const int aoff = lds_byte(wr * 64 + fr, fq * 8), boff = lds_byte(wc * 32 + fr, fq * 8);
#define PG8_SA(b, h) (((b) * 2 + (h)) * HTB)
#define PG8_SB(b, h) ((4 + (b) * 2 + (h)) * HTB)
#define PG8_STAGE(bufoff, gbase, voff) do { _Pragma("unroll") for (int _i = 0; _i < 2; ++_i) \
    __builtin_amdgcn_global_load_lds((const unsigned*)((const char*)(gbase) + (voff)[_i]), (LAS unsigned*)(lds + (bufoff) + ldsw + _i * 8192), 16, 0, 0); } while (0)
#define PG8_LDA(dst, b, h) do { _Pragma("unroll") for (int m = 0; m < 4; ++m) _Pragma("unroll") for (int k = 0; k < 2; ++k) dst[m][k] = *(const LAS bf16x8*)(lds + PG8_SA(b, h) + aoff + m * 2048 + k * 1024); } while (0)
#define PG8_LDB(dst, b, h) do { _Pragma("unroll") for (int n = 0; n < 2; ++n) _Pragma("unroll") for (int k = 0; k < 2; ++k) dst[n][k] = *(const LAS bf16x8*)(lds + PG8_SB(b, h) + boff + n * 2048 + k * 1024); } while (0)
#define PG8_MMA(ai, bj, At, Bt) do { __builtin_amdgcn_s_setprio(1); _Pragma("unroll") for (int m = 0; m < 4; ++m) _Pragma("unroll") for (int n = 0; n < 2; ++n) _Pragma("unroll") for (int k = 0; k < 2; ++k) \
    acc[ai][bj][m][n] = __builtin_amdgcn_mfma_f32_16x16x32_bf16(Bt[n][k], At[m][k], acc[ai][bj][m][n], 0, 0, 0); __builtin_amdgcn_s_setprio(0); } while (0)
#define PG8_WAIT_V(n) asm volatile("s_waitcnt vmcnt(" #n ")" ::: "memory")
#define PG8_WAIT_L(n) asm volatile("s_waitcnt lgkmcnt(" #n ")" ::: "memory")
#define PG8_BAR __builtin_amdgcn_s_barrier()
#define PG8_SCHED __builtin_amdgcn_sched_barrier(0)
  Unit cur, nxt; int ui = 0;
  if (!S.next(0, cur)) return;
  f32x4 acc[2][2][4][2];
#pragma unroll
  for (int a = 0; a < 2; ++a)
#pragma unroll
    for (int b = 0; b < 2; ++b)
#pragma unroll
      for (int m = 0; m < 4; ++m)
#pragma unroll
        for (int n = 0; n < 2; ++n) acc[a][b][m][n] = (f32x4){0.f, 0.f, 0.f, 0.f};
  bf16x8 At[4][2], B0[2][2], B1[2][2];
  const char* cA = (const char*)g.A + (size_t)cur.pm * 2 * hstepA + (size_t)cur.kb * g.kbA;
  const char* cB = (const char*)g.Bt + (size_t)cur.pn * 2 * hstepB + (size_t)cur.kb * g.kbB;
  PG8_STAGE(PG8_SB(0, 0), cB, voffB); PG8_STAGE(PG8_SB(0, 1), cB + hstepB, voffB); PG8_STAGE(PG8_SA(0, 0), cA, voffA); PG8_STAGE(PG8_SA(0, 1), cA + hstepA, voffA);
  if (wr == 1) PG8_BAR;
  PG8_WAIT_V(2); PG8_BAR;
  PG8_STAGE(PG8_SB(1, 0), cB + kstep, voffB); PG8_STAGE(PG8_SA(1, 0), cA + kstep, voffA); PG8_STAGE(PG8_SB(1, 1), cB + hstepB + kstep, voffB);
  PG8_WAIT_V(6); PG8_BAR;
  for (;;) {
    const bool has_next = S.next(ui + 1, nxt);
    const char* nA = has_next ? (const char*)g.A + (size_t)nxt.pm * 2 * hstepA + (size_t)nxt.kb * g.kbA : cA;
    const char* nB = has_next ? (const char*)g.Bt + (size_t)nxt.pn * 2 * hstepB + (size_t)nxt.kb * g.kbB : cB;
    for (int t = 0; t < nt; t += 2) {
      const bool last = (t == nt - 2);
      const char* a1 = cA + (size_t)(t + 1) * kstep;
      const char* a2 = last ? nA : cA + (size_t)(t + 2) * kstep; const char* b2 = last ? nB : cB + (size_t)(t + 2) * kstep;
      const char* a3 = a2 + kstep; const char* b3 = b2 + kstep;
      PG8_LDB(B0, 0, 0); PG8_LDB(B1, 0, 1); PG8_SCHED; PG8_LDA(At, 0, 0); PG8_STAGE(PG8_SA(1, 1), a1 + hstepA, voffA);
      PG8_WAIT_V(8); PG8_WAIT_L(0); PG8_BAR; PG8_MMA(0, 0, At, B0); PG8_MMA(0, 1, At, B1); PG8_BAR; PG8_SCHED;
      PG8_LDA(At, 0, 1); PG8_STAGE(PG8_SB(0, 0), b2, voffB); PG8_STAGE(PG8_SB(0, 1), b2 + hstepB, voffB); PG8_STAGE(PG8_SA(0, 0), a2, voffA);
      PG8_WAIT_V(8); PG8_WAIT_L(0); PG8_BAR; PG8_MMA(1, 0, At, B0); PG8_MMA(1, 1, At, B1); PG8_BAR; PG8_SCHED;
      PG8_LDB(B0, 1, 0); PG8_LDB(B1, 1, 1); PG8_SCHED; PG8_LDA(At, 1, 0); PG8_STAGE(PG8_SA(0, 1), a2 + hstepA, voffA);
      PG8_WAIT_V(8); PG8_WAIT_L(0); PG8_BAR; PG8_MMA(0, 0, At, B0); PG8_MMA(0, 1, At, B1); PG8_BAR; PG8_SCHED;
      PG8_LDA(At, 1, 1); PG8_STAGE(PG8_SB(1, 0), b3, voffB); PG8_STAGE(PG8_SB(1, 1), b3 + hstepB, voffB); PG8_STAGE(PG8_SA(1, 0), a3, voffA);
      PG8_WAIT_V(8); PG8_WAIT_L(0); PG8_BAR; PG8_MMA(1, 0, At, B0); PG8_MMA(1, 1, At, B1); PG8_BAR; PG8_SCHED;
      if constexpr (Epi::MID > 0) { if (((t + 2) % Epi::MID) == 0 && (t + 2) < nt) E.mid(acc, cur, (t + 2) / Epi::MID - 1, wr, wc, fr, fq); }
    }
    if constexpr (ALIGN_EPI) { if (wr == 0) PG8_BAR; }
    E(acc, cur, wr, wc, fr, fq);
    if (!has_next) break;
#pragma unroll
    for (int a = 0; a < 2; ++a)
#pragma unroll
      for (int b = 0; b < 2; ++b)
#pragma unroll
        for (int m = 0; m < 4; ++m)
#pragma unroll
          for (int n = 0; n < 2; ++n) acc[a][b][m][n] = (f32x4){0.f, 0.f, 0.f, 0.f};
    cur = nxt; cA = nA; cB = nB; ++ui;
    if constexpr (ALIGN_EPI) { if (wr == 1) PG8_BAR; }
  }
  PG8_WAIT_V(0);
  if constexpr (!ALIGN_EPI) { if (wr == 0) PG8_BAR; }
  PG8_BAR;
#undef PG8_SA
#undef PG8_SB
#undef PG8_STAGE
#undef PG8_LDA
#undef PG8_LDB
#undef PG8_MMA
#undef PG8_WAIT_V
#undef PG8_WAIT_L
#undef PG8_BAR
#undef PG8_SCHED
}
#else
template <class Epi, class Sched, bool ALIGN_EPI>
inline void gemm_phase(unsigned char* lds, const Gemm g, const Sched& S, const Epi& E, const int tid) {
  (void)lds;
  const int wid = tid >> 6, lane = tid & 63, wr = wid >> 2, wc = wid & 3, fr = lane & 15, fq = lane >> 4;
  emu::Block* blk = emu::g_blk;
  Unit u;
  for (int ui = 0; S.next(ui, u); ++ui) {
    __syncthreads();
    if (tid == 0) { blk->fa.resize((size_t)256 * g.K); blk->fb.resize((size_t)256 * g.K); }
    __syncthreads();
    const bf16_t* A = (const bf16_t*)((const char*)g.A + (size_t)u.kb * g.kbA) + (size_t)u.pm * 256 * g.lda;
    const bf16_t* B = (const bf16_t*)((const char*)g.Bt + (size_t)u.kb * g.kbB) + (size_t)u.pn * 256 * g.ldb;
    for (int i = tid; i < 256; i += NTHREADS) for (int k = 0; k < g.K; ++k) { blk->fa[(size_t)i * g.K + k] = bf2f(A[(size_t)i * g.lda + k]); blk->fb[(size_t)i * g.K + k] = bf2f(B[(size_t)i * g.ldb + k]); }
    __syncthreads();
    f32x4 acc[2][2][4][2];
    const int nseg = Epi::MID > 0 ? g.K / (Epi::MID * BK) : 1, segk = g.K / nseg;
    for (int ai = 0; ai < 2; ++ai) for (int bj = 0; bj < 2; ++bj) for (int m = 0; m < 4; ++m) for (int n = 0; n < 2; ++n) for (int j = 0; j < 4; ++j) acc[ai][bj][m][n][j] = 0.f;
    for (int sg = 0; sg < nseg; ++sg) {
      for (int ai = 0; ai < 2; ++ai) for (int bj = 0; bj < 2; ++bj) for (int m = 0; m < 4; ++m) for (int n = 0; n < 2; ++n) for (int j = 0; j < 4; ++j) {
        const int row = 128 * ai + 64 * wr + 16 * m + fr;
        const int col = Epi::PERM ? 128 * bj + 32 * wc + 8 * fq + 4 * n + j : 128 * bj + 32 * wc + 16 * n + 4 * fq + j;
        const float* a = &blk->fa[(size_t)row * g.K + sg * segk]; const float* b = &blk->fb[(size_t)col * g.K + sg * segk];
        float s = 0.f; for (int k = 0; k < segk; ++k) s += a[k] * b[k];
        acc[ai][bj][m][n][j] += s;
      }
      if constexpr (Epi::MID > 0) { if (sg + 1 < nseg) E.mid(acc, u, sg, wr, wc, fr, fq); }
    }
    E(acc, u, wr, wc, fr, fq);
  }
  __syncthreads();
}
#endif
}

#ifndef EMU
#define XB_TMO      128
#define XB_XCNT(j)  (256  + 64 * (j))
#define XB_XSUB(j)  (1280 + 64 * (j))
#define XB_XGEN(j)  (2304 + 64 * (j))
#define XB_TOP      3328
#define XB_TOPGEN   3392
#define XCD_BAR_WORDS 3456
#define XB_SPIN_CAP (1u << 18)
__device__ __forceinline__ unsigned xb_ld(unsigned* p)              { return __hip_atomic_load(p, __ATOMIC_RELAXED, __HIP_MEMORY_SCOPE_AGENT); }
__device__ __forceinline__ unsigned xb_add(unsigned* p, unsigned v) { return __hip_atomic_fetch_add(p, v, __ATOMIC_RELAXED, __HIP_MEMORY_SCOPE_AGENT); }
__device__ __forceinline__ unsigned xb_xcc_id() { return (unsigned)__builtin_amdgcn_s_getreg((3 << 11) | 20) & 0xFu; }
#define XB_SPIN(cond, bar) do { unsigned _sp = 0; while (cond) { __builtin_amdgcn_s_sleep(1); \
    if ((++_sp & 255u) == 0u) { if (xb_ld(&(bar)[XB_TMO])) break; if (_sp > XB_SPIN_CAP) { atomicAdd(&(bar)[XB_TMO], 1u); break; } } } } while (0)
struct XcdBarrier { unsigned* bar; unsigned x; volatile LAS unsigned* st; };
__device__ __forceinline__ XcdBarrier xcd_barrier_post(unsigned* bar, volatile LAS unsigned* st) {
  XcdBarrier b; b.bar = bar; b.x = xb_xcc_id(); b.st = st;
  if (threadIdx.x == 0) (void)xb_add(&bar[XB_XCNT(b.x)], 1u);
  return b;
}
__device__ __forceinline__ void xcd_barrier_complete(unsigned* bar, unsigned x, unsigned& nloc, unsigned& nx) {
  const unsigned G = gridDim.x * gridDim.y * gridDim.z;
  unsigned sum, cnt, mine, sp = 0u;
  for (;;) {
    sum = 0u; cnt = 0u; mine = 0u;
#pragma unroll
    for (unsigned j = 0; j < 16; ++j) { const unsigned c = xb_ld(&bar[XB_XCNT(j)]); sum += c; cnt += (c > 0u) ? 1u : 0u; mine = (j == x) ? c : mine; }
    if (sum == G) break;
    __builtin_amdgcn_s_sleep(1);
    if ((++sp & 255u) == 0u) { if (xb_ld(&bar[XB_TMO])) break; if (sp > XB_SPIN_CAP) { atomicAdd(&bar[XB_TMO], 1u); break; } }
  }
  nloc = mine > 0u ? mine : 1u; nx = cnt > 0u ? cnt : 1u;
}
__device__ __forceinline__ void xcd_barrier(const XcdBarrier& b) {
  asm volatile("s_waitcnt vmcnt(0)" ::: "memory");
  __syncthreads();
  if (threadIdx.x == 0) {
    unsigned* bar = b.bar;
    __builtin_amdgcn_s_waitcnt(0);
    unsigned nloc = b.st[0], nx = b.st[1];
    if (nloc == 0u) { xcd_barrier_complete(bar, b.x, nloc, nx); b.st[0] = nloc; b.st[1] = nx; }
    const unsigned old = xb_add(&bar[XB_XSUB(b.x)], 1u);
    const unsigned gen = old / nloc;
    if (old + 1u == (gen + 1u) * nloc) {
      __builtin_amdgcn_fence(__ATOMIC_RELEASE, "agent");
      asm volatile("s_waitcnt vmcnt(0)" ::: "memory");
      const unsigned og = xb_add(&bar[XB_TOP], 1u);
      const unsigned tg = og / nx;
      if (og + 1u == (tg + 1u) * nx) xb_add(&bar[XB_TOPGEN], 1u);
      else XB_SPIN(xb_ld(&bar[XB_TOPGEN]) == tg, bar);
      __builtin_amdgcn_fence(__ATOMIC_ACQUIRE, "agent");
      xb_add(&bar[XB_XGEN(b.x)], 1u);
      asm volatile("s_waitcnt vmcnt(0)" ::: "memory");
    } else {
      XB_SPIN(xb_ld(&bar[XB_XGEN(b.x)]) == gen, bar);
      __builtin_amdgcn_fence(__ATOMIC_ACQUIRE, "agent");
      asm volatile("s_waitcnt vmcnt(0)" ::: "memory");
    }
  }
  __syncthreads();
}
#endif

struct Ctx {
  LAS unsigned char* lds;
  LAS unsigned char* scr;
  int tid, lane, wave, G, bid;
  const float* in[20]; float* out; unsigned char* ws;
};
enum { IN_XP = 0, IN_XS, IN_CK, IN_CV, IN_MC, IN_MN, IN_MM, IN_RS, IN_CONV, IN_NG, IN_WIN, IN_BI, IN_BF, IN_CWT, IN_CB, IN_LNG, IN_LNB, IN_WBR, IN_WOUT, IN_FG };

DI const float* x_row_in(const Ctx& c, int r) { return r < TP ? c.in[IN_XP] + (size_t)r * D : c.in[IN_XS] + (size_t)(r - TP) * D; }

#ifdef EMU
static const float ROPE_INV[64] = {1.000000000e+00f, 8.659643531e-01f, 7.498942614e-01f, 6.493816376e-01f, 5.623413324e-01f, 4.869675338e-01f, 4.216965139e-01f, 3.651741147e-01f, 3.162277639e-01f, 2.738419771e-01f, 2.371373773e-01f, 2.053525001e-01f, 1.778279394e-01f, 1.539926529e-01f, 1.333521307e-01f, 1.154782027e-01f, 1.000000015e-01f, 8.659642935e-02f, 7.498941571e-02f, 6.493816525e-02f, 5.623413250e-02f, 4.869675264e-02f, 4.216965288e-02f, 3.651741147e-02f, 3.162277490e-02f, 2.738419734e-02f, 2.371373773e-02f, 2.053525113e-02f, 1.778279431e-02f, 1.539926510e-02f, 1.333521493e-02f, 1.154782064e-02f, 9.999999776e-03f, 8.659643121e-03f, 7.498941850e-03f, 6.493816152e-03f, 5.623413250e-03f, 4.869675264e-03f, 4.216964822e-03f, 3.651741194e-03f, 3.162277630e-03f, 2.738419687e-03f, 2.371373586e-03f, 2.053524833e-03f, 1.778279431e-03f, 1.539926510e-03f, 1.333521446e-03f, 1.154781901e-03f, 1.000000047e-03f, 8.659643354e-04f, 7.498942432e-04f, 6.493816618e-04f, 5.623413017e-04f, 4.869675322e-04f, 4.216965172e-04f, 3.651741426e-04f, 3.162277571e-04f, 2.738419571e-04f, 2.371373703e-04f, 2.053525095e-04f, 1.778279402e-04f, 1.539926452e-04f, 1.333521504e-04f, 1.154782003e-04f};
#else
__constant__ float ROPE_INV[64] = {1.000000000e+00f, 8.659643531e-01f, 7.498942614e-01f, 6.493816376e-01f, 5.623413324e-01f, 4.869675338e-01f, 4.216965139e-01f, 3.651741147e-01f, 3.162277639e-01f, 2.738419771e-01f, 2.371373773e-01f, 2.053525001e-01f, 1.778279394e-01f, 1.539926529e-01f, 1.333521307e-01f, 1.154782027e-01f, 1.000000015e-01f, 8.659642935e-02f, 7.498941571e-02f, 6.493816525e-02f, 5.623413250e-02f, 4.869675264e-02f, 4.216965288e-02f, 3.651741147e-02f, 3.162277490e-02f, 2.738419734e-02f, 2.371373773e-02f, 2.053525113e-02f, 1.778279431e-02f, 1.539926510e-02f, 1.333521493e-02f, 1.154782064e-02f, 9.999999776e-03f, 8.659643121e-03f, 7.498941850e-03f, 6.493816152e-03f, 5.623413250e-03f, 4.869675264e-03f, 4.216964822e-03f, 3.651741194e-03f, 3.162277630e-03f, 2.738419687e-03f, 2.371373586e-03f, 2.053524833e-03f, 1.778279431e-03f, 1.539926510e-03f, 1.333521446e-03f, 1.154781901e-03f, 1.000000047e-03f, 8.659643354e-04f, 7.498942432e-04f, 6.493816618e-04f, 5.623413017e-04f, 4.869675322e-04f, 4.216965172e-04f, 3.651741426e-04f, 3.162277571e-04f, 2.738419571e-04f, 2.371373703e-04f, 2.053525095e-04f, 1.778279402e-04f, 1.539926452e-04f, 1.333521504e-04f, 1.154782003e-04f};
#endif
DI void transpose_item(const float* Wsrc, int ldn, int K, bf16_t* WT, LAS float* scr, int kb, int srccol  , int n0dst, int lane, int koff = 0) {
  const int k0 = 64 * kb;
#pragma unroll 8
  for (int i = 0; i < 32; ++i) { const int kk = 2 * i + (lane >> 5); scr[kk * 33 + (lane & 31)] = Wsrc[(size_t)(k0 + kk) * ldn + srccol]; }
  LDS_WAIT();
  const int ch = lane & 7;
#pragma unroll
  for (int j = 0; j < 4; ++j) { const int n = (lane >> 3) + 8 * j; const LAS float* s = scr + (8 * ch) * 33 + n;
    u32x4 o; o.x = pk2(s[0 * 33], s[1 * 33]); o.y = pk2(s[2 * 33], s[3 * 33]); o.z = pk2(s[4 * 33], s[5 * 33]); o.w = pk2(s[6 * 33], s[7 * 33]);
    *(u32x4*)(WT + (size_t)(n0dst + n) * K + koff + k0 + 8 * ch) = o; }
  LDS_WAIT();
}
DI void phase_prologue(const Ctx& c) {
  LAS float* scr = (LAS float*)c.scr;
  const int gw = c.bid * NWAVES + c.wave, NGW = c.G * NWAVES;
  constexpr int I_IN = (D / 64) * (NP / 32), I_BR = 4 * (W / 64) * (D / 32), I_OUT = (D / 64) * (D / 32), I_L = I_IN + I_BR + I_OUT;
  for (int it = gw; it < DEPTH * I_L; it += NGW) {
    const int l = it / I_L; int r = it % I_L;
    if (r < I_IN) { const int nblk = NP / 32, kb = r / nblk, nb = r % nblk, n0 = 32 * nb;
      const int np = n0 + (c.lane & 31);
      int src = np < GATE_COL ? np : np + 8;
      if (np >= CB_UD * 512 && np < (CB_GD + 1) * 512) { const int g = (np - CB_UD * 512) >> 3, q = np & 7; src = (q < 4 ? CB_UD * 512 + 8 : CB_GD * 512 + 8) + 4 * g + (q & 3); }
      transpose_item(c.in[IN_WIN] + (size_t)l * D * N_IN, N_IN, D, (bf16_t*)(c.ws + WS_WIN) + (size_t)l * NP * D, scr, kb, src, n0, c.lane); continue; }
    r -= I_IN;
    if (r < I_BR) { const int per = (W / 64) * (D / 32), br = r / per, rr = r % per, nblk = D / 32, kb = rr / nblk, nb = rr % nblk;
      transpose_item(c.in[IN_WBR] + ((size_t)l * 4 + br) * W * D, D, D, (bf16_t*)(c.ws + WS_WBR) + (size_t)l * D * D, scr, kb, 32 * nb + (c.lane & 31), 32 * nb, c.lane, br * W); continue; }
    r -= I_BR;
    { const int nblk = D / 32, kb = r / nblk, nb = r % nblk;
      transpose_item(c.in[IN_WOUT] + (size_t)l * D * D, D, D, (bf16_t*)(c.ws + WS_WOUT) + (size_t)l * D * D, scr, kb, 32 * nb + (c.lane & 31), 32 * nb, c.lane); }
  }
  float* rope = (float*)(c.ws + WS_ROPE);
  for (int i = c.bid * NTHREADS + c.tid; i < SEQ * 64; i += c.G * NTHREADS) {
    const int pos = i >> 6, j = i & 63;
    const float inv = ROPE_INV[j];
    const float ang = (float)pos * inv;
    const double a = (double)ang, n = rint(a * 0.15915494309189535), red = (a - n * 6.283185307179586) ;
    const float rr = (float)(red - n * 2.4492935982947064e-16);
    rope[2 * i] = cosf(rr); rope[2 * i + 1] = sinf(rr);
  }
}

DI void phase_norm(const Ctx& c, int l) {
  LAS float* gw = (LAS float*)c.lds;
  const float* win = c.in[IN_WIN] + (size_t)l * D * N_IN + GATE_COL;
  for (int i = c.tid; i < D * 8; i += NTHREADS) { const int k = i >> 3, q = i & 7;
    gw[((((k >> 8) * 4 + (k & 3)) * 2 + (q >> 2)) * 64 + ((k >> 2) & 63)) * 4 + (q & 3)] = win[(size_t)k * N_IN + q]; }
  __syncthreads();
  const float* ng = c.in[IN_NG] + (size_t)l * D;
  bf16_t* HIN = (bf16_t*)(c.ws + WS_HIN);
  float* IG = (float*)(c.ws + WS_IG); float* LF = (float*)(c.ws + WS_LF);
  const int gwv = c.bid * NWAVES + c.wave, NGW = c.G * NWAVES, lane = c.lane;
  const int gq = (lane & 1) * 4 + ((lane >> 1) & 1) * 2 + ((lane >> 2) & 1);
  const float gbias = gq < 4 ? c.in[IN_BI][l * NH + gq] : c.in[IN_BF][l * NH + gq - 4];
  const bool b0 = lane & 1, b1 = lane & 2, b2 = lane & 4;
  const int loff = 4 * lane;
  f32x4 vn[8];
  {
    const float* xr = (l == 0) ? x_row_in(c, gwv < T ? gwv : 0) : c.out + O_Y + (size_t)(gwv < T ? gwv : 0) * D;
#pragma unroll
    for (int j = 0; j < 8; ++j) vn[j] = *(const f32x4*)(xr + loff + 256 * j);
  }
  for (int r = gwv; r < T; r += NGW) {
    f32x4 v[8]; float ss = 0.f;
#pragma unroll
    for (int j = 0; j < 8; ++j) { v[j] = vn[j]; ss += (v[j].x * v[j].x + v[j].y * v[j].y) + (v[j].z * v[j].z + v[j].w * v[j].w); }
    {
      const int rn = r + NGW < T ? r + NGW : r;
      const float* xr = (l == 0) ? x_row_in(c, rn) : c.out + O_Y + (size_t)rn * D;
#pragma unroll
      for (int j = 0; j < 8; ++j) vn[j] = *(const f32x4*)(xr + loff + 256 * j);
    }
    const float rstd = 1.0f / sqrtf(wave_sum(ss, lane) * (1.0f / D) + 1e-6f);
    float ga[8];
#pragma unroll
    for (int k = 0; k < 8; ++k) ga[k] = 0.f;
    bf16_t* hrow = HIN + (size_t)r * D + loff;
#pragma unroll
    for (int j = 0; j < 8; ++j) {
      const LAS float* gp = gw + (j * 8 * 64 + lane) * 4;
      const f32x4 gvj = *(const f32x4*)(ng + 256 * j + loff);
      v[j] = v[j] * rstd * gvj;
      *(u32x2*)(hrow + 256 * j) = (u32x2){pk2(v[j].x, v[j].y), pk2(v[j].z, v[j].w)};
#pragma unroll
      for (int e = 0; e < 4; ++e) {
        const f32x4 w0 = *(const LAS f32x4*)(gp + e * 512), w1 = *(const LAS f32x4*)(gp + e * 512 + 256);
        const float xv = v[j][e];
        ga[0] += xv * w0.x; ga[1] += xv * w0.y; ga[2] += xv * w0.z; ga[3] += xv * w0.w;
        ga[4] += xv * w1.x; ga[5] += xv * w1.y; ga[6] += xv * w1.z; ga[7] += xv * w1.w;
      }
      asm volatile("" ::: "memory");
    }
    {
      float t4[4];
#pragma unroll
      for (int k = 0; k < 4; ++k) { const float snd = b0 ? ga[k] : ga[4 + k]; const float keep = b0 ? ga[4 + k] : ga[k]; t4[k] = keep + wshfl_xor(snd, 1, lane); }
      float t2[2];
#pragma unroll
      for (int k = 0; k < 2; ++k) { const float snd = b1 ? t4[k] : t4[2 + k]; const float keep = b1 ? t4[2 + k] : t4[k]; t2[k] = keep + wshfl_xor(snd, 2, lane); }
      float t1; { const float snd = b2 ? t2[0] : t2[1]; const float keep = b2 ? t2[1] : t2[0]; t1 = keep + wshfl_xor(snd, 4, lane); }
      t1 += wshfl_xor(t1, 8, lane); t1 += wshfl_xor(t1, 16, lane); t1 += wshfl_xor(t1, 32, lane);
      if (lane < 8) {
        const float val = t1 + gbias;
        if (gq < 4) IG[(size_t)r * 4 + gq] = val;
        else LF[(size_t)r * 4 + gq - 4] = fminf(val, 0.f) - log1p_f(__expf(-fabsf(val)));
      }
    }
  }
  __syncthreads();
}

DI float gate_e(float g) { return __expf(-fmaxf(g, -30.f)); }
struct EpiInproj {
  static constexpr bool PERM = true; static constexpr int MID = 0;
  bf16_t* P; float* out; int l;
  DI void operator()(const f32x4 (&acc)[2][2][4][2], const pg8::Unit& u, int wr, int wc, int fr, int fq) const {
    const int row0 = u.pm * 256 + wr * 64 + fr, colt = u.pn * 256, cb = colt >> 9;
    const int col0 = colt + wc * 32 + 8 * fq;
    const bool kv = (cb == CB_KA || cb == CB_VA), gate = cb >= CB_G0, glu = (cb == CB_UD || cb == CB_GD);
    if (glu) {
#pragma unroll
      for (int ai = 0; ai < 2; ++ai)
#pragma unroll
        for (int m = 0; m < 4; ++m) {
          const int r = row0 + ai * 128 + m * 16;
#pragma unroll
          for (int bj = 0; bj < 2; ++bj) {
            const f32x4 v0 = acc[ai][bj][m][0], v1 = acc[ai][bj][m][1];
            const int chb = (col0 + bj * 128 - CB_UD * 512) >> 1;
            const float g0 = v0[0] * sigmoid_f(v1[0]), g1 = v0[1] * sigmoid_f(v1[1]), g2 = v0[2] * sigmoid_f(v1[2]), g3 = v0[3] * sigmoid_f(v1[3]);
            *(u32x2*)(P + PIX(r, CB_UD) + chb) = (u32x2){pk2(g0, g1), pk2(g2, g3)};
          }
        }
      return;
    }
#pragma unroll
    for (int ai = 0; ai < 2; ++ai)
#pragma unroll
      for (int m = 0; m < 4; ++m) {
        const int r = row0 + ai * 128 + m * 16;
        bf16_t* rowp = P + PIX(r, cb) + (col0 - cb * 512);
#pragma unroll
        for (int bj = 0; bj < 2; ++bj) {
          f32x4 v0 = acc[ai][bj][m][0], v1 = acc[ai][bj][m][1];
          if (gate) {
#pragma unroll
            for (int j = 0; j < 4; ++j) { v0[j] = 1.0f + gate_e(v0[j]); v1[j] = 1.0f + gate_e(v1[j]); }
          }
          u32x4 w; w.x = pk2(v0[0], v0[1]); w.y = pk2(v0[2], v0[3]); w.z = pk2(v1[0], v1[1]); w.w = pk2(v1[2], v1[3]);
          NT_STORE((u32x4*)(rowp + bj * 128), w);
          if (kv) {
            const int cc = col0 + bj * 128 - cb * 512;
            float* o = (r < TP) ? out + (cb == CB_KA ? O_PK : O_PV) + ((size_t)l * TP + r) * W + cc
                                : out + (cb == CB_KA ? O_SK : O_SV) + ((size_t)l * TS + (r - TP)) * W + cc;
            *(f32x4*)o = v0; *(f32x4*)(o + 4) = v1;
          }
        }
      }
  }
};
struct EpiMergeH {
  static constexpr bool PERM = true; static constexpr int MID = 8;
  const bf16_t* P; bf16_t* MG;
  DI void mid(f32x4 (&acc)[2][2][4][2], const pg8::Unit& u, int seg, int wr, int wc, int fr, int fq) const {
    const int row0 = u.pm * 256 + wr * 64 + fr, col0 = u.pn * 256 + wc * 32 + 8 * fq;
#pragma unroll
    for (int ai = 0; ai < 2; ++ai) {
      u32x4 qa[4][2], qb[4][2];
#pragma unroll
      for (int m = 0; m < 4; ++m) {
        const bf16_t* gp = P + PIX(row0 + ai * 128 + m * 16, CB_G0 + seg * 4 + (u.pn >> 1)) + (col0 & 511);
#pragma unroll
        for (int bj = 0; bj < 2; ++bj) { qa[m][bj] = *(const u32x4*)(gp + bj * 128); qb[m][bj] = *(const u32x4*)(gp + (size_t)4 * T * 512 + bj * 128); }
      }
#pragma unroll
      for (int m = 0; m < 4; ++m)
#pragma unroll
        for (int bj = 0; bj < 2; ++bj) {
          float ga[8], gb[8]; unpack8(qa[m][bj], ga); unpack8(qb[m][bj], gb);
          float rt[8];
#pragma unroll
          for (int j = 0; j < 8; ++j) rt[j] = gb[j] * frcp(ga[j]);
          f32x4& v0 = acc[ai][bj][m][0]; f32x4& v1 = acc[ai][bj][m][1];
          v0 = (f32x4){v0[0] * rt[0], v0[1] * rt[1], v0[2] * rt[2], v0[3] * rt[3]};
          v1 = (f32x4){v1[0] * rt[4], v1[1] * rt[5], v1[2] * rt[6], v1[3] * rt[7]};
        }
      asm volatile("" ::: "memory");
    }
  }
  DI void operator()(const f32x4 (&acc)[2][2][4][2], const pg8::Unit& u, int wr, int wc, int fr, int fq) const {
    const int row0 = u.pm * 256 + wr * 64 + fr, col0 = u.pn * 256 + wc * 32 + 8 * fq;
    u32x4 q3[2][4][2];
#pragma unroll
    for (int ai = 0; ai < 2; ++ai)
#pragma unroll
      for (int m = 0; m < 4; ++m)
#pragma unroll
        for (int bj = 0; bj < 2; ++bj) q3[ai][m][bj] = *(const u32x4*)(P + PIX(row0 + ai * 128 + m * 16, CB_G0 + 12 + (u.pn >> 1)) + ((col0 + bj * 128) & 511));
#pragma unroll
    for (int ai = 0; ai < 2; ++ai)
#pragma unroll
      for (int m = 0; m < 4; ++m) {
        const int r = row0 + ai * 128 + m * 16;
#pragma unroll
        for (int bj = 0; bj < 2; ++bj) {
          const int cc = col0 + bj * 128;
          float g3[8]; unpack8(q3[ai][m][bj], g3);
          float s[8];
#pragma unroll
          for (int j = 0; j < 8; ++j) s[j] = frcp(g3[j]);
          const f32x4 v0 = acc[ai][bj][m][0], v1 = acc[ai][bj][m][1];
          u32x4 w; w.x = pk2(v0[0] * s[0], v0[1] * s[1]); w.y = pk2(v0[2] * s[2], v0[3] * s[3]); w.z = pk2(v1[0] * s[4], v1[1] * s[5]); w.w = pk2(v1[2] * s[6], v1[3] * s[7]);
          *(u32x4*)(MG + (size_t)r * D + cc) = w;
        }
      }
  }
};
struct EpiOut {
  static constexpr bool PERM = false; static constexpr int MID = 0;
  const float* xp; const float* xs; const float* xprev; float* y; int l;
  DI void operator()(const f32x4 (&acc)[2][2][4][2], const pg8::Unit& u, int wr, int wc, int fr, int fq) const {
    const int row0 = u.pm * 256 + wr * 64 + fr, col0 = u.pn * 256 + wc * 32 + 4 * fq;
#pragma unroll
    for (int ai = 0; ai < 2; ++ai) {
      f32x4 xv[4][2][2];
#pragma unroll
      for (int m = 0; m < 4; ++m) {
        const int r = row0 + ai * 128 + m * 16;
        const float* xin = (l == 0) ? (r < TP ? xp + (size_t)r * D : xs + (size_t)(r - TP) * D) : xprev + (size_t)r * D;
#pragma unroll
        for (int bj = 0; bj < 2; ++bj)
#pragma unroll
          for (int n = 0; n < 2; ++n) xv[m][bj][n] = *(const f32x4*)(xin + col0 + bj * 128 + n * 16);
      }
#pragma unroll
      for (int m = 0; m < 4; ++m) {
        float* yo = y + (size_t)(row0 + ai * 128 + m * 16) * D;
#pragma unroll
        for (int bj = 0; bj < 2; ++bj)
#pragma unroll
          for (int n = 0; n < 2; ++n) *(f32x4*)(yo + col0 + bj * 128 + n * 16) = xv[m][bj][n] + acc[ai][bj][m][n];
      }
    }
  }
};

struct ChunkGeo { int sq, c, b, h, row0, L, nch; bool sample; };
DI ChunkGeo chunk_geo(int ck) {
  ChunkGeo g;
  if (ck < NSEQ_P * NCH_P) { g.sq = ck / NCH_P; g.c = ck % NCH_P; g.b = g.sq / NH; g.h = g.sq % NH; g.row0 = g.b * SEQ + g.c * 64; g.L = 64; g.nch = NCH_P; g.sample = false; }
  else { const int s = ck - NSEQ_P * NCH_P; g.sq = NSEQ_P + s; g.c = 0; g.b = s / NH; g.h = s % NH; g.row0 = TP + g.b * DS; g.L = DS; g.nch = 1; g.sample = true; }
  return g;
}
DI int seq_pos0(const ChunkGeo& g) { return g.sample ? PAST : g.c * 64; }
DI float ret_log2gamma(int h) { return log2f(1.0f - exp2f(-5.0f - (float)h)); }
DI float wave_prefix_sum(float v, int lane) {
#pragma unroll
  for (int o = 1; o < 64; o <<= 1) { const float t = wshfl_up(v, o, lane); if (lane >= o) v += t; }
  return v;
}
DI float wave_prefix_max(float v, int lane) {
#pragma unroll
  for (int o = 1; o < 64; o <<= 1) { const float t = wshfl_up(v, o, lane); if (lane >= o) v = fmaxf(v, t); }
  return v;
}
DI void rotary_frags(bf16x8 (&f)[8], const float* rope_pos, int h) {
#pragma unroll
  for (int s = 0; s < 4; ++s) {
    float x1[8], x2[8]; unpack8(__builtin_bit_cast(u32x4, f[s]), x1); unpack8(__builtin_bit_cast(u32x4, f[s + 4]), x2);
    const float* cs = rope_pos + 2 * (16 * s + 8 * h);
    float o1[8], o2[8];
#pragma unroll
    for (int j = 0; j < 8; ++j) { const float co = cs[2 * j], si = cs[2 * j + 1]; o1[j] = x1[j] * co - x2[j] * si; o2[j] = x1[j] * si + x2[j] * co; }
    f[s] = pack8(o1[0], o1[1], o1[2], o1[3], o1[4], o1[5], o1[6], o1[7]);
    f[s + 4] = pack8(o2[0], o2[1], o2[2], o2[3], o2[4], o2[5], o2[6], o2[7]);
  }
}
DI bf16x8 tr_frag(const LAS unsigned char* tile, int stride, int row_lo, int row_hi, int col0, int lane) {
  const int q = (lane & 15) >> 2, p = lane & 3, blk = (lane >> 4) & 1;
  const int cbyte = (col0 + 16 * blk + 4 * p) * 2;
  const s16x4 lo = ds_tr16(tile + (row_lo + q) * stride + cbyte);
  const s16x4 hi = ds_tr16(tile + (row_hi + q) * stride + cbyte);
  return (bf16x8){lo[0], lo[1], lo[2], lo[3], hi[0], hi[1], hi[2], hi[3]};
}

constexpr int OT_STRIDE = 132;
DI void o_to_lds(const f32x16* acc, LAS float* tile, int r, int h) {
#pragma unroll
  for (int i = 0; i < 16; ++i)
#pragma unroll
    for (int cc = 0; cc < 4; ++cc) tile[crow(i, h) * OT_STRIDE + 32 * cc + r] = acc[cc][i];
}
DI void conv_pass(const Ctx& c, int l, const LAS float* cw, int s0, int t0, int nt, bool sample, int b, const float (&bias)[8], const float (&lg)[8], const float (&lb)[8]) {
  const bf16_t* P = (const bf16_t*)(c.ws + WS_P);
  bf16_t* YC = (bf16_t*)(c.ws + WS_YCAT);
  const int lane = c.lane, c0 = 8 * lane;
  float acc[8][8];
#pragma unroll
  for (int t = 0; t < 8; ++t)
#pragma unroll
    for (int j = 0; j < 8; ++j) acc[t][j] = bias[j];
  const int nrows = nt + 30;
#define CONV_ROW(idx) (*(const u32x4*)(P + PIX(s0 + ((t0 - 30 + (idx)) < 0 ? 0 : ((t0 - 30 + (idx)) > t0 + nt - 1 ? t0 + nt - 1 : (t0 - 30 + (idx)))), CB_UD) + c0))
  u32x4 p0 = CONV_ROW(0), p1 = CONV_ROW(1), p2 = CONV_ROW(2), p3 = CONV_ROW(3), p4 = CONV_ROW(4), p5 = CONV_ROW(5);
#pragma unroll 1
  for (int jj = 0; jj < nrows; ++jj) {
    const u32x4 cur = p0; p0 = p1; p1 = p2; p2 = p3; p3 = p4; p4 = p5; p5 = CONV_ROW(jj + 6);
    const int rr = t0 - 30 + jj;
    float glu[8];
    if (rr >= 0) {
      unpack8(cur, glu);
    } else if (sample) {
      const float* hp = c.in[IN_CONV] + (((size_t)l * DB + b) * 30 + (30 + rr)) * W + c0;
      const f32x4 a = *(const f32x4*)hp, bb = *(const f32x4*)(hp + 4);
      glu[0] = a.x; glu[1] = a.y; glu[2] = a.z; glu[3] = a.w; glu[4] = bb.x; glu[5] = bb.y; glu[6] = bb.z; glu[7] = bb.w;
    } else {
#pragma unroll
      for (int j = 0; j < 8; ++j) glu[j] = 0.f;
    }
    if (sample) {
      const int xi = 30 + rr;
      if (xi >= 16 && (rr >= t0 || (rr < 0 && t0 == 0))) { float* o = c.out + O_SCONV + (((size_t)l * DB + b) * 30 + (xi - 16)) * W + c0;
        *(f32x4*)o = (f32x4){glu[0], glu[1], glu[2], glu[3]}; *(f32x4*)(o + 4) = (f32x4){glu[4], glu[5], glu[6], glu[7]}; }
    } else if (rr >= t0 && rr >= SEQ - 30) {
      float* o = c.out + O_PCONV + (((size_t)l * NBATCH + b) * 30 + (rr - (SEQ - 30))) * W + c0;
      *(f32x4*)o = (f32x4){glu[0], glu[1], glu[2], glu[3]}; *(f32x4*)(o + 4) = (f32x4){glu[4], glu[5], glu[6], glu[7]};
    }
#pragma unroll
    for (int t = 0; t < 8; ++t) {
      const int j = jj - t;
      if (j >= 0 && j <= 30 && t < nt) {
        const f32x4 w0 = *(const LAS f32x4*)(cw + j * W + 4 * lane), w1 = *(const LAS f32x4*)(cw + j * W + 256 + 4 * lane);
        acc[t][0] += w0.x * glu[0]; acc[t][1] += w0.y * glu[1]; acc[t][2] += w0.z * glu[2]; acc[t][3] += w0.w * glu[3];
        acc[t][4] += w1.x * glu[4]; acc[t][5] += w1.y * glu[5]; acc[t][6] += w1.z * glu[6]; acc[t][7] += w1.w * glu[7];
      }
    }
  }
#undef CONV_ROW
#pragma unroll
  for (int t = 0; t < 8; ++t) {
    if (t < nt) {
      float s1 = 0.f;
#pragma unroll
      for (int j = 0; j < 8; ++j) s1 += acc[t][j];
      const float mean = wave_sum(s1, lane) * (1.0f / W);
      float s2 = 0.f;
#pragma unroll
      for (int j = 0; j < 8; ++j) { const float d = acc[t][j] - mean; s2 += d * d; }
      const float rstd = 1.0f / sqrtf(wave_sum(s2, lane) * (1.0f / W) + 1e-5f);
      const int r = s0 + t0 + t;
      float zd[8]; unpack8(*(const u32x4*)(P + PIX(r, CB_ZD) + c0), zd);
      float o[8];
#pragma unroll
      for (int j = 0; j < 8; ++j) o[j] = silu_f((acc[t][j] - mean) * rstd * lg[j] + lb[j]) * silu_f(zd[j]);
      u32x4 w; w.x = pk2(o[0], o[1]); w.y = pk2(o[2], o[3]); w.z = pk2(o[4], o[5]); w.w = pk2(o[6], o[7]);
      *(u32x4*)(YC + (size_t)r * D + 3 * W + c0) = w;
    }
  }
}
DI void phase_conv(const Ctx& c, int l) {
  LAS float* cw = (LAS float*)c.lds;
  const float* cwg = c.in[IN_CWT] + (size_t)l * CW * W;
  for (int i = c.tid; i < CW * W; i += NTHREADS) { const int j = i / W, ch = i % W; cw[j * W + ((ch >> 2) & 1) * 256 + (ch >> 3) * 4 + (ch & 3)] = cwg[i]; }
  __syncthreads();
  const int c0 = 8 * c.lane;
  const int gwv = c.bid * NWAVES + c.wave, NGW = c.G * NWAVES;
  float bias[8], lg[8], lb[8];
#pragma unroll
  for (int j = 0; j < 8; ++j) { bias[j] = c.in[IN_CB][l * W + c0 + j]; lg[j] = c.in[IN_LNG][l * W + c0 + j]; lb[j] = c.in[IN_LNB][l * W + c0 + j]; }
  constexpr int NPP = TP / 8;
  for (int p0 = 2 * gwv; p0 < NPP; p0 += 2 * NGW)
    for (int p = p0; p < p0 + 2 && p < NPP; ++p) { const int b = p / (SEQ / 8), t0 = (p % (SEQ / 8)) * 8; conv_pass(c, l, cw, b * SEQ, t0, 8, false, b, bias, lg, lb); }
  for (int q = NGW - 1 - gwv; q < DB * (DS / 2); q += NGW) { const int b = q / (DS / 2), t0 = (q % (DS / 2)) * 2; conv_pass(c, l, cw, TP + b * DS, t0, 2, true, b, bias, lg, lb); }
  __syncthreads();
}

constexpr int NUP = NSEQ_P * (SEQ / 32), NUA = NUP + NSEQ_S;
constexpr int NLONGW = (NSEQ_P * 129 + NSEQ_P * 128 + 1) / 2;
constexpr float SB_C2 = 0.08838834764831845f * 1.4426950408889634f;
constexpr float SB_RSTOP = 140.0f;
DI void attn_unit(const Ctx& c, int l, int u) {
  int lane_ = c.lane; OPAQUE_V(lane_);
  const int lane = lane_, r = lane & 31, h = lane >> 5;
  const bf16_t* P = (const bf16_t*)(c.ws + WS_P);
  int b, head, qrow0, qpos0, nq, kstart; bool sample;
  if (u < NUP) { const int sq = u / (SEQ / 32), qb = u % (SEQ / 32); b = sq / NH; head = sq % NH; qrow0 = b * SEQ + qb * 32; qpos0 = qb * 32; nq = 32; kstart = qb * 32; sample = false; }
  else { const int s = u - NUP; b = s / NH; head = s % NH; qrow0 = TP + b * DS; qpos0 = PAST; nq = DS; kstart = PAST; sample = true; }
  const int qrow = qrow0 + (r < nq ? r : nq - 1);
  const int qpos = qpos0 + r;
  bf16x8 qf[8];
#pragma unroll
  for (int s = 0; s < 8; ++s) qf[s] = *(const bf16x8*)(P + PIX(qrow, CB_QA) + head * HD + 16 * s + 8 * h);
  f32x16 o[4];
#pragma unroll
  for (int cc = 0; cc < 4; ++cc)
#pragma unroll
    for (int i = 0; i < 16; ++i) o[cc][i] = 0.f;
  float R = 0.f;
  LAS unsigned char* vt = c.scr;
  const float* ck = c.in[IN_CK]; const float* cv = c.in[IN_CV];
  for (int k0 = kstart; k0 >= 0; k0 -= 32) {
    const bool from_cache = sample && k0 < PAST;
    bf16x8 kf[8];
    if (!from_cache) {
      const int krow = sample ? TP + b * DS + (r < DS ? r : DS - 1) : b * SEQ + k0 + r;
#pragma unroll
      for (int s = 0; s < 8; ++s) kf[s] = *(const bf16x8*)(P + PIX(krow, CB_KA) + head * HD + 16 * s + 8 * h);
#pragma unroll
      for (int i = 0; i < 8; ++i) { const int n = lane + 64 * i, vr = n >> 4, ch = n & 15;
        const int vrow = sample ? TP + b * DS + (vr < DS ? vr : DS - 1) : b * SEQ + k0 + vr;
        *(LAS u32x4*)(vt + vr * TS272 + ch * 16) = *(const u32x4*)(P + PIX(vrow, CB_VA) + head * HD + ch * 8); }
    } else {
      const float* kp = ck + ((((size_t)l * DB + b) * PAST + (k0 + r)) * NH + head) * HD;
#pragma unroll
      for (int s = 0; s < 8; ++s) { const f32x4 a = *(const f32x4*)(kp + 16 * s + 8 * h), bb = *(const f32x4*)(kp + 16 * s + 8 * h + 4); kf[s] = pack8(a.x, a.y, a.z, a.w, bb.x, bb.y, bb.z, bb.w); }
#pragma unroll
      for (int i = 0; i < 8; ++i) { const int n = lane + 64 * i, vr = n >> 4, ch = n & 15;
        const float* vp = cv + ((((size_t)l * DB + b) * PAST + (k0 + vr)) * NH + head) * HD + ch * 8;
        const f32x4 a = *(const f32x4*)vp, bb = *(const f32x4*)(vp + 4);
        *(LAS bf16x8*)(vt + vr * TS272 + ch * 16) = pack8(a.x, a.y, a.z, a.w, bb.x, bb.y, bb.z, bb.w); }
    }
    f32x16 sacc;
#pragma unroll
    for (int i = 0; i < 16; ++i) sacc[i] = 0.f;
#pragma unroll
    for (int s = 0; s < 8; ++s) sacc = mfma32(kf[s], qf[s], sacc);
    float z2[16], sp[16];
#pragma unroll
    for (int i = 0; i < 16; ++i) {
      const bool ok = (k0 + crow(i, h)) < qpos;
      z2[i] = fminf(sacc[i] * SB_C2, 126.0f);
      sp[i] = ok ? lg2(1.0f + ex2(z2[i])) : 0.0f;
      z2[i] = ok ? z2[i] : -1e30f;
    }
    float gs[4], pg[4];
#pragma unroll
    for (int j = 0; j < 4; ++j) { gs[j] = (sp[4 * j] + sp[4 * j + 1]) + (sp[4 * j + 2] + sp[4 * j + 3]); pg[j] = wshfl_xor(gs[j], 32, lane); }
    float after = 0.f, wgt[16];
#pragma unroll
    for (int j = 3; j >= 0; --j) {
      float run = after + (h == 0 ? pg[j] : 0.f) + R;
#pragma unroll
      for (int ii = 3; ii >= 0; --ii) { run += sp[4 * j + ii]; wgt[4 * j + ii] = ex2(z2[4 * j + ii] - run); }
      after += (h == 0) ? (gs[j] + pg[j]) : (pg[j] + gs[j]);
    }
    R += after;
    const bf16x8 pf0 = pack8(wgt[0], wgt[1], wgt[2], wgt[3], wgt[4], wgt[5], wgt[6], wgt[7]);
    const bf16x8 pf1 = pack8(wgt[8], wgt[9], wgt[10], wgt[11], wgt[12], wgt[13], wgt[14], wgt[15]);
    LDS_WAIT();
#pragma unroll
    for (int cc = 0; cc < 4; ++cc) {
      const bf16x8 v0 = tr_frag(vt, TS272, 4 * h, 8 + 4 * h, 32 * cc, lane);
      const bf16x8 v1 = tr_frag(vt, TS272, 16 + 4 * h, 24 + 4 * h, 32 * cc, lane);
      o[cc] = mfma32(pf0, v0, o[cc]);
      o[cc] = mfma32(pf1, v1, o[cc]);
    }
    const float rmin = wave_min(r < nq ? R : 1e30f, lane);
    if (rmin >= SB_RSTOP) break;
  }
  bf16_t* YC = (bf16_t*)(c.ws + WS_YCAT);
  LAS float* ot = (LAS float*)c.scr;
  LDS_WAIT();
  o_to_lds(o, ot, r, h);
  LDS_WAIT();
#pragma unroll
  for (int i = 0; i < 8; ++i) {
    const int q = lane + 64 * i, t = q >> 4, ch = q & 15;
    if (t < nq) {
      const size_t row = (size_t)(qrow0 + t);
      const int col = head * HD + 8 * ch;
      const f32x4 x0 = *(const LAS f32x4*)(ot + t * OT_STRIDE + 8 * ch), x1 = *(const LAS f32x4*)(ot + t * OT_STRIDE + 8 * ch + 4);
      float za[8]; unpack8(*(const u32x4*)(P + PIX(row, CB_ZA) + col), za);
      u32x4 w; w.x = pk2(x0.x * silu_f(za[0]), x0.y * silu_f(za[1])); w.y = pk2(x0.z * silu_f(za[2]), x0.w * silu_f(za[3]));
      w.z = pk2(x1.x * silu_f(za[4]), x1.y * silu_f(za[5])); w.w = pk2(x1.z * silu_f(za[6]), x1.w * silu_f(za[7]));
      *(u32x4*)(YC + row * D + col) = w;
    }
  }
  LDS_WAIT();
}

DI bf16_t* st_ptr(const Ctx& c, int br, int ck) { return (bf16_t*)(c.ws + WS_ST + ((size_t)br * NCHUNK + ck) * ST_BYTES); }
DI bf16_t* st2_ptr(const Ctx& c, int br, int ck) { return (bf16_t*)(c.ws + WS_ST2 + ((size_t)br * NCHUNK + ck) * ST_BYTES); }
template <int BR> DI void scan_local_unit(const Ctx& c, int l, int ck, int eb) {
  int lane_ = c.lane; OPAQUE_V(lane_);
  const int lane = lane_, r = lane & 31, h = lane >> 5;
  const ChunkGeo g = chunk_geo(ck);
  const bf16_t* P = (const bf16_t*)(c.ws + WS_P);
  LAS unsigned char* kt = c.scr;
  LAS unsigned char* vtl = c.scr + 64 * 144;
  LAS float* wtab = (LAS float*)(c.scr + 64 * 144 + 64 * 80);
  constexpr int KS = 144, VS = 80;
  const int kcb = BR == 0 ? CB_KB : CB_KC, vcb = BR == 0 ? CB_VB : CB_VC;
  const float* rope = (const float*)(c.ws + WS_ROPE);
  u32x4 kx1[8], kx2[8], vv[4];
#pragma unroll
  for (int i = 0; i < 8; ++i) {
    const int n = lane + 64 * i, s = n >> 3, ch = n & 7;
    const bf16_t* kp = P + PIX(g.row0 + (s < g.L ? s : g.L - 1), kcb) + g.h * HD;
    kx1[i] = *(const u32x4*)(kp + ch * 8); kx2[i] = *(const u32x4*)(kp + 64 + ch * 8);
  }
#pragma unroll
  for (int i = 0; i < 4; ++i) {
    const int n = lane + 64 * i, s = n >> 2, ch = n & 3;
    const int row = g.row0 + (s < g.L ? s : g.L - 1);
    if (eb < 4) vv[i] = *(const u32x4*)(P + PIX(row, vcb) + g.h * HD + eb * 32 + ch * 8);
    else vv[i] = (u32x4){ch == 0 ? 0x00003F80u : 0u, 0u, 0u, 0u};
  }
  {
    const int s = lane; float w;
    if (BR == 0) {
      const float* LFp = (const float*)(c.ws + WS_LF); const float* IGp = (const float*)(c.ws + WS_IG);
      const float lf = s < g.L ? LFp[(size_t)(g.row0 + s) * 4 + g.h] : 0.f;
      const float ig = s < g.L ? IGp[(size_t)(g.row0 + s) * 4 + g.h] : -1e30f;
      const float bcum = wave_prefix_sum(lf, lane);
      const float Bc = wshfl(bcum, 63);
      const float gg = Bc - bcum + ig;
      const float G = wave_max(gg, lane);
      w = s < g.L ? __expf(gg - G) : 0.f;
      if (eb == 0 && lane == 0) { ((float*)(c.ws + WS_SCB))[ck] = Bc; ((float*)(c.ws + WS_SCG))[ck] = G; }
    } else {
      w = s < g.L ? exp2f(ret_log2gamma(g.h) * (float)(g.L - 1 - s)) : 0.f;
    }
    wtab[s] = w * 0.08838834764831845f;
  }
#pragma unroll
  for (int i = 0; i < 4; ++i) { const int n = lane + 64 * i, s = n >> 2, ch = n & 3; *(LAS u32x4*)(vtl + s * VS + ch * 16) = vv[i]; }
  LDS_WAIT();
  f32x16 acc[4];
#pragma unroll
  for (int cc = 0; cc < 4; ++cc)
#pragma unroll
    for (int i = 0; i < 16; ++i) acc[cc][i] = 0.f;
  bf16x8 af[4];
#pragma unroll
  for (int ks = 0; ks < 4; ++ks) af[ks] = tr_frag(vtl, VS, 16 * ks + 8 * h, 16 * ks + 8 * h + 4, 0, lane);
#pragma unroll
  for (int dh = 0; dh < 2; ++dh) {
#pragma unroll
    for (int i = 0; i < 8; ++i) {
      const int n = lane + 64 * i, s = n >> 3, ch = n & 7;
      float o[8];
      if (BR == 0) { unpack8(dh == 0 ? kx1[i] : kx2[i], o); }
      else {
        float x1[8], x2[8]; unpack8(kx1[i], x1); unpack8(kx2[i], x2);
        const float* cs = rope + ((size_t)(seq_pos0(g) + (s < g.L ? s : g.L - 1)) * 64 + ch * 8) * 2;
#pragma unroll
        for (int j = 0; j < 8; ++j) { const float co = cs[2 * j], si = cs[2 * j + 1]; o[j] = dh == 0 ? x1[j] * co - x2[j] * si : x1[j] * si + x2[j] * co; }
      }
      const float w = wtab[s];
      *(LAS bf16x8*)(kt + s * KS + ch * 16) = pack8(o[0] * w, o[1] * w, o[2] * w, o[3] * w, o[4] * w, o[5] * w, o[6] * w, o[7] * w);
      if (BR == 1 && (i & 1)) asm volatile("" ::: "memory");
    }
    LDS_WAIT();
#pragma unroll
    for (int ks = 0; ks < 4; ++ks)
#pragma unroll
      for (int cc = 0; cc < 2; ++cc) {
        const bf16x8 bfr = tr_frag(kt, KS, 16 * ks + 8 * h, 16 * ks + 8 * h + 4, 32 * cc, lane);
        acc[2 * dh + cc] = mfma32(af[ks], bfr, acc[2 * dh + cc]);
      }
    LDS_WAIT();
  }
  LAS float* ot = (LAS float*)c.scr;
  o_to_lds(acc, ot, r, h);
  LDS_WAIT();
  bf16_t* st = st_ptr(c, BR, ck);
#pragma unroll
  for (int i = 0; i < 8; ++i) {
    const int q = lane + 64 * i, t = q >> 4, ch = q & 15, e = 32 * eb + t;
    if (e <= 128) {
      const f32x4 x0 = *(const LAS f32x4*)(ot + t * OT_STRIDE + 8 * ch), x1 = *(const LAS f32x4*)(ot + t * OT_STRIDE + 8 * ch + 4);
      u32x4 w; w.x = pk2(x0.x, x0.y); w.y = pk2(x0.z, x0.w); w.z = pk2(x1.x, x1.y); w.w = pk2(x1.z, x1.w);
      *(u32x4*)(st + (size_t)e * HD + 8 * ch) = w;
    }
  }
  LDS_WAIT();
}

DI void scan_prop_item(const Ctx& c, int l, int it) {
  constexpr int NLP = NSEQ_P * 129 + NSEQ_P * 128, NTOT = NSEQ * 129 + NSEQ * 128;
  const bool live = it < NTOT;
  if (!live) it = NTOT - 1;
  int br, sq, e;
  if (it < NLP) { if (it < NSEQ_P * 129) { br = 0; sq = it / 129; e = it % 129; } else { const int j = it - NSEQ_P * 129; br = 1; sq = j / 128; e = j % 128; } }
  else { const int j = it - NLP; if (j < NSEQ_S * 129) { br = 0; sq = NSEQ_P + j / 129; e = j % 129; } else { const int k = j - NSEQ_S * 129; br = 1; sq = NSEQ_P + k / 128; e = k % 128; } }
  const int d0 = 4 * (c.lane & 31);
  const bool sample = sq >= NSEQ_P;
  const int b = sample ? (sq - NSEQ_P) / NH : sq / NH, h = sample ? (sq - NSEQ_P) % NH : sq % NH;
  const int nch = sample ? 1 : NCH_P, ck0 = sample ? NSEQ_P * NCH_P + (sq - NSEQ_P) : sq * NCH_P;
  const int L = sample ? DS : 64;
  float s[4] = {0.f, 0.f, 0.f, 0.f}; float m = 0.f;
  if (sample) {
    if (br == 0) {
      if (e < 128) { const float* C0 = c.in[IN_MC] + (((size_t)l * DB + b) * NH + h) * HD * HD;
#pragma unroll
        for (int j = 0; j < 4; ++j) s[j] = C0[(size_t)(d0 + j) * HD + e]; }
      else { const float* n0 = c.in[IN_MN] + (((size_t)l * DB + b) * NH + h) * HD;
#pragma unroll
        for (int j = 0; j < 4; ++j) s[j] = n0[d0 + j]; }
      m = c.in[IN_MM][((size_t)l * DB + b) * NH + h];
    } else { const float* S0 = c.in[IN_RS] + (((size_t)l * DB + b) * NH + h) * HD * HD;
#pragma unroll
      for (int j = 0; j < 4; ++j) s[j] = S0[(size_t)(d0 + j) * HD + e]; }
  }
  const float* SCB = (const float*)(c.ws + WS_SCB); const float* SCG = (const float*)(c.ws + WS_SCG); float* MCp = (float*)(c.ws + WS_MC);
  const float cdec = br == 1 ? exp2f(ret_log2gamma(h) * (float)L) : 0.f;
  constexpr int PB = 32;
  const int hl = c.lane & 31, hbase = c.lane & 32;
  LAS float* tab = (LAS float*)c.scr + 2 * hbase;
  if (nch == 1) {
    const int ck = ck0;
    const u32x2 dv1 = *(const u32x2*)(st_ptr(c, br, ck) + (size_t)e * HD + d0);
    const float q0 = bits_f(dv1.x << 16), q1 = bits_f(dv1.x & 0xffff0000u), q2 = bits_f(dv1.y << 16), q3 = bits_f(dv1.y & 0xffff0000u);
    if (live) *(u32x2*)(st2_ptr(c, br, ck) + (size_t)e * HD + d0) = (u32x2){pk2(s[0], s[1]), pk2(s[2], s[3])};
    if (br == 0) {
      const float Bl = SCB[ck], Gl = SCG[ck], m_out = fmaxf(m + Bl, Gl), dec = __expf(m + Bl - m_out), inj = __expf(Gl - m_out);
      if (live && e == 0 && hl == 0) MCp[ck] = m;
      s[0] = dec * s[0] + inj * q0; s[1] = dec * s[1] + inj * q1; s[2] = dec * s[2] + inj * q2; s[3] = dec * s[3] + inj * q3; m = m_out;
    } else { s[0] = cdec * s[0] + q0; s[1] = cdec * s[1] + q1; s[2] = cdec * s[2] + q2; s[3] = cdec * s[3] + q3; }
  } else
  for (int ci0 = 0; ci0 < nch; ci0 += PB) {
    u32x2 dv[PB];
#pragma unroll
    for (int j = 0; j < PB; ++j) {
      const int ck = ck0 + (ci0 + j < nch ? ci0 + j : nch - 1);
      dv[j] = *(const u32x2*)(st_ptr(c, br, ck) + (size_t)e * HD + d0);
    }
    if (br == 0) {
      const bool okc = ci0 + hl < nch;
      const int ckl = ck0 + (okc ? ci0 + hl : nch - 1);
      const float Bl = okc ? SCB[ckl] : 0.f, Gl = okc ? SCG[ckl] : -1e30f;
      float BB = Bl, GG = Gl;
#pragma unroll
      for (int o = 1; o < 32; o <<= 1) {
        const float pb = wshfl(BB, hbase + (hl >= o ? hl - o : hl)), pg = wshfl(GG, hbase + (hl >= o ? hl - o : hl));
        if (hl >= o) { GG = fmaxf(pg + BB, GG); BB = pb + BB; }
      }
      const float m_out = fmaxf(m + BB, GG);
      float m_in = wshfl(m_out, hbase + (hl > 0 ? hl - 1 : 0)); if (hl == 0) m_in = m;
      tab[2 * hl] = __expf(m_in + Bl - m_out); tab[2 * hl + 1] = __expf(Gl - m_out);
      if (live && okc && e == 0) MCp[ckl] = m_in;
      m = wshfl(m_out, hbase + 31);
      LDS_WAIT();
    }
#pragma unroll
    for (int j = 0; j < PB; ++j) {
      if (ci0 + j < nch) {
        const int ck = ck0 + ci0 + j;
        const float q0 = bits_f(dv[j].x << 16), q1 = bits_f(dv[j].x & 0xffff0000u), q2 = bits_f(dv[j].y << 16), q3 = bits_f(dv[j].y & 0xffff0000u);
        if (live) *(u32x2*)(st2_ptr(c, br, ck) + (size_t)e * HD + d0) = (u32x2){pk2(s[0], s[1]), pk2(s[2], s[3])};
        if (br == 0) { const float dec = tab[2 * j], inj = tab[2 * j + 1];
          s[0] = dec * s[0] + inj * q0; s[1] = dec * s[1] + inj * q1; s[2] = dec * s[2] + inj * q2; s[3] = dec * s[3] + inj * q3; }
        else { s[0] = cdec * s[0] + q0; s[1] = cdec * s[1] + q1; s[2] = cdec * s[2] + q2; s[3] = cdec * s[3] + q3; }
      }
    }
    LDS_WAIT();
  }
  if (!live) return;
  if (br == 0) {
    if (e < 128) { float* o = c.out + (sample ? O_SC + (((size_t)l * DB + b) * NH + h) * HD * HD : O_PC + (((size_t)l * NBATCH + b) * NH + h) * HD * HD);
#pragma unroll
      for (int j = 0; j < 4; ++j) o[(size_t)(d0 + j) * HD + e] = s[j]; }
    else { float* o = c.out + (sample ? O_SN + (((size_t)l * DB + b) * NH + h) * HD : O_PN + (((size_t)l * NBATCH + b) * NH + h) * HD); *(f32x4*)(o + d0) = (f32x4){s[0], s[1], s[2], s[3]}; }
    if (e == 0 && (c.lane & 31) == 0) c.out[(sample ? O_SM + ((size_t)l * DB + b) * NH + h : O_PM + ((size_t)l * NBATCH + b) * NH + h)] = m;
  } else {
    float* o = c.out + (sample ? O_SS + (((size_t)l * DB + b) * NH + h) * HD * HD : O_PS + (((size_t)l * NBATCH + b) * NH + h) * HD * HD);
#pragma unroll
    for (int j = 0; j < 4; ++j) o[(size_t)(d0 + j) * HD + e] = s[j];
  }
}

template <int BR> DI void scan_apply_unit(const Ctx& c, int l, int ck, int th) {
  int lane_ = c.lane; OPAQUE_V(lane_);
  const int lane = lane_, r = lane & 31, h = lane >> 5;
  const ChunkGeo g = chunk_geo(ck);
  if (32 * th >= g.L) return;
  const bf16_t* P = (const bf16_t*)(c.ws + WS_P);
  LAS unsigned char* vt = c.scr;
  LAS float* tb = (LAS float*)(c.scr + 64 * TS272);
  LAS float* t_a = tb; LAS float* t_w = tb + 64; LAS float* t_0 = tb + 128; LAS float* t_1 = tb + 160; LAS float* t_2 = tb + 192;
  const int qcb = BR == 0 ? CB_QB : CB_QC, kcb = BR == 0 ? CB_KB : CB_KC, vcb = BR == 0 ? CB_VB : CB_VC;
  const float* rope = (const float*)(c.ws + WS_ROPE);
  const int pos0 = seq_pos0(g);
  const float l2g = ret_log2gamma(g.h);
  const int tq = 32 * th + r, tqc = tq < g.L ? tq : g.L - 1;
  bf16x8 qf[8];
  u32x4 vreg[16];
#pragma unroll
  for (int s = 0; s < 8; ++s) qf[s] = *(const bf16x8*)(P + PIX(g.row0 + tqc, qcb) + g.h * HD + 16 * s + 8 * h);
#pragma unroll
  for (int i = 0; i < 16; ++i) { const int n = lane + 64 * i, s = n >> 4, ch = n & 15; const int row = g.row0 + (s < g.L ? s : g.L - 1);
    vreg[i] = *(const u32x4*)(P + PIX(row, vcb) + g.h * HD + ch * 8); }
  float Mt = 0.f;
  {
    const int s = lane;
    if (BR == 0) {
      const float* LFp = (const float*)(c.ws + WS_LF); const float* IGp = (const float*)(c.ws + WS_IG);
      const float lf = s < g.L ? LFp[(size_t)(g.row0 + s) * 4 + g.h] : 0.f;
      const float ig = s < g.L ? IGp[(size_t)(g.row0 + s) * 4 + g.h] : -1e30f;
      const float bcum = wave_prefix_sum(lf, lane);
      const float a = ig - bcum;
      const float pm = wave_prefix_max(a, lane);
      const float mc = ((const float*)(c.ws + WS_MC))[ck];
      const float M = fmaxf(mc, pm);
      t_a[s] = a;
      if ((s >> 5) == th) { t_0[s & 31] = __expf(mc - M); t_1[s & 31] = __expf(-(bcum + M)); }
      Mt = wshfl(M, 32 * th + r);
    } else {
      t_w[s] = exp2f(-l2g * (float)s);
      if ((s >> 5) == th) t_0[s & 31] = exp2f(l2g * (float)(s + 1));
    }
  }
  if (BR == 1) rotary_frags(qf, rope + (size_t)(pos0 + tqc) * 128, h);
#pragma unroll
  for (int i = 0; i < 16; ++i) { const int n = lane + 64 * i, s = n >> 4, ch = n & 15; *(LAS u32x4*)(vt + s * TS272 + ch * 16) = vreg[i]; }
  LDS_WAIT();
  constexpr int NB = BR == 0 ? 5 : 4;
  f32x16 acc[NB];
  const bf16_t* st = st2_ptr(c, BR, ck);
#pragma unroll
  for (int cc = 0; cc < NB; ++cc) {
#pragma unroll
    for (int i = 0; i < 16; ++i) acc[cc][i] = 0.f;
#pragma unroll
    for (int s = 0; s < 8; ++s) { const bf16x8 bfr = *(const bf16x8*)(st + (size_t)(32 * cc + r) * HD + 16 * s + 8 * h); acc[cc] = mfma32(qf[s], bfr, acc[cc]); }
  }
  {
    float sc[16];
#pragma unroll
    for (int i = 0; i < 16; ++i) sc[i] = t_0[crow(i, h)];
#pragma unroll
    for (int cc = 0; cc < NB; ++cc)
#pragma unroll
      for (int i = 0; i < 16; ++i) acc[cc][i] *= sc[i];
  }
  const float gt = BR == 1 ? exp2f(l2g * (float)tq) : 0.f;
  for (int kb = 0; kb <= th; ++kb) {
    bf16x8 kf[8];
    const int sk = 32 * kb + r, skc = sk < g.L ? sk : g.L - 1;
#pragma unroll
    for (int s = 0; s < 8; ++s) kf[s] = *(const bf16x8*)(P + PIX(g.row0 + skc, kcb) + g.h * HD + 16 * s + 8 * h);
    if (BR == 1) rotary_frags(kf, rope + (size_t)(pos0 + skc) * 128, h);
    f32x16 sacc;
#pragma unroll
    for (int i = 0; i < 16; ++i) sacc[i] = 0.f;
#pragma unroll
    for (int s = 0; s < 8; ++s) sacc = mfma32(kf[s], qf[s], sacc);
    float wv[16];
#pragma unroll
    for (int i = 0; i < 16; ++i) {
      const int s = 32 * kb + crow(i, h);
      const bool ok = s <= tq && s < g.L;
      float w;
      if (BR == 0) w = __expf(fminf(t_a[s] - Mt, 0.f)) * sacc[i] * 0.08838834764831845f;
      else w = sacc[i] * 0.08838834764831845f * gt * t_w[s];
      wv[i] = ok ? w : 0.f;
    }
    const bf16x8 pf0 = pack8(wv[0], wv[1], wv[2], wv[3], wv[4], wv[5], wv[6], wv[7]);
    const bf16x8 pf1 = pack8(wv[8], wv[9], wv[10], wv[11], wv[12], wv[13], wv[14], wv[15]);
#pragma unroll
    for (int cc = 0; cc < 4; ++cc) {
      const bf16x8 v0 = tr_frag(vt, TS272, 32 * kb + 4 * h, 32 * kb + 8 + 4 * h, 32 * cc, lane);
      const bf16x8 v1 = tr_frag(vt, TS272, 32 * kb + 16 + 4 * h, 32 * kb + 24 + 4 * h, 32 * cc, lane);
      acc[cc] = mfma32(pf0, v0, acc[cc]);
      acc[cc] = mfma32(pf1, v1, acc[cc]);
    }
    if (BR == 0) {
      const bf16x8 ones = r == 0 ? (bf16x8){0x3F80, 0x3F80, 0x3F80, 0x3F80, 0x3F80, 0x3F80, 0x3F80, 0x3F80} : (bf16x8){0, 0, 0, 0, 0, 0, 0, 0};
      acc[NB - 1] = mfma32(pf0, ones, acc[NB - 1]);
      acc[NB - 1] = mfma32(pf1, ones, acc[NB - 1]);
    }
  }
  if (BR == 0) {
    if (r == 0) {
#pragma unroll
      for (int i = 0; i < 16; ++i) t_2[crow(i, h)] = acc[NB - 1][i];
    }
    LDS_WAIT();
#pragma unroll
    for (int i = 0; i < 16; ++i) {
      const int t = crow(i, h);
      const float dn = fmaxf(fabsf(t_2[t]), t_1[t]);
      const float inv = 1.0f / dn;
#pragma unroll
      for (int cc = 0; cc < 4; ++cc) acc[cc][i] *= inv;
    }
  }
  bf16_t* YC = (bf16_t*)(c.ws + WS_YCAT);
  LAS float* ot = (LAS float*)c.scr;
  LDS_WAIT();
  o_to_lds(acc, ot, r, h);
  LDS_WAIT();
  {
    const LAS float* rp = ot + r * OT_STRIDE + 64 * h;
    float s1 = 0.f, s2 = 0.f;
#pragma unroll
    for (int k = 0; k < 16; ++k) { const f32x4 x = *(const LAS f32x4*)(rp + 4 * k); s1 += (x.x + x.y) + (x.z + x.w); s2 += (x.x * x.x + x.y * x.y) + (x.z * x.z + x.w * x.w); }
    s1 += wshfl_xor(s1, 32, lane); s2 += wshfl_xor(s2, 32, lane);
    const float mean = s1 * (1.0f / HD), var = fmaxf(s2 * (1.0f / HD) - mean * mean, 0.f);
    if (h == 0) { t_0[r] = mean; t_1[r] = 1.0f / sqrtf(var + 1e-5f); }
  }
  LDS_WAIT();
#pragma unroll
  for (int i = 0; i < 8; ++i) {
    const int q = lane + 64 * i, t = q >> 4, ch = q & 15;
    if (32 * th + t < g.L) {
      const size_t row = (size_t)(g.row0 + 32 * th + t);
      const int col = g.h * HD + 8 * ch;
      const f32x4 x0 = *(const LAS f32x4*)(ot + t * OT_STRIDE + 8 * ch), x1 = *(const LAS f32x4*)(ot + t * OT_STRIDE + 8 * ch + 4);
      const float mean = t_0[t], rstd = t_1[t];
      float y[8] = {(x0.x - mean) * rstd, (x0.y - mean) * rstd, (x0.z - mean) * rstd, (x0.w - mean) * rstd, (x1.x - mean) * rstd, (x1.y - mean) * rstd, (x1.z - mean) * rstd, (x1.w - mean) * rstd};
      if (BR == 0) {
        float ob[8], zb[8]; unpack8(*(const u32x4*)(P + PIX(row, CB_OB) + col), ob); unpack8(*(const u32x4*)(P + PIX(row, CB_ZB) + col), zb);
#pragma unroll
        for (int j = 0; j < 8; ++j) y[j] *= sigmoid_f(ob[j]) * silu_f(zb[j]);
      } else {
        float zc[8]; unpack8(*(const u32x4*)(P + PIX(row, CB_ZC) + col), zc);
#pragma unroll
        for (int j = 0; j < 8; ++j) y[j] *= silu_f(zc[j]);
      }
      u32x4 w; w.x = pk2(y[0], y[1]); w.y = pk2(y[2], y[3]); w.z = pk2(y[4], y[5]); w.w = pk2(y[6], y[7]);
      *(u32x4*)(YC + row * D + (BR == 0 ? 1 : 2) * W + col) = w;
    }
  }
  LDS_WAIT();
}

template <int MODE> DI void sample_tail_gemm(const Ctx& c, int l, const bf16_t* Wt  , const bf16_t* Act  ) {
  int lane_ = c.lane; OPAQUE_V(lane_);
  const int lane = lane_, r = lane & 31, h = lane >> 5, wv = c.wave, tw = wv & 3, kh = wv >> 2;
  const bf16_t* P = (const bf16_t*)(c.ws + WS_P);
  constexpr int NTILE = (TS / 32) * (D / 32);
  LAS float* xch = (LAS float*)(c.lds) + tw * 1024;
  for (int tb = c.bid; tb * 4 < NTILE; tb += c.G) {
    const int tile = tb * 4 + tw, tt = tile / (D / 32), nn = tile % (D / 32);
    const int t0 = 32 * tt, n0 = 32 * nn;
    const bf16_t* ap = Wt + (size_t)(n0 + r) * D + kh * 1024 + 8 * h;
    const bf16_t* bp = Act + (size_t)(t0 + r) * D + kh * 1024 + 8 * h;
    f32x16 acc;
#pragma unroll
    for (int i = 0; i < 16; ++i) acc[i] = 0.f;
    const size_t grow = (size_t)(TP + t0 + r);
#pragma unroll 1
    for (int sg = 0; sg < 2; ++sg) {
#pragma unroll 1
      for (int k0 = 0; k0 < 32; k0 += 8) {
        bf16x8 af[8], bf[8];
#pragma unroll
        for (int q = 0; q < 8; ++q) { af[q] = *(const bf16x8*)(ap + (sg * 32 + k0 + q) * 16); bf[q] = *(const bf16x8*)(bp + (sg * 32 + k0 + q) * 16); }
#pragma unroll
        for (int q = 0; q < 8; ++q) acc = mfma32(af[q], bf[q], acc);
      }
      if (MODE == 0) {
        const int br = 2 * kh + sg;
#pragma unroll
        for (int g4 = 0; g4 < 4; ++g4) {
          const int n = n0 + 8 * g4 + 4 * h;
          const u32x2 ea = *(const u32x2*)(P + PIX(grow, CB_G0 + 4 * br + (n >> 9)) + (n & 511));
          float e0[4] = {bits_f(ea.x << 16), bits_f(ea.x & 0xffff0000u), bits_f(ea.y << 16), bits_f(ea.y & 0xffff0000u)};
          float sc[4];
          if (sg == 0) {
            const u32x2 eb = *(const u32x2*)(P + PIX(grow, CB_G0 + 4 * (br + 1) + (n >> 9)) + (n & 511));
            const float e1[4] = {bits_f(eb.x << 16), bits_f(eb.x & 0xffff0000u), bits_f(eb.y << 16), bits_f(eb.y & 0xffff0000u)};
#pragma unroll
            for (int j = 0; j < 4; ++j) sc[j] = e1[j] * frcp(e0[j]);
          } else {
#pragma unroll
            for (int j = 0; j < 4; ++j) sc[j] = frcp(e0[j]);
          }
#pragma unroll
          for (int j = 0; j < 4; ++j) acc[4 * g4 + j] *= sc[j];
        }
      }
    }
    if (kh == 1) {
#pragma unroll
      for (int i = 0; i < 16; ++i) xch[i * 64 + lane] = acc[i];
    }
    __syncthreads();
    if (kh == 0) {
#pragma unroll
      for (int i = 0; i < 16; ++i) acc[i] += xch[i * 64 + lane];
#pragma unroll
      for (int g4 = 0; g4 < 4; ++g4) {
        const int n = n0 + 8 * g4 + 4 * h;
        if (MODE == 0) {
          bf16_t* o = (bf16_t*)(c.ws + WS_MG) + grow * D + n;
          *(u32x2*)o = (u32x2){pk2(acc[4 * g4], acc[4 * g4 + 1]), pk2(acc[4 * g4 + 2], acc[4 * g4 + 3])};
        } else {
          const float* xin = (l == 0) ? c.in[IN_XS] + (size_t)(t0 + r) * D + n : c.out + O_Y + grow * D + n;
          const f32x4 xv = *(const f32x4*)xin;
          *(f32x4*)(c.out + O_Y + grow * D + n) = (f32x4){xv.x + acc[4 * g4], xv.y + acc[4 * g4 + 1], xv.z + acc[4 * g4 + 2], xv.w + acc[4 * g4 + 3]};
        }
      }
    }
    __syncthreads();
  }
}

DI void phase_final(const Ctx& c) {
  const float* fg = c.in[IN_FG];
  const int gwv = c.bid * NWAVES + c.wave, NGW = c.G * NWAVES, lane = c.lane;
  f32x4 gv[8];
#pragma unroll
  for (int j = 0; j < 8; ++j) gv[j] = *(const f32x4*)(fg + 256 * j + 4 * lane);
  for (int r = gwv; r < T; r += NGW) {
    float* xr = c.out + O_Y + (size_t)r * D;
    f32x4 v[8]; float ss = 0.f;
#pragma unroll
    for (int j = 0; j < 8; ++j) { v[j] = *(const f32x4*)(xr + 256 * j + 4 * lane); ss += (v[j].x * v[j].x + v[j].y * v[j].y) + (v[j].z * v[j].z + v[j].w * v[j].w); }
    const float rstd = 1.0f / sqrtf(wave_sum(ss, lane) * (1.0f / D) + 1e-6f);
#pragma unroll
    for (int j = 0; j < 8; ++j) *(f32x4*)(xr + 256 * j + 4 * lane) = v[j] * rstd * gv[j];
  }
}

constexpr int PH_PRO = 0, PH_PER_LAYER = 7, PH_FINAL = 1 + DEPTH * PH_PER_LAYER, PH_COUNT = PH_FINAL + 1;
constexpr int CW_BAR = 4096;

__global__ void __launch_bounds__(NTHREADS, 2) fwd(Args args) {
  DYN_LDS(lds);
  Ctx c;
  c.lds = lds; c.tid = threadIdx.x; c.lane = c.tid & 63; c.wave = rfl(c.tid >> 6); c.G = gridDim.x; c.bid = blockIdx.x;
  const int wave_s = c.wave; (void)wave_s;
  c.scr = lds + c.wave * WSCR;
#pragma unroll
  for (int i = 0; i < 20; ++i) c.in[i] = args.in[i];
  c.out = args.out; c.ws = args.ws;
  const int lo = args.ph_lo, hi = args.ph_hi;
#ifndef EMU
  if (c.tid < 16) ((LAS unsigned*)(lds + LDSCTL_OFF))[c.tid] = 0u;
  __syncthreads();
  XcdBarrier bar = xcd_barrier_post((unsigned*)(c.ws + WS_CTL) + CW_BAR, (volatile LAS unsigned*)(lds + LDSCTL_OFF));
#define GRID_BAR() xcd_barrier(bar)
#else
#define GRID_BAR() do {} while (0)
#endif
#ifndef PHMASK
#define PHMASK 0x1FF
#endif
#define KIND(kk) ((PHMASK >> (kk)) & 1)
#ifndef REP_NORM
#define REP_NORM 1
#endif
#ifndef REP_INPROJ
#define REP_INPROJ 1
#endif
#ifndef REP_MIX1
#define REP_MIX1 1
#endif
#ifndef REP_MIX3
#define REP_MIX3 1
#endif
#ifndef REP_MERGE
#define REP_MERGE 1
#endif
#ifdef EMU
#define LAUNDER() do {} while (0)
#else
#define LAUNDER() do { unsigned m_ = ~0u; int w_ = wave_s; asm volatile("" : "+s"(m_), "+s"(w_));   \
    c.lane = (int)__builtin_amdgcn_mbcnt_hi(m_, __builtin_amdgcn_mbcnt_lo(m_, 0u)); c.wave = w_; c.tid = w_ * 64 + c.lane; c.scr = lds + w_ * WSCR; } while (0)
#endif
#define IN(k) (lo <= (k) && (k) < hi)
#define SEAM(k) do { if (hi > (k) + 1) GRID_BAR(); } while (0)

  #ifndef REP_PRO
#define REP_PRO 1
#endif
  if (KIND(0) && IN(PH_PRO)) { _Pragma("unroll 1") for (int rp = 0; rp < REP_PRO; ++rp) { LAUNDER(); phase_prologue(c); } __syncthreads();   }

  for (int l = 0; l < DEPTH; ++l) {
    const int pb = 1 + l * PH_PER_LAYER;
    if (KIND(1) && IN(pb + 0)) { _Pragma("unroll 1") for (int rep = 0; rep < REP_NORM; ++rep) { LAUNDER(); phase_norm(c, l); SEAM(pb + 0); } }
    if (KIND(2) && IN(pb + 1)) _Pragma("unroll 1") for (int rep = 0; rep < REP_INPROJ; ++rep) { LAUNDER();
      pg8::Gemm g{(const bf16_t*)(c.ws + WS_HIN), (const bf16_t*)(c.ws + WS_WIN) + (size_t)l * NP * D, T, NP, D, D, D, 0, 0};
      pg8::StaticOrder S; S.init(T, NP, c.G, c.bid);
      EpiInproj E{(bf16_t*)(c.ws + WS_P), c.out, l};
      pg8::gemm_phase<EpiInproj, pg8::StaticOrder, true>(lds, g, S, E, c.tid);
      SEAM(pb + 1);
    }
    if (KIND(3) && IN(pb + 2)) _Pragma("unroll 1") for (int rep = 0; rep < REP_MIX1; ++rep) { LAUNDER();
#ifndef SUBMASK
#define SUBMASK 15
#endif
#ifndef REP_CONV
#define REP_CONV 1
#endif
#ifndef REP_ATTN
#define REP_ATTN 1
#endif
#ifndef REP_LOC
#define REP_LOC 1
#endif
      _Pragma("unroll 1") for (int rp = 0; rp < REP_CONV; ++rp) phase_conv(c, l);
      const int gwv = c.bid * NWAVES + c.wave, NGW = c.G * NWAVES;
      { const int NF = NGW > NLONGW ? NGW - NLONGW : 0, ND = NF < NUA / 2 ? NF : NUA / 2;
        _Pragma("unroll 1") for (int rp = 0; rp < REP_ATTN; ++rp) for (int u = gwv; u < NUA - ND; u += NGW) attn_unit(c, l, u); }
      _Pragma("unroll 1") for (int rp = 0; rp < REP_LOC; ++rp) {
      for (int u = (gwv + (NGW * 9) / 16) % NGW; u < NCHUNK * 5; u += NGW) scan_local_unit<0>(c, l, u / 5, u % 5);
      for (int u = (gwv + (NGW * 14) / 16) % NGW; u < NCHUNK * 4; u += NGW) scan_local_unit<1>(c, l, u >> 2, u & 3); }
      SEAM(pb + 2);
    }
    #ifndef REP_MIX2
#define REP_MIX2 1
#endif
    if (KIND(4) && IN(pb + 3)) _Pragma("unroll 1") for (int rp = 0; rp < REP_MIX2; ++rp) { LAUNDER();
      const int wv = c.wave * c.G + c.bid, NGW = c.G * NWAVES;
      constexpr int NIT = NSEQ * 129 + NSEQ * 128;
      for (int wi = wv; 2 * wi < NIT; wi += NGW) scan_prop_item(c, l, 2 * wi + (c.lane >> 5));
      { const int NF = NGW > NLONGW ? NGW - NLONGW : 0, ND = NF < NUA / 2 ? NF : NUA / 2;
        if (wv >= NLONGW && wv - NLONGW < ND) attn_unit(c, l, NUA - ND + (wv - NLONGW)); }
      SEAM(pb + 3);
    }
    if (KIND(5) && IN(pb + 4)) _Pragma("unroll 1") for (int rep = 0; rep < REP_MIX3; ++rep) { LAUNDER();
      const int gwv = c.bid * NWAVES + c.wave, NGW = c.G * NWAVES;
      for (int u = gwv; u < NCHUNK * 2; u += NGW) scan_apply_unit<0>(c, l, u >> 1, u & 1);
      for (int u = (gwv + NGW / 2) % NGW; u < NCHUNK * 2; u += NGW) scan_apply_unit<1>(c, l, u >> 1, u & 1);
      SEAM(pb + 4);
    }
    if (KIND(6) && IN(pb + 5)) _Pragma("unroll 1") for (int rep = 0; rep < REP_MERGE; ++rep) { LAUNDER();
      pg8::Gemm g{(const bf16_t*)(c.ws + WS_YCAT), (const bf16_t*)(c.ws + WS_WBR) + (size_t)l * D * D, TP, D, D, D, D, 0, 0};
      pg8::StaticOrder S; S.init(TP, D, c.G, c.bid);
      EpiMergeH E{(const bf16_t*)(c.ws + WS_P), (bf16_t*)(c.ws + WS_MG)};
      pg8::gemm_phase<EpiMergeH, pg8::StaticOrder, true>(lds, g, S, E, c.tid);
      sample_tail_gemm<0>(c, l, (const bf16_t*)(c.ws + WS_WBR) + (size_t)l * D * D, (const bf16_t*)(c.ws + WS_YCAT) + (size_t)TP * D);
      SEAM(pb + 5);
    }
    #ifndef REP_OUT0
#define REP_OUT0 1
#endif
    if (KIND(7) && IN(pb + 6)) _Pragma("unroll 1") for (int rp = 0; rp < (l == 0 ? REP_OUT0 : 1); ++rp) { LAUNDER();
      pg8::Gemm g{(const bf16_t*)(c.ws + WS_MG), (const bf16_t*)(c.ws + WS_WOUT) + (size_t)l * D * D, TP, D, D, D, D, 0, 0};
      pg8::StaticOrder S; S.init(TP, D, c.G, c.bid);
      EpiOut E{c.in[IN_XP], c.in[IN_XS], c.out + O_Y, c.out + O_Y, l};
      pg8::gemm_phase<EpiOut, pg8::StaticOrder, true>(lds, g, S, E, c.tid);
      sample_tail_gemm<1>(c, l, (const bf16_t*)(c.ws + WS_WOUT) + (size_t)l * D * D, (const bf16_t*)(c.ws + WS_MG) + (size_t)TP * D);
      SEAM(pb + 6);
    }
  }
  if (KIND(8) && IN(PH_FINAL)) { LAUNDER(); phase_final(c); }
#undef IN
#undef SEAM
}

#ifndef N_LAUNCHES
#define N_LAUNCHES 1
#endif
#ifdef EMU
void emu_after_phase(int p, unsigned char* ws, float* out);
#endif
extern "C" void kernel_launch(void* const* d_in, const int* in_sizes, int n_in, void* d_out, int out_size, void* d_ws, size_t ws_size, hipStream_t stream) {
  (void)in_sizes; (void)n_in; (void)out_size; (void)ws_size;
  Args a;
  memset(&a, 0, sizeof(a));
  for (int i = 0; i < 20; ++i) a.in[i] = (const float*)d_in[i];
  a.out = (float*)d_out; a.ws = (unsigned char*)d_ws;
#ifdef EMU
  int grid = EMU_GRID;
  for (int p = 0; p < PH_COUNT; ++p) { a.ph_lo = p; a.ph_hi = p + 1; emu_launch(fwd, grid, NTHREADS, LDS_BYTES, a); emu_after_phase(p, a.ws, a.out); }
#else
  static int grid = 0;
  if (grid == 0) {
    int dev = 0, cus = 0;
    if (hipGetDevice(&dev) != hipSuccess || hipDeviceGetAttribute(&cus, hipDeviceAttributeMultiprocessorCount, dev) != hipSuccess) { grid = -1; return; }
    if (hipFuncSetAttribute((const void*)fwd, hipFuncAttributeMaxDynamicSharedMemorySize, LDS_BYTES) != hipSuccess) { grid = -1; return; }
    int per_cu = 0;
    (void)hipOccupancyMaxActiveBlocksPerMultiprocessor(&per_cu, (const void*)fwd, NTHREADS, LDS_BYTES);
    (void)hipGetLastError();
    grid = cus;
  }
  if (grid < 0) return;
  (void)hipMemsetAsync((char*)d_ws + WS_CTL, 0, CTL_BYTES, stream);
  if (N_LAUNCHES == 1) { a.ph_lo = 0; a.ph_hi = PH_COUNT; hipLaunchKernelGGL(fwd, dim3(grid), dim3(NTHREADS), LDS_BYTES, stream, a); }
  else for (int p = 0; p < PH_COUNT; ++p) { a.ph_lo = p; a.ph_hi = p + 1; hipLaunchKernelGGL(fwd, dim3(grid), dim3(NTHREADS), LDS_BYTES, stream, a); }
#endif
}
```

```cpp
#ifndef EMU
#include <hip/hip_runtime.h>
#include <cstdio>
#include <cstdint>
#include <cstring>
#endif

typedef unsigned short bf16_t;
typedef short bf16x8 __attribute__((ext_vector_type(8)));
typedef short s16x4 __attribute__((ext_vector_type(4)));
typedef float f32x4 __attribute__((ext_vector_type(4)));
typedef float f32x16 __attribute__((ext_vector_type(16)));
typedef unsigned u32x4 __attribute__((ext_vector_type(4)));
typedef unsigned u32x2 __attribute__((ext_vector_type(2)));

#ifdef EMU
#define DI inline
#define LAS
#define GAS
DI unsigned f_bits(float f) { unsigned u; memcpy(&u, &f, 4); return u; }
DI float bits_f(unsigned u) { float f; memcpy(&f, &u, 4); return f; }
DI float ex2(float x) { return exp2f(x); }
DI float lg2(float x) { return log2f(x); }
DI float frcp(float x) { return 1.0f / x; }
DI float frsq(float x) { return 1.0f / sqrtf(x); }
DI float wshfl(float v, int src) { auto s = emu::wave_exchange(&v, 4); float r; memcpy(&r, s[src & 63], 4); return r; }
DI float wshfl_xor(float v, int m, int lane) { return wshfl(v, lane ^ m); }
DI float wshfl_up(float v, int d, int lane) { return wshfl(v, lane >= d ? lane - d : lane); }
DI int rfl(int v) { return v; }
DI float bf2f(bf16_t b) { return bits_f((unsigned)b << 16); }
DI f32x16 mfma32(bf16x8 a, bf16x8 b, f32x16 c) {
  struct { bf16x8 a, b; } d{a, b};
  auto s = emu::wave_exchange(&d, 32);
  int lane = emu::tid() & 63, r = lane & 31, h = lane >> 5;
  f32x16 o = c;
  for (int i = 0; i < 16; ++i) {
    int row = (i & 3) + 8 * (i >> 2) + 4 * h; double acc = 0;
    for (int k = 0; k < 16; ++k) {
      bf16x8 av, bv; memcpy(&av, s[row + 32 * (k >> 3)], 16); memcpy(&bv, (char*)s[r + 32 * (k >> 3)] + 16, 16);
      acc += (double)bf2f((bf16_t)av[k & 7]) * (double)bf2f((bf16_t)bv[k & 7]);
    }
    o[i] = c[i] + (float)acc;
  }
  return o;
}
DI s16x4 ds_tr16(const void* p) {
  auto s = emu::wave_exchange(&p, 8);
  int lane = emu::tid() & 63, g = lane & ~15, i = lane & 15;
  s16x4 o;
  for (int q = 0; q < 4; ++q) { const short* a; memcpy(&a, s[g + 4 * q + (i >> 2)], 8); o[q] = a[i & 3]; }
  return o;
}
#define OPAQUE_V(x) do {} while (0)
#define NT_STORE(ptr, val) (*(ptr) = (val))
#define VM_WAIT() do {} while (0)
#define LDS_WAIT() do { int _z = 0; (void)emu::wave_exchange(&_z, 4); } while (0)
#define DYN_LDS(name) unsigned char* name = emu::g_blk->lds
DI float log1p_f(float x) { return log1pf(x); }
#else
#define DI __device__ __forceinline__
#define LAS __attribute__((address_space(3)))
#define GAS __attribute__((address_space(1)))
DI unsigned f_bits(float f) { return __builtin_bit_cast(unsigned, f); }
DI float bits_f(unsigned u) { return __builtin_bit_cast(float, u); }
DI float ex2(float x) { return __builtin_amdgcn_exp2f(x); }
DI float lg2(float x) { return __builtin_amdgcn_logf(x); }
DI float frcp(float x) { return __builtin_amdgcn_rcpf(x); }
DI float frsq(float x) { return __builtin_amdgcn_rsqf(x); }
DI float wshfl(float v, int src) { return bits_f((unsigned)__builtin_amdgcn_ds_bpermute(src << 2, (int)f_bits(v))); }
DI float wshfl_xor(float v, int m, int lane) { return wshfl(v, lane ^ m); }
DI float wshfl_up(float v, int d, int lane) { return wshfl(v, lane >= d ? lane - d : lane); }
DI int rfl(int v) { return __builtin_amdgcn_readfirstlane(v); }
DI float bf2f(bf16_t b) { return bits_f((unsigned)b << 16); }
DI f32x16 mfma32(bf16x8 a, bf16x8 b, f32x16 c) { return __builtin_amdgcn_mfma_f32_32x32x16_bf16(a, b, c, 0, 0, 0); }
DI s16x4 ds_tr16(const LAS void* p) { return __builtin_amdgcn_ds_read_tr16_b64_v4i16((LAS s16x4*)p); }
#define OPAQUE_V(x) asm volatile("" : "+v"(x))
#define NT_STORE(ptr, val) __builtin_nontemporal_store((val), (ptr))
#define VM_WAIT() asm volatile("s_waitcnt vmcnt(0)" ::: "memory")
#define LDS_WAIT() asm volatile("s_waitcnt lgkmcnt(0)" ::: "memory")
#define DYN_LDS(name) extern __shared__ __attribute__((aligned(16))) unsigned char name##_raw[]; LAS unsigned char* name = (LAS unsigned char*)name##_raw
DI float log1p_f(float x) { return x < 1e-4f ? x * (1.0f - 0.5f * x) : __builtin_amdgcn_logf(1.0f + x) * 0.6931471805599453f; }
#endif

DI bf16_t f2bf(float f) { unsigned u = f_bits(f); return (bf16_t)((u + 0x7fffu + ((u >> 16) & 1u)) >> 16); }
#ifdef EMU
DI unsigned pk2(float lo, float hi) { return (unsigned)f2bf(lo) | ((unsigned)f2bf(hi) << 16); }
#else
typedef float f32x2_t __attribute__((ext_vector_type(2))); typedef __bf16 bf16x2_t __attribute__((ext_vector_type(2)));
DI unsigned pk2(float lo, float hi) { f32x2_t v = {lo, hi}; bf16x2_t b = __builtin_convertvector(v, bf16x2_t); return __builtin_bit_cast(unsigned, b); }
#endif
DI bf16x8 pack8(float a0, float a1, float a2, float a3, float a4, float a5, float a6, float a7) {
  u32x4 p; p.x = pk2(a0, a1); p.y = pk2(a2, a3); p.z = pk2(a4, a5); p.w = pk2(a6, a7); return __builtin_bit_cast(bf16x8, p);
}
DI void unpack8(const u32x4 g, float (&o)[8]) {
#pragma unroll
  for (int j = 0; j < 4; ++j) { o[2 * j] = bits_f(g[j] << 16); o[2 * j + 1] = bits_f(g[j] & 0xffff0000u); }
}
DI float wave_sum(float v, int lane) {
#pragma unroll
  for (int o = 1; o < 64; o <<= 1) v += wshfl_xor(v, o, lane);
  return v;
}
DI float wave_max(float v, int lane) {
#pragma unroll
  for (int o = 1; o < 64; o <<= 1) v = fmaxf(v, wshfl_xor(v, o, lane));
  return v;
}
DI float wave_min(float v, int lane) {
#pragma unroll
  for (int o = 1; o < 64; o <<= 1) v = fminf(v, wshfl_xor(v, o, lane));
  return v;
}
DI float half_sum(float v, int lane) {
#pragma unroll
  for (int o = 1; o < 32; o <<= 1) v += wshfl_xor(v, o, lane);
  return v;
}
DI float sigmoid_f(float x) { return frcp(1.0f + __expf(-x)); }
DI float silu_f(float x) { return x * sigmoid_f(x); }
DI int crow(int i, int h) { return (i & 3) + 8 * (i >> 2) + 4 * h; }


#ifdef EMU
constexpr int SEQ = EMU_SEQ, PAST = EMU_PAST;
#else
constexpr int SEQ = 16384, PAST = 4096;
#endif
constexpr int D = 2048, NBATCH = 2, DEPTH = 2, DB = 32, DS = 16, W = 512, NH = 4, HD = 128, CW = 31;
constexpr int TP = NBATCH * SEQ, TS = DB * DS, T = TP + TS;
constexpr int NP = 16384, N_IN = 16392, GATE_COL = 4608;
#define PIX(row, cb) (((size_t)(cb) * T + (size_t)(row)) * 512)
constexpr int NCH_P = SEQ / 64, NSEQ_P = NBATCH * NH, NSEQ_S = DB * NH, NSEQ = NSEQ_P + NSEQ_S;
constexpr int NCHUNK = NSEQ_P * NCH_P + NSEQ_S;
constexpr int NWAVES = 8, NTHREADS = 512;
static_assert(T % 256 == 0 && SEQ % 64 == 0 && PAST % 32 == 0 && PAST + DS <= SEQ, "shapes");
constexpr int CB_QA = 0, CB_KA = 1, CB_VA = 2, CB_ZA = 3, CB_QB = 4, CB_KB = 5, CB_VB = 6, CB_OB = 7, CB_ZB = 8, CB_QC = 9, CB_KC = 10, CB_VC = 11, CB_ZC = 12,
              CB_UD = 13, CB_GD = 14, CB_ZD = 15, CB_G0 = 16;
constexpr size_t O_Y = 0;
constexpr size_t O_PK = O_Y + (size_t)T * D;
constexpr size_t O_PV = O_PK + (size_t)DEPTH * TP * W;
constexpr size_t O_PC = O_PV + (size_t)DEPTH * TP * W;
constexpr size_t O_PN = O_PC + (size_t)DEPTH * NBATCH * NH * HD * HD;
constexpr size_t O_PM = O_PN + (size_t)DEPTH * NBATCH * NH * HD;
constexpr size_t O_PS = O_PM + (size_t)DEPTH * NBATCH * NH;
constexpr size_t O_PCONV = O_PS + (size_t)DEPTH * NBATCH * NH * HD * HD;
constexpr size_t O_SK = O_PCONV + (size_t)DEPTH * NBATCH * 30 * W;
constexpr size_t O_SV = O_SK + (size_t)DEPTH * TS * W;
constexpr size_t O_SC = O_SV + (size_t)DEPTH * TS * W;
constexpr size_t O_SN = O_SC + (size_t)DEPTH * DB * NH * HD * HD;
constexpr size_t O_SM = O_SN + (size_t)DEPTH * DB * NH * HD;
constexpr size_t O_SS = O_SM + (size_t)DEPTH * DB * NH;
constexpr size_t O_SCONV = O_SS + (size_t)DEPTH * DB * NH * HD * HD;
constexpr size_t O_END = O_SCONV + (size_t)DEPTH * DB * 30 * W;
constexpr size_t MiB = 1u << 20;
constexpr size_t al(size_t x) { return (x + 4095) & ~(size_t)4095; }
constexpr size_t WS_CTL = 0, CTL_BYTES = 1 * MiB;
constexpr size_t WS_WIN = WS_CTL + CTL_BYTES;
constexpr size_t WS_WBR = WS_WIN + al((size_t)DEPTH * NP * D * 2);
constexpr size_t WS_WOUT = WS_WBR + al((size_t)DEPTH * 4 * D * W * 2);
constexpr size_t WS_ROPE = WS_WOUT + al((size_t)DEPTH * D * D * 2);
constexpr size_t WS_IG = WS_ROPE + al((size_t)SEQ * 64 * 8);
constexpr size_t WS_LF = WS_IG + al((size_t)T * 4 * 4);
constexpr size_t WS_SCB = WS_LF + al((size_t)T * 4 * 4);
constexpr size_t WS_SCG = WS_SCB + al((size_t)NCHUNK * 4);
constexpr size_t WS_MC = WS_SCG + al((size_t)NCHUNK * 4);
constexpr size_t WS_HIN = WS_MC + al((size_t)NCHUNK * 4);
constexpr int ST_ROWS = 160;
constexpr size_t ST_BYTES = (size_t)ST_ROWS * HD * 2;
constexpr size_t WS_ST = WS_HIN + al((size_t)T * D * 2);
constexpr size_t WS_ST2 = WS_ST + al((size_t)2 * NCHUNK * ST_BYTES);
constexpr size_t WS_P = WS_ST2 + al((size_t)2 * NCHUNK * ST_BYTES);
constexpr size_t WS_YCAT = WS_P + al((size_t)T * NP * 2);
constexpr size_t WS_MG = WS_YCAT + al((size_t)T * D * 2);
constexpr size_t WS_END = WS_MG + al((size_t)T * D * 2);
constexpr int WSCR = 18304;
constexpr int LDSCTL_OFF = NWAVES * WSCR;
constexpr int LDS_BYTES = 147456;
static_assert(LDSCTL_OFF + 64 <= LDS_BYTES && LDSCTL_OFF % 16 == 0, "lds map");
constexpr int TS272 = 272;

struct Args {
  const float* in[20]; float* out; unsigned char* ws; int ph_lo, ph_hi;
};

namespace pg8 {
constexpr int BM = 256, BK = 64, HALF = 128, HTB = HALF * BK * 2, STAGE_BYTES = 8 * HTB, NXCD = 8, WGM = 4;
__host__ __device__ inline int lds_byte(int r, int c) { const int st = (r >> 4) * 2 + (c >> 5), rr = r & 15, cc = c & 31, ob = rr * 64 + cc * 2; return st * 1024 + (ob ^ (((ob >> 9) & 1) << 5)); }
__host__ __device__ inline void stage_rc(int b, int& R, int& C) { const int st = b / 1024, sb = b % 1024, swz = sb ^ (((sb >> 9) & 1) << 5); R = (st >> 1) * 16 + swz / 64; C = (st & 1) * 32 + (swz % 64) / 2; }
__host__ __device__ inline int perm32(int rho) { const int n = rho >> 4, i = rho & 15; return 8 * (i >> 2) + 4 * n + (i & 3); }
struct Unit { int pm, pn, kb; };
struct Gemm { const bf16_t* A; const bf16_t* Bt; int M, N, K, lda, ldb; size_t kbA, kbB; };
struct StaticOrder {
  int nM, nN, nwg, G, c;
  __host__ __device__ void init(int M, int N, int G_, int c_) { nM = M / BM; nN = N / BM; nwg = nM * nN; G = G_; c = c_; }
  __host__ __device__ bool tile(long L, Unit& u) const {
    if (L >= nwg) return false;
    int wgid = (int)L; { const int q = nwg / NXCD, r = nwg % NXCD, xcd = wgid % NXCD, off = wgid / NXCD; wgid = (xcd < r ? xcd * (q + 1) : r * (q + 1) + (xcd - r) * q) + off; }
    const int nig = WGM * nN, gid = wgid / nig, fm = gid * WGM, gsz = (nM - fm) < WGM ? (nM - fm) : WGM;
    u.pm = fm + ((wgid % nig) % gsz); u.pn = (wgid % nig) / gsz; u.kb = 0; return true;
  }
  __host__ __device__ bool next(int i, Unit& u) const { return tile((long)i * G + c, u); }
};
#ifndef EMU
template <class Epi, class Sched, bool ALIGN_EPI>
__device__ __forceinline__ void gemm_phase(LAS unsigned char* lds, const Gemm g, const Sched& S, const Epi& E, const int tid) {
  const int wid = __builtin_amdgcn_readfirstlane(tid >> 6), lane = tid & 63, wr = wid >> 2, wc = wid & 3, fr = lane & 15, fq = lane >> 4;
  const int nt = g.K / BK;
  unsigned voffA[2], voffB[2];
#pragma unroll
  for (int i = 0; i < 2; ++i) { int R, C; stage_rc(tid * 16 + i * 8192, R, C); const int Rb = Epi::PERM ? ((R & ~31) + perm32(R & 31)) : R;
    voffA[i] = (unsigned)(R * g.lda + C) * 2u; voffB[i] = (unsigned)(Rb * g.ldb + C) * 2u; }
  const size_t kstep = (size_t)(BK * 2);
  const size_t hstepA = (size_t)HALF * g.lda * 2, hstepB = (size_t)HALF * g.ldb * 2;
  const unsigned ldsw = (unsigned)wid * 1024u;
  const int aoff = lds_byte(wr * 64 + fr, fq * 8), boff = lds_byte(wc * 32 + fr, fq * 8);
#define PG8_SA(b, h) (((b) * 2 + (h)) * HTB)
#define PG8_SB(b, h) ((4 + (b) * 2 + (h)) * HTB)
#define PG8_STAGE(bufoff, gbase, voff) do { _Pragma("unroll") for (int _i = 0; _i < 2; ++_i) \
    __builtin_amdgcn_global_load_lds((const unsigned*)((const char*)(gbase) + (voff)[_i]), (LAS unsigned*)(lds + (bufoff) + ldsw + _i * 8192), 16, 0, 0); } while (0)
#define PG8_LDA(dst, b, h) do { _Pragma("unroll") for (int m = 0; m < 4; ++m) _Pragma("unroll") for (int k = 0; k < 2; ++k) dst[m][k] = *(const LAS bf16x8*)(lds + PG8_SA(b, h) + aoff + m * 2048 + k * 1024); } while (0)
#define PG8_LDB(dst, b, h) do { _Pragma("unroll") for (int n = 0; n < 2; ++n) _Pragma("unroll") for (int k = 0; k < 2; ++k) dst[n][k] = *(const LAS bf16x8*)(lds + PG8_SB(b, h) + boff + n * 2048 + k * 1024); } while (0)
#define PG8_MMA(ai, bj, At, Bt) do { __builtin_amdgcn_s_setprio(1); _Pragma("unroll") for (int m = 0; m < 4; ++m) _Pragma("unroll") for (int n = 0; n < 2; ++n) _Pragma("unroll") for (int k = 0; k < 2; ++k) \
    acc[ai][bj][m][n] = __builtin_amdgcn_mfma_f32_16x16x32_bf16(Bt[n][k], At[m][k], acc[ai][bj][m][n], 0, 0, 0); __builtin_amdgcn_s_setprio(0); } while (0)
#define PG8_WAIT_V(n) asm volatile("s_waitcnt vmcnt(" #n ")" ::: "memory")
#define PG8_WAIT_L(n) asm volatile("s_waitcnt lgkmcnt(" #n ")" ::: "memory")
#define PG8_BAR __builtin_amdgcn_s_barrier()
#define PG8_SCHED __builtin_amdgcn_sched_barrier(0)
  Unit cur, nxt; int ui = 0;
  if (!S.next(0, cur)) return;
  f32x4 acc[2][2][4][2];
#pragma unroll
  for (int a = 0; a < 2; ++a)
#pragma unroll
    for (int b = 0; b < 2; ++b)
#pragma unroll
      for (int m = 0; m < 4; ++m)
#pragma unroll
        for (int n = 0; n < 2; ++n) acc[a][b][m][n] = (f32x4){0.f, 0.f, 0.f, 0.f};
  bf16x8 At[4][2], B0[2][2], B1[2][2];
  const char* cA = (const char*)g.A + (size_t)cur.pm * 2 * hstepA + (size_t)cur.kb * g.kbA;
  const char* cB = (const char*)g.Bt + (size_t)cur.pn * 2 * hstepB + (size_t)cur.kb * g.kbB;
  PG8_STAGE(PG8_SB(0, 0), cB, voffB); PG8_STAGE(PG8_SB(0, 1), cB + hstepB, voffB); PG8_STAGE(PG8_SA(0, 0), cA, voffA); PG8_STAGE(PG8_SA(0, 1), cA + hstepA, voffA);
  if (wr == 1) PG8_BAR;
  PG8_WAIT_V(2); PG8_BAR;
  PG8_STAGE(PG8_SB(1, 0), cB + kstep, voffB); PG8_STAGE(PG8_SA(1, 0), cA + kstep, voffA); PG8_STAGE(PG8_SB(1, 1), cB + hstepB + kstep, voffB);
  PG8_WAIT_V(6); PG8_BAR;
  for (;;) {
    const bool has_next = S.next(ui + 1, nxt);
    const char* nA = has_next ? (const char*)g.A + (size_t)nxt.pm * 2 * hstepA + (size_t)nxt.kb * g.kbA : cA;
    const char* nB = has_next ? (const char*)g.Bt + (size_t)nxt.pn * 2 * hstepB + (size_t)nxt.kb * g.kbB : cB;
    for (int t = 0; t < nt; t += 2) {
      const bool last = (t == nt - 2);
      const char* a1 = cA + (size_t)(t + 1) * kstep;
      const char* a2 = last ? nA : cA + (size_t)(t + 2) * kstep; const char* b2 = last ? nB : cB + (size_t)(t + 2) * kstep;
      const char* a3 = a2 + kstep; const char* b3 = b2 + kstep;
      PG8_LDB(B0, 0, 0); PG8_LDB(B1, 0, 1); PG8_SCHED; PG8_LDA(At, 0, 0); PG8_STAGE(PG8_SA(1, 1), a1 + hstepA, voffA);
      PG8_WAIT_V(8); PG8_WAIT_L(0); PG8_BAR; PG8_MMA(0, 0, At, B0); PG8_MMA(0, 1, At, B1); PG8_BAR; PG8_SCHED;
      PG8_LDA(At, 0, 1); PG8_STAGE(PG8_SB(0, 0), b2, voffB); PG8_STAGE(PG8_SB(0, 1), b2 + hstepB, voffB); PG8_STAGE(PG8_SA(0, 0), a2, voffA);
      PG8_WAIT_V(8); PG8_WAIT_L(0); PG8_BAR; PG8_MMA(1, 0, At, B0); PG8_MMA(1, 1, At, B1); PG8_BAR; PG8_SCHED;
      PG8_LDB(B0, 1, 0); PG8_LDB(B1, 1, 1); PG8_SCHED; PG8_LDA(At, 1, 0); PG8_STAGE(PG8_SA(0, 1), a2 + hstepA, voffA);
      PG8_WAIT_V(8); PG8_WAIT_L(0); PG8_BAR; PG8_MMA(0, 0, At, B0); PG8_MMA(0, 1, At, B1); PG8_BAR; PG8_SCHED;
      PG8_LDA(At, 1, 1); PG8_STAGE(PG8_SB(1, 0), b3, voffB); PG8_STAGE(PG8_SB(1, 1), b3 + hstepB, voffB); PG8_STAGE(PG8_SA(1, 0), a3, voffA);
      PG8_WAIT_V(8); PG8_WAIT_L(0); PG8_BAR; PG8_MMA(1, 0, At, B0); PG8_MMA(1, 1, At, B1); PG8_BAR; PG8_SCHED;
      if constexpr (Epi::MID > 0) { if (((t + 2) % Epi::MID) == 0 && (t + 2) < nt) E.mid(acc, cur, (t + 2) / Epi::MID - 1, wr, wc, fr, fq); }
    }
    if constexpr (ALIGN_EPI) { if (wr == 0) PG8_BAR; }
    E(acc, cur, wr, wc, fr, fq);
    if (!has_next) break;
#pragma unroll
    for (int a = 0; a < 2; ++a)
#pragma unroll
      for (int b = 0; b < 2; ++b)
#pragma unroll
        for (int m = 0; m < 4; ++m)
#pragma unroll
          for (int n = 0; n < 2; ++n) acc[a][b][m][n] = (f32x4){0.f, 0.f, 0.f, 0.f};
    cur = nxt; cA = nA; cB = nB; ++ui;
    if constexpr (ALIGN_EPI) { if (wr == 1) PG8_BAR; }
  }
  PG8_WAIT_V(0);
  if constexpr (!ALIGN_EPI) { if (wr == 0) PG8_BAR; }
  PG8_BAR;
#undef PG8_SA
#undef PG8_SB
#undef PG8_STAGE
#undef PG8_LDA
#undef PG8_LDB
#undef PG8_MMA
#undef PG8_WAIT_V
#undef PG8_WAIT_L
#undef PG8_BAR
#undef PG8_SCHED
}
#else
template <class Epi, class Sched, bool ALIGN_EPI>
inline void gemm_phase(unsigned char* lds, const Gemm g, const Sched& S, const Epi& E, const int tid) {
  (void)lds;
  const int wid = tid >> 6, lane = tid & 63, wr = wid >> 2, wc = wid & 3, fr = lane & 15, fq = lane >> 4;
  emu::Block* blk = emu::g_blk;
  Unit u;
  for (int ui = 0; S.next(ui, u); ++ui) {
    __syncthreads();
    if (tid == 0) { blk->fa.resize((size_t)256 * g.K); blk->fb.resize((size_t)256 * g.K); }
    __syncthreads();
    const bf16_t* A = (const bf16_t*)((const char*)g.A + (size_t)u.kb * g.kbA) + (size_t)u.pm * 256 * g.lda;
    const bf16_t* B = (const bf16_t*)((const char*)g.Bt + (size_t)u.kb * g.kbB) + (size_t)u.pn * 256 * g.ldb;
    for (int i = tid; i < 256; i += NTHREADS) for (int k = 0; k < g.K; ++k) { blk->fa[(size_t)i * g.K + k] = bf2f(A[(size_t)i * g.lda + k]); blk->fb[(size_t)i * g.K + k] = bf2f(B[(size_t)i * g.ldb + k]); }
    __syncthreads();
    f32x4 acc[2][2][4][2];
    const int nseg = Epi::MID > 0 ? g.K / (Epi::MID * BK) : 1, segk = g.K / nseg;
    for (int ai = 0; ai < 2; ++ai) for (int bj = 0; bj < 2; ++bj) for (int m = 0; m < 4; ++m) for (int n = 0; n < 2; ++n) for (int j = 0; j < 4; ++j) acc[ai][bj][m][n][j] = 0.f;
    for (int sg = 0; sg < nseg; ++sg) {
      for (int ai = 0; ai < 2; ++ai) for (int bj = 0; bj < 2; ++bj) for (int m = 0; m < 4; ++m) for (int n = 0; n < 2; ++n) for (int j = 0; j < 4; ++j) {
        const int row = 128 * ai + 64 * wr + 16 * m + fr;
        const int col = Epi::PERM ? 128 * bj + 32 * wc + 8 * fq + 4 * n + j : 128 * bj + 32 * wc + 16 * n + 4 * fq + j;
        const float* a = &blk->fa[(size_t)row * g.K + sg * segk]; const float* b = &blk->fb[(size_t)col * g.K + sg * segk];
        float s = 0.f; for (int k = 0; k < segk; ++k) s += a[k] * b[k];
        acc[ai][bj][m][n][j] += s;
      }
      if constexpr (Epi::MID > 0) { if (sg + 1 < nseg) E.mid(acc, u, sg, wr, wc, fr, fq); }
    }
    E(acc, u, wr, wc, fr, fq);
  }
  __syncthreads();
}
#endif
}

#ifndef EMU
#define XB_TMO      128
#define XB_XCNT(j)  (256  + 64 * (j))
#define XB_XSUB(j)  (1280 + 64 * (j))
#define XB_XGEN(j)  (2304 + 64 * (j))
#define XB_TOP      3328
#define XB_TOPGEN   3392
#define XCD_BAR_WORDS 3456
#define XB_SPIN_CAP (1u << 18)
__device__ __forceinline__ unsigned xb_ld(unsigned* p)              { return __hip_atomic_load(p, __ATOMIC_RELAXED, __HIP_MEMORY_SCOPE_AGENT); }
__device__ __forceinline__ unsigned xb_add(unsigned* p, unsigned v) { return __hip_atomic_fetch_add(p, v, __ATOMIC_RELAXED, __HIP_MEMORY_SCOPE_AGENT); }
__device__ __forceinline__ unsigned xb_xcc_id() { return (unsigned)__builtin_amdgcn_s_getreg((3 << 11) | 20) & 0xFu; }
#define XB_SPIN(cond, bar) do { unsigned _sp = 0; while (cond) { __builtin_amdgcn_s_sleep(1); \
    if ((++_sp & 255u) == 0u) { if (xb_ld(&(bar)[XB_TMO])) break; if (_sp > XB_SPIN_CAP) { atomicAdd(&(bar)[XB_TMO], 1u); break; } } } } while (0)
struct XcdBarrier { unsigned* bar; unsigned x; volatile LAS unsigned* st; };
__device__ __forceinline__ XcdBarrier xcd_barrier_post(unsigned* bar, volatile LAS unsigned* st) {
  XcdBarrier b; b.bar = bar; b.x = xb_xcc_id(); b.st = st;
  if (threadIdx.x == 0) (void)xb_add(&bar[XB_XCNT(b.x)], 1u);
  return b;
}
__device__ __forceinline__ void xcd_barrier_complete(unsigned* bar, unsigned x, unsigned& nloc, unsigned& nx) {
  const unsigned G = gridDim.x * gridDim.y * gridDim.z;
  unsigned sum, cnt, mine, sp = 0u;
  for (;;) {
    sum = 0u; cnt = 0u; mine = 0u;
#pragma unroll
    for (unsigned j = 0; j < 16; ++j) { const unsigned c = xb_ld(&bar[XB_XCNT(j)]); sum += c; cnt += (c > 0u) ? 1u : 0u; mine = (j == x) ? c : mine; }
    if (sum == G) break;
    __builtin_amdgcn_s_sleep(1);
    if ((++sp & 255u) == 0u) { if (xb_ld(&bar[XB_TMO])) break; if (sp > XB_SPIN_CAP) { atomicAdd(&bar[XB_TMO], 1u); break; } }
  }
  nloc = mine > 0u ? mine : 1u; nx = cnt > 0u ? cnt : 1u;
}
__device__ __forceinline__ void xcd_barrier(const XcdBarrier& b) {
  asm volatile("s_waitcnt vmcnt(0)" ::: "memory");
  __syncthreads();
  if (threadIdx.x == 0) {
    unsigned* bar = b.bar;
    __builtin_amdgcn_s_waitcnt(0);
    unsigned nloc = b.st[0], nx = b.st[1];
    if (nloc == 0u) { xcd_barrier_complete(bar, b.x, nloc, nx); b.st[0] = nloc; b.st[1] = nx; }
    const unsigned old = xb_add(&bar[XB_XSUB(b.x)], 1u);
    const unsigned gen = old / nloc;
    if (old + 1u == (gen + 1u) * nloc) {
      __builtin_amdgcn_fence(__ATOMIC_RELEASE, "agent");
      asm volatile("s_waitcnt vmcnt(0)" ::: "memory");
      const unsigned og = xb_add(&bar[XB_TOP], 1u);
      const unsigned tg = og / nx;
      if (og + 1u == (tg + 1u) * nx) xb_add(&bar[XB_TOPGEN], 1u);
      else XB_SPIN(xb_ld(&bar[XB_TOPGEN]) == tg, bar);
      __builtin_amdgcn_fence(__ATOMIC_ACQUIRE, "agent");
      xb_add(&bar[XB_XGEN(b.x)], 1u);
      asm volatile("s_waitcnt vmcnt(0)" ::: "memory");
    } else {
      XB_SPIN(xb_ld(&bar[XB_XGEN(b.x)]) == gen, bar);
      __builtin_amdgcn_fence(__ATOMIC_ACQUIRE, "agent");
      asm volatile("s_waitcnt vmcnt(0)" ::: "memory");
    }
  }
  __syncthreads();
}
#endif

struct Ctx {
  LAS unsigned char* lds;
  LAS unsigned char* scr;
  int tid, lane, wave, G, bid;
  const float* in[20]; float* out; unsigned char* ws;
};
enum { IN_XP = 0, IN_XS, IN_CK, IN_CV, IN_MC, IN_MN, IN_MM, IN_RS, IN_CONV, IN_NG, IN_WIN, IN_BI, IN_BF, IN_CWT, IN_CB, IN_LNG, IN_LNB, IN_WBR, IN_WOUT, IN_FG };

DI const float* x_row_in(const Ctx& c, int r) { return r < TP ? c.in[IN_XP] + (size_t)r * D : c.in[IN_XS] + (size_t)(r - TP) * D; }

#ifdef EMU
static const float ROPE_INV[64] = {1.000000000e+00f, 8.659643531e-01f, 7.498942614e-01f, 6.493816376e-01f, 5.623413324e-01f, 4.869675338e-01f, 4.216965139e-01f, 3.651741147e-01f, 3.162277639e-01f, 2.738419771e-01f, 2.371373773e-01f, 2.053525001e-01f, 1.778279394e-01f, 1.539926529e-01f, 1.333521307e-01f, 1.154782027e-01f, 1.000000015e-01f, 8.659642935e-02f, 7.498941571e-02f, 6.493816525e-02f, 5.623413250e-02f, 4.869675264e-02f, 4.216965288e-02f, 3.651741147e-02f, 3.162277490e-02f, 2.738419734e-02f, 2.371373773e-02f, 2.053525113e-02f, 1.778279431e-02f, 1.539926510e-02f, 1.333521493e-02f, 1.154782064e-02f, 9.999999776e-03f, 8.659643121e-03f, 7.498941850e-03f, 6.493816152e-03f, 5.623413250e-03f, 4.869675264e-03f, 4.216964822e-03f, 3.651741194e-03f, 3.162277630e-03f, 2.738419687e-03f, 2.371373586e-03f, 2.053524833e-03f, 1.778279431e-03f, 1.539926510e-03f, 1.333521446e-03f, 1.154781901e-03f, 1.000000047e-03f, 8.659643354e-04f, 7.498942432e-04f, 6.493816618e-04f, 5.623413017e-04f, 4.869675322e-04f, 4.216965172e-04f, 3.651741426e-04f, 3.162277571e-04f, 2.738419571e-04f, 2.371373703e-04f, 2.053525095e-04f, 1.778279402e-04f, 1.539926452e-04f, 1.333521504e-04f, 1.154782003e-04f};
#else
__constant__ float ROPE_INV[64] = {1.000000000e+00f, 8.659643531e-01f, 7.498942614e-01f, 6.493816376e-01f, 5.623413324e-01f, 4.869675338e-01f, 4.216965139e-01f, 3.651741147e-01f, 3.162277639e-01f, 2.738419771e-01f, 2.371373773e-01f, 2.053525001e-01f, 1.778279394e-01f, 1.539926529e-01f, 1.333521307e-01f, 1.154782027e-01f, 1.000000015e-01f, 8.659642935e-02f, 7.498941571e-02f, 6.493816525e-02f, 5.623413250e-02f, 4.869675264e-02f, 4.216965288e-02f, 3.651741147e-02f, 3.162277490e-02f, 2.738419734e-02f, 2.371373773e-02f, 2.053525113e-02f, 1.778279431e-02f, 1.539926510e-02f, 1.333521493e-02f, 1.154782064e-02f, 9.999999776e-03f, 8.659643121e-03f, 7.498941850e-03f, 6.493816152e-03f, 5.623413250e-03f, 4.869675264e-03f, 4.216964822e-03f, 3.651741194e-03f, 3.162277630e-03f, 2.738419687e-03f, 2.371373586e-03f, 2.053524833e-03f, 1.778279431e-03f, 1.539926510e-03f, 1.333521446e-03f, 1.154781901e-03f, 1.000000047e-03f, 8.659643354e-04f, 7.498942432e-04f, 6.493816618e-04f, 5.623413017e-04f, 4.869675322e-04f, 4.216965172e-04f, 3.651741426e-04f, 3.162277571e-04f, 2.738419571e-04f, 2.371373703e-04f, 2.053525095e-04f, 1.778279402e-04f, 1.539926452e-04f, 1.333521504e-04f, 1.154782003e-04f};
#endif
DI void transpose_item(const float* Wsrc, int ldn, int K, bf16_t* WT, LAS float* scr, int kb, int srccol  , int n0dst, int lane, int koff = 0) {
  const int k0 = 64 * kb;
#pragma unroll 8
  for (int i = 0; i < 32; ++i) { const int kk = 2 * i + (lane >> 5); scr[kk * 33 + (lane & 31)] = Wsrc[(size_t)(k0 + kk) * ldn + srccol]; }
  LDS_WAIT();
  const int ch = lane & 7;
#pragma unroll
  for (int j = 0; j < 4; ++j) { const int n = (lane >> 3) + 8 * j; const LAS float* s = scr + (8 * ch) * 33 + n;
    u32x4 o; o.x = pk2(s[0 * 33], s[1 * 33]); o.y = pk2(s[2 * 33], s[3 * 33]); o.z = pk2(s[4 * 33], s[5 * 33]); o.w = pk2(s[6 * 33], s[7 * 33]);
    *(u32x4*)(WT + (size_t)(n0dst + n) * K + koff + k0 + 8 * ch) = o; }
  LDS_WAIT();
}
DI void phase_prologue(const Ctx& c) {
  LAS float* scr = (LAS float*)c.scr;
  const int gw = c.bid * NWAVES + c.wave, NGW = c.G * NWAVES;
  constexpr int I_IN = (D / 64) * (NP / 32), I_BR = 4 * (W / 64) * (D / 32), I_OUT = (D / 64) * (D / 32), I_L = I_IN + I_BR + I_OUT;
  for (int it = gw; it < DEPTH * I_L; it += NGW) {
    const int l = it / I_L; int r = it % I_L;
    if (r < I_IN) { const int nblk = NP / 32, kb = r / nblk, nb = r % nblk, n0 = 32 * nb;
      const int np = n0 + (c.lane & 31);
      int src = np < GATE_COL ? np : np + 8;
      if (np >= CB_UD * 512 && np < (CB_GD + 1) * 512) { const int g = (np - CB_UD * 512) >> 3, q = np & 7; src = (q < 4 ? CB_UD * 512 + 8 : CB_GD * 512 + 8) + 4 * g + (q & 3); }
      transpose_item(c.in[IN_WIN] + (size_t)l * D * N_IN, N_IN, D, (bf16_t*)(c.ws + WS_WIN) + (size_t)l * NP * D, scr, kb, src, n0, c.lane); continue; }
    r -= I_IN;
    if (r < I_BR) { const int per = (W / 64) * (D / 32), br = r / per, rr = r % per, nblk = D / 32, kb = rr / nblk, nb = rr % nblk;
      transpose_item(c.in[IN_WBR] + ((size_t)l * 4 + br) * W * D, D, D, (bf16_t*)(c.ws + WS_WBR) + (size_t)l * D * D, scr, kb, 32 * nb + (c.lane & 31), 32 * nb, c.lane, br * W); continue; }
    r -= I_BR;
    { const int nblk = D / 32, kb = r / nblk, nb = r % nblk;
      transpose_item(c.in[IN_WOUT] + (size_t)l * D * D, D, D, (bf16_t*)(c.ws + WS_WOUT) + (size_t)l * D * D, scr, kb, 32 * nb + (c.lane & 31), 32 * nb, c.lane); }
  }
  float* rope = (float*)(c.ws + WS_ROPE);
  for (int i = c.bid * NTHREADS + c.tid; i < SEQ * 64; i += c.G * NTHREADS) {
    const int pos = i >> 6, j = i & 63;
    const float inv = ROPE_INV[j];
    const float ang = (float)pos * inv;
    const double a = (double)ang, n = rint(a * 0.15915494309189535), red = (a - n * 6.283185307179586) ;
    const float rr = (float)(red - n * 2.4492935982947064e-16);
    rope[2 * i] = cosf(rr); rope[2 * i + 1] = sinf(rr);
  }
}

DI void phase_norm(const Ctx& c, int l) {
  LAS float* gw = (LAS float*)c.lds;
  const float* win = c.in[IN_WIN] + (size_t)l * D * N_IN + GATE_COL;
  for (int i = c.tid; i < D * 8; i += NTHREADS) { const int k = i >> 3, q = i & 7;
    gw[((((k >> 8) * 4 + (k & 3)) * 2 + (q >> 2)) * 64 + ((k >> 2) & 63)) * 4 + (q & 3)] = win[(size_t)k * N_IN + q]; }
  __syncthreads();
  const float* ng = c.in[IN_NG] + (size_t)l * D;
  bf16_t* HIN = (bf16_t*)(c.ws + WS_HIN);
  float* IG = (float*)(c.ws + WS_IG); float* LF = (float*)(c.ws + WS_LF);
  const int gwv = c.bid * NWAVES + c.wave, NGW = c.G * NWAVES, lane = c.lane;
  const int gq = (lane & 1) * 4 + ((lane >> 1) & 1) * 2 + ((lane >> 2) & 1);
  const float gbias = gq < 4 ? c.in[IN_BI][l * NH + gq] : c.in[IN_BF][l * NH + gq - 4];
  const bool b0 = lane & 1, b1 = lane & 2, b2 = lane & 4;
  const int loff = 4 * lane;
  f32x4 vn[8];
  {
    const float* xr = (l == 0) ? x_row_in(c, gwv < T ? gwv : 0) : c.out + O_Y + (size_t)(gwv < T ? gwv : 0) * D;
#pragma unroll
    for (int j = 0; j < 8; ++j) vn[j] = *(const f32x4*)(xr + loff + 256 * j);
  }
  for (int r = gwv; r < T; r += NGW) {
    f32x4 v[8]; float ss = 0.f;
#pragma unroll
    for (int j = 0; j < 8; ++j) { v[j] = vn[j]; ss += (v[j].x * v[j].x + v[j].y * v[j].y) + (v[j].z * v[j].z + v[j].w * v[j].w); }
    {
      const int rn = r + NGW < T ? r + NGW : r;
      const float* xr = (l == 0) ? x_row_in(c, rn) : c.out + O_Y + (size_t)rn * D;
#pragma unroll
      for (int j = 0; j < 8; ++j) vn[j] = *(const f32x4*)(xr + loff + 256 * j);
    }
    const float rstd = frsq(wave_sum(ss, lane) * (1.0f / D) + 1e-6f);
    float ga[8];
#pragma unroll
    for (int k = 0; k < 8; ++k) ga[k] = 0.f;
    bf16_t* hrow = HIN + (size_t)r * D + loff;
#pragma unroll
    for (int j = 0; j < 8; ++j) {
      const LAS float* gp = gw + (j * 8 * 64 + lane) * 4;
      const f32x4 gvj = *(const f32x4*)(ng + 256 * j + loff);
      v[j] = v[j] * rstd * gvj;
      *(u32x2*)(hrow + 256 * j) = (u32x2){pk2(v[j].x, v[j].y), pk2(v[j].z, v[j].w)};
#pragma unroll
      for (int e = 0; e < 4; ++e) {
        const f32x4 w0 = *(const LAS f32x4*)(gp + e * 512), w1 = *(const LAS f32x4*)(gp + e * 512 + 256);
        const float xv = v[j][e];
        ga[0] += xv * w0.x; ga[1] += xv * w0.y; ga[2] += xv * w0.z; ga[3] += xv * w0.w;
        ga[4] += xv * w1.x; ga[5] += xv * w1.y; ga[6] += xv * w1.z; ga[7] += xv * w1.w;
      }
      asm volatile("" ::: "memory");
    }
    {
      float t4[4];
#pragma unroll
      for (int k = 0; k < 4; ++k) { const float snd = b0 ? ga[k] : ga[4 + k]; const float keep = b0 ? ga[4 + k] : ga[k]; t4[k] = keep + wshfl_xor(snd, 1, lane); }
      float t2[2];
#pragma unroll
      for (int k = 0; k < 2; ++k) { const float snd = b1 ? t4[k] : t4[2 + k]; const float keep = b1 ? t4[2 + k] : t4[k]; t2[k] = keep + wshfl_xor(snd, 2, lane); }
      float t1; { const float snd = b2 ? t2[0] : t2[1]; const float keep = b2 ? t2[1] : t2[0]; t1 = keep + wshfl_xor(snd, 4, lane); }
      t1 += wshfl_xor(t1, 8, lane); t1 += wshfl_xor(t1, 16, lane); t1 += wshfl_xor(t1, 32, lane);
      if (lane < 8) {
        const float val = t1 + gbias;
        if (gq < 4) IG[(size_t)r * 4 + gq] = val;
        else LF[(size_t)r * 4 + gq - 4] = fminf(val, 0.f) - log1p_f(__expf(-fabsf(val)));
      }
    }
  }
  __syncthreads();
}

DI float gate_e(float g) { return __expf(-fmaxf(g, -30.f)); }
struct EpiInproj {
  static constexpr bool PERM = true; static constexpr int MID = 0;
  bf16_t* P; float* out; int l;
  DI void operator()(const f32x4 (&acc)[2][2][4][2], const pg8::Unit& u, int wr, int wc, int fr, int fq) const {
    const int row0 = u.pm * 256 + wr * 64 + fr, colt = u.pn * 256, cb = colt >> 9;
    const int col0 = colt + wc * 32 + 8 * fq;
    const bool kv = (cb == CB_KA || cb == CB_VA), gate = cb >= CB_G0, glu = (cb == CB_UD || cb == CB_GD);
    if (glu) {
#pragma unroll
      for (int ai = 0; ai < 2; ++ai)
#pragma unroll
        for (int m = 0; m < 4; ++m) {
          const int r = row0 + ai * 128 + m * 16;
#pragma unroll
          for (int bj = 0; bj < 2; ++bj) {
            const f32x4 v0 = acc[ai][bj][m][0], v1 = acc[ai][bj][m][1];
            const int chb = (col0 + bj * 128 - CB_UD * 512) >> 1;
            const float g0 = v0[0] * sigmoid_f(v1[0]), g1 = v0[1] * sigmoid_f(v1[1]), g2 = v0[2] * sigmoid_f(v1[2]), g3 = v0[3] * sigmoid_f(v1[3]);
            *(u32x2*)(P + PIX(r, CB_UD) + chb) = (u32x2){pk2(g0, g1), pk2(g2, g3)};
          }
        }
      return;
    }
#pragma unroll
    for (int ai = 0; ai < 2; ++ai)
#pragma unroll
      for (int m = 0; m < 4; ++m) {
        const int r = row0 + ai * 128 + m * 16;
        bf16_t* rowp = P + PIX(r, cb) + (col0 - cb * 512);
#pragma unroll
        for (int bj = 0; bj < 2; ++bj) {
          f32x4 v0 = acc[ai][bj][m][0], v1 = acc[ai][bj][m][1];
          if (gate) {
#pragma unroll
            for (int j = 0; j < 4; ++j) { v0[j] = 1.0f + gate_e(v0[j]); v1[j] = 1.0f + gate_e(v1[j]); }
          }
          u32x4 w; w.x = pk2(v0[0], v0[1]); w.y = pk2(v0[2], v0[3]); w.z = pk2(v1[0], v1[1]); w.w = pk2(v1[2], v1[3]);
          NT_STORE((u32x4*)(rowp + bj * 128), w);
          if (kv) {
            const int cc = col0 + bj * 128 - cb * 512;
            float* o = (r < TP) ? out + (cb == CB_KA ? O_PK : O_PV) + ((size_t)l * TP + r) * W + cc
                                : out + (cb == CB_KA ? O_SK : O_SV) + ((size_t)l * TS + (r - TP)) * W + cc;
            *(f32x4*)o = v0; *(f32x4*)(o + 4) = v1;
          }
        }
      }
  }
};
struct EpiMergeH {
  static constexpr bool PERM = true; static constexpr int MID = 8;
  const bf16_t* P; bf16_t* MG;
  DI void mid(f32x4 (&acc)[2][2][4][2], const pg8::Unit& u, int seg, int wr, int wc, int fr, int fq) const {
    const int row0 = u.pm * 256 + wr * 64 + fr, col0 = u.pn * 256 + wc * 32 + 8 * fq;
#pragma unroll
    for (int ai = 0; ai < 2; ++ai) {
      u32x4 qa[4][2], qb[4][2];
#pragma unroll
      for (int m = 0; m < 4; ++m) {
        const bf16_t* gp = P + PIX(row0 + ai * 128 + m * 16, CB_G0 + seg * 4 + (u.pn >> 1)) + (col0 & 511);
#pragma unroll
        for (int bj = 0; bj < 2; ++bj) { qa[m][bj] = *(const u32x4*)(gp + bj * 128); qb[m][bj] = *(const u32x4*)(gp + (size_t)4 * T * 512 + bj * 128); }
      }
#pragma unroll
      for (int m = 0; m < 4; ++m)
#pragma unroll
        for (int bj = 0; bj < 2; ++bj) {
          float ga[8], gb[8]; unpack8(qa[m][bj], ga); unpack8(qb[m][bj], gb);
          float rt[8];
#pragma unroll
          for (int j = 0; j < 8; ++j) rt[j] = gb[j] * frcp(ga[j]);
          f32x4& v0 = acc[ai][bj][m][0]; f32x4& v1 = acc[ai][bj][m][1];
          v0 = (f32x4){v0[0] * rt[0], v0[1] * rt[1], v0[2] * rt[2], v0[3] * rt[3]};
          v1 = (f32x4){v1[0] * rt[4], v1[1] * rt[5], v1[2] * rt[6], v1[3] * rt[7]};
        }
      asm volatile("" ::: "memory");
    }
  }
  DI void operator()(const f32x4 (&acc)[2][2][4][2], const pg8::Unit& u, int wr, int wc, int fr, int fq) const {
    const int row0 = u.pm * 256 + wr * 64 + fr, col0 = u.pn * 256 + wc * 32 + 8 * fq;
    u32x4 q3[2][4][2];
#pragma unroll
    for (int ai = 0; ai < 2; ++ai)
#pragma unroll
      for (int m = 0; m < 4; ++m)
#pragma unroll
        for (int bj = 0; bj < 2; ++bj) q3[ai][m][bj] = *(const u32x4*)(P + PIX(row0 + ai * 128 + m * 16, CB_G0 + 12 + (u.pn >> 1)) + ((col0 + bj * 128) & 511));
#pragma unroll
    for (int ai = 0; ai < 2; ++ai)
#pragma unroll
      for (int m = 0; m < 4; ++m) {
        const int r = row0 + ai * 128 + m * 16;
#pragma unroll
        for (int bj = 0; bj < 2; ++bj) {
          const int cc = col0 + bj * 128;
          float g3[8]; unpack8(q3[ai][m][bj], g3);
          float s[8];
#pragma unroll
          for (int j = 0; j < 8; ++j) s[j] = frcp(g3[j]);
          const f32x4 v0 = acc[ai][bj][m][0], v1 = acc[ai][bj][m][1];
          u32x4 w; w.x = pk2(v0[0] * s[0], v0[1] * s[1]); w.y = pk2(v0[2] * s[2], v0[3] * s[3]); w.z = pk2(v1[0] * s[4], v1[1] * s[5]); w.w = pk2(v1[2] * s[6], v1[3] * s[7]);
          *(u32x4*)(MG + (size_t)r * D + cc) = w;
        }
      }
  }
};
struct EpiOut {
  static constexpr bool PERM = false; static constexpr int MID = 0;
  const float* xp; const float* xs; const float* xprev; float* y; int l;
  DI void operator()(const f32x4 (&acc)[2][2][4][2], const pg8::Unit& u, int wr, int wc, int fr, int fq) const {
    const int row0 = u.pm * 256 + wr * 64 + fr, col0 = u.pn * 256 + wc * 32 + 4 * fq;
#pragma unroll
    for (int ai = 0; ai < 2; ++ai) {
      f32x4 xv[4][2][2];
#pragma unroll
      for (int m = 0; m < 4; ++m) {
        const int r = row0 + ai * 128 + m * 16;
        const float* xin = (l == 0) ? (r < TP ? xp + (size_t)r * D : xs + (size_t)(r - TP) * D) : xprev + (size_t)r * D;
#pragma unroll
        for (int bj = 0; bj < 2; ++bj)
#pragma unroll
          for (int n = 0; n < 2; ++n) xv[m][bj][n] = *(const f32x4*)(xin + col0 + bj * 128 + n * 16);
      }
#pragma unroll
      for (int m = 0; m < 4; ++m) {
        float* yo = y + (size_t)(row0 + ai * 128 + m * 16) * D;
#pragma unroll
        for (int bj = 0; bj < 2; ++bj)
#pragma unroll
          for (int n = 0; n < 2; ++n) *(f32x4*)(yo + col0 + bj * 128 + n * 16) = xv[m][bj][n] + acc[ai][bj][m][n];
      }
    }
  }
};

struct ChunkGeo { int sq, c, b, h, row0, L, nch; bool sample; };
DI ChunkGeo chunk_geo(int ck) {
  ChunkGeo g;
  if (ck < NSEQ_P * NCH_P) { g.sq = ck / NCH_P; g.c = ck % NCH_P; g.b = g.sq / NH; g.h = g.sq % NH; g.row0 = g.b * SEQ + g.c * 64; g.L = 64; g.nch = NCH_P; g.sample = false; }
  else { const int s = ck - NSEQ_P * NCH_P; g.sq = NSEQ_P + s; g.c = 0; g.b = s / NH; g.h = s % NH; g.row0 = TP + g.b * DS; g.L = DS; g.nch = 1; g.sample = true; }
  return g;
}
DI int seq_pos0(const ChunkGeo& g) { return g.sample ? PAST : g.c * 64; }
DI float ret_log2gamma(int h) { return h == 0 ? -4.580368961e-02f : h == 1 ? -2.272007650e-02f : h == 2 ? -1.131531323e-02f : -5.646563141e-03f; }
DI float wave_prefix_sum(float v, int lane) {
#pragma unroll
  for (int o = 1; o < 64; o <<= 1) { const float t = wshfl_up(v, o, lane); if (lane >= o) v += t; }
  return v;
}
DI float wave_prefix_max(float v, int lane) {
#pragma unroll
  for (int o = 1; o < 64; o <<= 1) { const float t = wshfl_up(v, o, lane); if (lane >= o) v = fmaxf(v, t); }
  return v;
}
DI void rotary_frags(bf16x8 (&f)[8], const float* rope_pos, int h) {
#pragma unroll
  for (int s = 0; s < 4; ++s) {
    float x1[8], x2[8]; unpack8(__builtin_bit_cast(u32x4, f[s]), x1); unpack8(__builtin_bit_cast(u32x4, f[s + 4]), x2);
    const float* cs = rope_pos + 2 * (16 * s + 8 * h);
    float o1[8], o2[8];
#pragma unroll
    for (int j = 0; j < 8; ++j) { const float co = cs[2 * j], si = cs[2 * j + 1]; o1[j] = x1[j] * co - x2[j] * si; o2[j] = x1[j] * si + x2[j] * co; }
    f[s] = pack8(o1[0], o1[1], o1[2], o1[3], o1[4], o1[5], o1[6], o1[7]);
    f[s + 4] = pack8(o2[0], o2[1], o2[2], o2[3], o2[4], o2[5], o2[6], o2[7]);
  }
}
DI bf16x8 tr_frag(const LAS unsigned char* tile, int stride, int row_lo, int row_hi, int col0, int lane) {
  const int q = (lane & 15) >> 2, p = lane & 3, blk = (lane >> 4) & 1;
  const int cbyte = (col0 + 16 * blk + 4 * p) * 2;
  const s16x4 lo = ds_tr16(tile + (row_lo + q) * stride + cbyte);
  const s16x4 hi = ds_tr16(tile + (row_hi + q) * stride + cbyte);
  return (bf16x8){lo[0], lo[1], lo[2], lo[3], hi[0], hi[1], hi[2], hi[3]};
}

constexpr int OT_STRIDE = 132;
DI void o_to_lds(const f32x16* acc, LAS float* tile, int r, int h) {
#pragma unroll
  for (int i = 0; i < 16; ++i)
#pragma unroll
    for (int cc = 0; cc < 4; ++cc) tile[crow(i, h) * OT_STRIDE + 32 * cc + r] = acc[cc][i];
}
DI void conv_pass(const Ctx& c, int l, const LAS float* cw, int s0, int t0, int nt, bool sample, int b, const float (&bias)[8], const float (&lg)[8], const float (&lb)[8]) {
  const bf16_t* P = (const bf16_t*)(c.ws + WS_P);
  bf16_t* YC = (bf16_t*)(c.ws + WS_YCAT);
  const int lane = c.lane, c0 = 8 * lane;
  float acc[8][8];
#pragma unroll
  for (int t = 0; t < 8; ++t)
#pragma unroll
    for (int j = 0; j < 8; ++j) acc[t][j] = bias[j];
  const int nrows = nt + 30;
#define CONV_ROW(idx) (*(const u32x4*)(P + PIX(s0 + ((t0 - 30 + (idx)) < 0 ? 0 : ((t0 - 30 + (idx)) > t0 + nt - 1 ? t0 + nt - 1 : (t0 - 30 + (idx)))), CB_UD) + c0))
  u32x4 p0 = CONV_ROW(0), p1 = CONV_ROW(1), p2 = CONV_ROW(2), p3 = CONV_ROW(3), p4 = CONV_ROW(4), p5 = CONV_ROW(5);
#pragma unroll 1
  for (int jj = 0; jj < nrows; ++jj) {
    const u32x4 cur = p0; p0 = p1; p1 = p2; p2 = p3; p3 = p4; p4 = p5; p5 = CONV_ROW(jj + 6);
    const int rr = t0 - 30 + jj;
    float glu[8];
    if (rr >= 0) {
      unpack8(cur, glu);
    } else if (sample) {
      const float* hp = c.in[IN_CONV] + (((size_t)l * DB + b) * 30 + (30 + rr)) * W + c0;
      const f32x4 a = *(const f32x4*)hp, bb = *(const f32x4*)(hp + 4);
      glu[0] = a.x; glu[1] = a.y; glu[2] = a.z; glu[3] = a.w; glu[4] = bb.x; glu[5] = bb.y; glu[6] = bb.z; glu[7] = bb.w;
    } else {
#pragma unroll
      for (int j = 0; j < 8; ++j) glu[j] = 0.f;
    }
    if (sample) {
      const int xi = 30 + rr;
      if (xi >= 16 && (rr >= t0 || (rr < 0 && t0 == 0))) { float* o = c.out + O_SCONV + (((size_t)l * DB + b) * 30 + (xi - 16)) * W + c0;
        *(f32x4*)o = (f32x4){glu[0], glu[1], glu[2], glu[3]}; *(f32x4*)(o + 4) = (f32x4){glu[4], glu[5], glu[6], glu[7]}; }
    } else if (rr >= t0 && rr >= SEQ - 30) {
      float* o = c.out + O_PCONV + (((size_t)l * NBATCH + b) * 30 + (rr - (SEQ - 30))) * W + c0;
      *(f32x4*)o = (f32x4){glu[0], glu[1], glu[2], glu[3]}; *(f32x4*)(o + 4) = (f32x4){glu[4], glu[5], glu[6], glu[7]};
    }
#pragma unroll
    for (int t = 0; t < 8; ++t) {
      const int j = jj - t;
      if (j >= 0 && j <= 30 && t < nt) {
        const f32x4 w0 = *(const LAS f32x4*)(cw + j * W + 4 * lane), w1 = *(const LAS f32x4*)(cw + j * W + 256 + 4 * lane);
        acc[t][0] += w0.x * glu[0]; acc[t][1] += w0.y * glu[1]; acc[t][2] += w0.z * glu[2]; acc[t][3] += w0.w * glu[3];
        acc[t][4] += w1.x * glu[4]; acc[t][5] += w1.y * glu[5]; acc[t][6] += w1.z * glu[6]; acc[t][7] += w1.w * glu[7];
      }
    }
  }
#undef CONV_ROW
#pragma unroll
  for (int t = 0; t < 8; ++t) {
    if (t < nt) {
      float s1 = 0.f;
#pragma unroll
      for (int j = 0; j < 8; ++j) s1 += acc[t][j];
      const float mean = wave_sum(s1, lane) * (1.0f / W);
      float s2 = 0.f;
#pragma unroll
      for (int j = 0; j < 8; ++j) { const float d = acc[t][j] - mean; s2 += d * d; }
      const float rstd = frsq(wave_sum(s2, lane) * (1.0f / W) + 1e-5f);
      const int r = s0 + t0 + t;
      float zd[8]; unpack8(*(const u32x4*)(P + PIX(r, CB_ZD) + c0), zd);
      float o[8];
#pragma unroll
      for (int j = 0; j < 8; ++j) o[j] = silu_f((acc[t][j] - mean) * rstd * lg[j] + lb[j]) * silu_f(zd[j]);
      u32x4 w; w.x = pk2(o[0], o[1]); w.y = pk2(o[2], o[3]); w.z = pk2(o[4], o[5]); w.w = pk2(o[6], o[7]);
      *(u32x4*)(YC + (size_t)r * D + 3 * W + c0) = w;
    }
  }
}
DI void phase_conv(const Ctx& c, int l) {
  LAS float* cw = (LAS float*)c.lds;
  const float* cwg = c.in[IN_CWT] + (size_t)l * CW * W;
  for (int i = c.tid; i < CW * W; i += NTHREADS) { const int j = i / W, ch = i % W; cw[j * W + ((ch >> 2) & 1) * 256 + (ch >> 3) * 4 + (ch & 3)] = cwg[i]; }
  __syncthreads();
  const int c0 = 8 * c.lane;
  const int gwv = c.bid * NWAVES + c.wave, NGW = c.G * NWAVES;
  float bias[8], lg[8], lb[8];
#pragma unroll
  for (int j = 0; j < 8; ++j) { bias[j] = c.in[IN_CB][l * W + c0 + j]; lg[j] = c.in[IN_LNG][l * W + c0 + j]; lb[j] = c.in[IN_LNB][l * W + c0 + j]; }
  constexpr int NPP = TP / 8;
  for (int p0 = 2 * gwv; p0 < NPP; p0 += 2 * NGW)
    for (int p = p0; p < p0 + 2 && p < NPP; ++p) { const int b = p / (SEQ / 8), t0 = (p % (SEQ / 8)) * 8; conv_pass(c, l, cw, b * SEQ, t0, 8, false, b, bias, lg, lb); }
  for (int q = NGW - 1 - gwv; q < DB * (DS / 2); q += NGW) { const int b = q / (DS / 2), t0 = (q % (DS / 2)) * 2; conv_pass(c, l, cw, TP + b * DS, t0, 2, true, b, bias, lg, lb); }
  __syncthreads();
}

constexpr int NUP = NSEQ_P * (SEQ / 32), NUA = NUP + NSEQ_S;
constexpr int NLONGW = (NSEQ_P * 129 + NSEQ_P * 128 + 1) / 2;
constexpr float SB_C2 = 0.08838834764831845f * 1.4426950408889634f;
constexpr float SB_RSTOP = 140.0f;
DI void attn_unit(const Ctx& c, int l, int u) {
  int lane_ = c.lane; OPAQUE_V(lane_);
  const int lane = lane_, r = lane & 31, h = lane >> 5;
  const bf16_t* P = (const bf16_t*)(c.ws + WS_P);
  int b, head, qrow0, qpos0, nq, kstart; bool sample;
  if (u < NUP) { const int sq = u / (SEQ / 32), qb = u % (SEQ / 32); b = sq / NH; head = sq % NH; qrow0 = b * SEQ + qb * 32; qpos0 = qb * 32; nq = 32; kstart = qb * 32; sample = false; }
  else { const int s = u - NUP; b = s / NH; head = s % NH; qrow0 = TP + b * DS; qpos0 = PAST; nq = DS; kstart = PAST; sample = true; }
  const int qrow = qrow0 + (r < nq ? r : nq - 1);
  const int qpos = qpos0 + r;
  bf16x8 qf[8];
#pragma unroll
  for (int s = 0; s < 8; ++s) qf[s] = *(const bf16x8*)(P + PIX(qrow, CB_QA) + head * HD + 16 * s + 8 * h);
  f32x16 o[4];
#pragma unroll
  for (int cc = 0; cc < 4; ++cc)
#pragma unroll
    for (int i = 0; i < 16; ++i) o[cc][i] = 0.f;
  float R = 0.f;
  LAS unsigned char* vt = c.scr;
  const float* ck = c.in[IN_CK]; const float* cv = c.in[IN_CV];
  for (int k0 = kstart; k0 >= 0; k0 -= 32) {
    const bool from_cache = sample && k0 < PAST;
    bf16x8 kf[8];
    if (!from_cache) {
      const int krow = sample ? TP + b * DS + (r < DS ? r : DS - 1) : b * SEQ + k0 + r;
#pragma unroll
      for (int s = 0; s < 8; ++s) kf[s] = *(const bf16x8*)(P + PIX(krow, CB_KA) + head * HD + 16 * s + 8 * h);
#pragma unroll
      for (int i = 0; i < 8; ++i) { const int n = lane + 64 * i, vr = n >> 4, ch = n & 15;
        const int vrow = sample ? TP + b * DS + (vr < DS ? vr : DS - 1) : b * SEQ + k0 + vr;
        *(LAS u32x4*)(vt + vr * TS272 + ch * 16) = *(const u32x4*)(P + PIX(vrow, CB_VA) + head * HD + ch * 8); }
    } else {
      const float* kp = ck + ((((size_t)l * DB + b) * PAST + (k0 + r)) * NH + head) * HD;
#pragma unroll
      for (int s = 0; s < 8; ++s) { const f32x4 a = *(const f32x4*)(kp + 16 * s + 8 * h), bb = *(const f32x4*)(kp + 16 * s + 8 * h + 4); kf[s] = pack8(a.x, a.y, a.z, a.w, bb.x, bb.y, bb.z, bb.w); }
#pragma unroll
      for (int i = 0; i < 8; ++i) { const int n = lane + 64 * i, vr = n >> 4, ch = n & 15;
        const float* vp = cv + ((((size_t)l * DB + b) * PAST + (k0 + vr)) * NH + head) * HD + ch * 8;
        const f32x4 a = *(const f32x4*)vp, bb = *(const f32x4*)(vp + 4);
        *(LAS bf16x8*)(vt + vr * TS272 + ch * 16) = pack8(a.x, a.y, a.z, a.w, bb.x, bb.y, bb.z, bb.w); }
    }
    f32x16 sacc;
#pragma unroll
    for (int i = 0; i < 16; ++i) sacc[i] = 0.f;
#pragma unroll
    for (int s = 0; s < 8; ++s) sacc = mfma32(kf[s], qf[s], sacc);
    float z2[16], sp[16];
#pragma unroll
    for (int i = 0; i < 16; ++i) {
      const bool ok = (k0 + crow(i, h)) < qpos;
      z2[i] = fminf(sacc[i] * SB_C2, 126.0f);
      sp[i] = ok ? lg2(1.0f + ex2(z2[i])) : 0.0f;
      z2[i] = ok ? z2[i] : -1e30f;
    }
    float gs[4], pg[4];
#pragma unroll
    for (int j = 0; j < 4; ++j) { gs[j] = (sp[4 * j] + sp[4 * j + 1]) + (sp[4 * j + 2] + sp[4 * j + 3]); pg[j] = wshfl_xor(gs[j], 32, lane); }
    float after = 0.f, wgt[16];
#pragma unroll
    for (int j = 3; j >= 0; --j) {
      float run = after + (h == 0 ? pg[j] : 0.f) + R;
#pragma unroll
      for (int ii = 3; ii >= 0; --ii) { run += sp[4 * j + ii]; wgt[4 * j + ii] = ex2(z2[4 * j + ii] - run); }
      after += (h == 0) ? (gs[j] + pg[j]) : (pg[j] + gs[j]);
    }
    R += after;
    const bf16x8 pf0 = pack8(wgt[0], wgt[1], wgt[2], wgt[3], wgt[4], wgt[5], wgt[6], wgt[7]);
    const bf16x8 pf1 = pack8(wgt[8], wgt[9], wgt[10], wgt[11], wgt[12], wgt[13], wgt[14], wgt[15]);
    LDS_WAIT();
#pragma unroll
    for (int cc = 0; cc < 4; ++cc) {
      const bf16x8 v0 = tr_frag(vt, TS272, 4 * h, 8 + 4 * h, 32 * cc, lane);
      const bf16x8 v1 = tr_frag(vt, TS272, 16 + 4 * h, 24 + 4 * h, 32 * cc, lane);
      o[cc] = mfma32(pf0, v0, o[cc]);
      o[cc] = mfma32(pf1, v1, o[cc]);
    }
    const float rmin = wave_min(r < nq ? R : 1e30f, lane);
    if (rmin >= SB_RSTOP) break;
  }
  bf16_t* YC = (bf16_t*)(c.ws + WS_YCAT);
  LAS float* ot = (LAS float*)c.scr;
  LDS_WAIT();
  o_to_lds(o, ot, r, h);
  LDS_WAIT();
#pragma unroll
  for (int i = 0; i < 8; ++i) {
    const int q = lane + 64 * i, t = q >> 4, ch = q & 15;
    if (t < nq) {
      const size_t row = (size_t)(qrow0 + t);
      const int col = head * HD + 8 * ch;
      const f32x4 x0 = *(const LAS f32x4*)(ot + t * OT_STRIDE + 8 * ch), x1 = *(const LAS f32x4*)(ot + t * OT_STRIDE + 8 * ch + 4);
      float za[8]; unpack8(*(const u32x4*)(P + PIX(row, CB_ZA) + col), za);
      u32x4 w; w.x = pk2(x0.x * silu_f(za[0]), x0.y * silu_f(za[1])); w.y = pk2(x0.z * silu_f(za[2]), x0.w * silu_f(za[3]));
      w.z = pk2(x1.x * silu_f(za[4]), x1.y * silu_f(za[5])); w.w = pk2(x1.z * silu_f(za[6]), x1.w * silu_f(za[7]));
      *(u32x4*)(YC + row * D + col) = w;
    }
  }
  LDS_WAIT();
}

DI bf16_t* st_ptr(const Ctx& c, int br, int ck) { return (bf16_t*)(c.ws + WS_ST + ((size_t)br * NCHUNK + ck) * ST_BYTES); }
DI bf16_t* st2_ptr(const Ctx& c, int br, int ck) { return (bf16_t*)(c.ws + WS_ST2 + ((size_t)br * NCHUNK + ck) * ST_BYTES); }
template <int BR> DI void scan_local_unit(const Ctx& c, int l, int ck, int eb) {
  int lane_ = c.lane; OPAQUE_V(lane_);
  const int lane = lane_, r = lane & 31, h = lane >> 5;
  const ChunkGeo g = chunk_geo(ck);
  const bf16_t* P = (const bf16_t*)(c.ws + WS_P);
  LAS unsigned char* kt = c.scr;
  LAS unsigned char* vtl = c.scr + 64 * 144;
  LAS float* wtab = (LAS float*)(c.scr + 64 * 144 + 64 * 80);
  constexpr int KS = 144, VS = 80;
  const int kcb = BR == 0 ? CB_KB : CB_KC, vcb = BR == 0 ? CB_VB : CB_VC;
  const float* rope = (const float*)(c.ws + WS_ROPE);
  u32x4 kx1[8], kx2[8], vv[4];
#pragma unroll
  for (int i = 0; i < 8; ++i) {
    const int n = lane + 64 * i, s = n >> 3, ch = n & 7;
    const bf16_t* kp = P + PIX(g.row0 + (s < g.L ? s : g.L - 1), kcb) + g.h * HD;
    kx1[i] = *(const u32x4*)(kp + ch * 8); kx2[i] = *(const u32x4*)(kp + 64 + ch * 8);
  }
#pragma unroll
  for (int i = 0; i < 4; ++i) {
    const int n = lane + 64 * i, s = n >> 2, ch = n & 3;
    const int row = g.row0 + (s < g.L ? s : g.L - 1);
    if (eb < 4) vv[i] = *(const u32x4*)(P + PIX(row, vcb) + g.h * HD + eb * 32 + ch * 8);
    else vv[i] = (u32x4){ch == 0 ? 0x00003F80u : 0u, 0u, 0u, 0u};
  }
  {
    const int s = lane; float w;
    if (BR == 0) {
      const float* LFp = (const float*)(c.ws + WS_LF); const float* IGp = (const float*)(c.ws + WS_IG);
      const float lf = s < g.L ? LFp[(size_t)(g.row0 + s) * 4 + g.h] : 0.f;
      const float ig = s < g.L ? IGp[(size_t)(g.row0 + s) * 4 + g.h] : -1e30f;
      const float bcum = wave_prefix_sum(lf, lane);
      const float Bc = wshfl(bcum, 63);
      const float gg = Bc - bcum + ig;
      const float G = wave_max(gg, lane);
      w = s < g.L ? __expf(gg - G) : 0.f;
      if (eb == 0 && lane == 0) { ((float*)(c.ws + WS_SCB))[ck] = Bc; ((float*)(c.ws + WS_SCG))[ck] = G; }
    } else {
      w = s < g.L ? ex2(ret_log2gamma(g.h) * (float)(g.L - 1 - s)) : 0.f;
    }
    wtab[s] = w * 0.08838834764831845f;
  }
#pragma unroll
  for (int i = 0; i < 4; ++i) { const int n = lane + 64 * i, s = n >> 2, ch = n & 3; *(LAS u32x4*)(vtl + s * VS + ch * 16) = vv[i]; }
  LDS_WAIT();
  f32x16 acc[4];
#pragma unroll
  for (int cc = 0; cc < 4; ++cc)
#pragma unroll
    for (int i = 0; i < 16; ++i) acc[cc][i] = 0.f;
  bf16x8 af[4];
#pragma unroll
  for (int ks = 0; ks < 4; ++ks) af[ks] = tr_frag(vtl, VS, 16 * ks + 8 * h, 16 * ks + 8 * h + 4, 0, lane);
#pragma unroll
  for (int dh = 0; dh < 2; ++dh) {
#pragma unroll
    for (int i = 0; i < 8; ++i) {
      const int n = lane + 64 * i, s = n >> 3, ch = n & 7;
      float o[8];
      if (BR == 0) { unpack8(dh == 0 ? kx1[i] : kx2[i], o); }
      else {
        float x1[8], x2[8]; unpack8(kx1[i], x1); unpack8(kx2[i], x2);
        const float* cs = rope + ((size_t)(seq_pos0(g) + (s < g.L ? s : g.L - 1)) * 64 + ch * 8) * 2;
#pragma unroll
        for (int j = 0; j < 8; ++j) { const float co = cs[2 * j], si = cs[2 * j + 1]; o[j] = dh == 0 ? x1[j] * co - x2[j] * si : x1[j] * si + x2[j] * co; }
      }
      const float w = wtab[s];
      *(LAS bf16x8*)(kt + s * KS + ch * 16) = pack8(o[0] * w, o[1] * w, o[2] * w, o[3] * w, o[4] * w, o[5] * w, o[6] * w, o[7] * w);
      if (BR == 1 && (i & 1)) asm volatile("" ::: "memory");
    }
    LDS_WAIT();
#pragma unroll
    for (int ks = 0; ks < 4; ++ks)
#pragma unroll
      for (int cc = 0; cc < 2; ++cc) {
        const bf16x8 bfr = tr_frag(kt, KS, 16 * ks + 8 * h, 16 * ks + 8 * h + 4, 32 * cc, lane);
        acc[2 * dh + cc] = mfma32(af[ks], bfr, acc[2 * dh + cc]);
      }
    LDS_WAIT();
  }
  LAS float* ot = (LAS float*)c.scr;
  o_to_lds(acc, ot, r, h);
  LDS_WAIT();
  bf16_t* st = st_ptr(c, BR, ck);
#pragma unroll
  for (int i = 0; i < 8; ++i) {
    const int q = lane + 64 * i, t = q >> 4, ch = q & 15, e = 32 * eb + t;
    if (e <= 128) {
      const f32x4 x0 = *(const LAS f32x4*)(ot + t * OT_STRIDE + 8 * ch), x1 = *(const LAS f32x4*)(ot + t * OT_STRIDE + 8 * ch + 4);
      u32x4 w; w.x = pk2(x0.x, x0.y); w.y = pk2(x0.z, x0.w); w.z = pk2(x1.x, x1.y); w.w = pk2(x1.z, x1.w);
      *(u32x4*)(st + (size_t)e * HD + 8 * ch) = w;
    }
  }
  LDS_WAIT();
}

DI void scan_prop_item(const Ctx& c, int l, int it) {
  constexpr int NLP = NSEQ_P * 129 + NSEQ_P * 128, NTOT = NSEQ * 129 + NSEQ * 128;
  const bool live = it < NTOT;
  if (!live) it = NTOT - 1;
  int br, sq, e;
  if (it < NLP) { if (it < NSEQ_P * 129) { br = 0; sq = it / 129; e = it % 129; } else { const int j = it - NSEQ_P * 129; br = 1; sq = j / 128; e = j % 128; } }
  else { const int j = it - NLP; if (j < NSEQ_S * 129) { br = 0; sq = NSEQ_P + j / 129; e = j % 129; } else { const int k = j - NSEQ_S * 129; br = 1; sq = NSEQ_P + k / 128; e = k % 128; } }
  const int d0 = 4 * (c.lane & 31);
  const bool sample = sq >= NSEQ_P;
  const int b = sample ? (sq - NSEQ_P) / NH : sq / NH, h = sample ? (sq - NSEQ_P) % NH : sq % NH;
  const int nch = sample ? 1 : NCH_P, ck0 = sample ? NSEQ_P * NCH_P + (sq - NSEQ_P) : sq * NCH_P;
  const int L = sample ? DS : 64;
  float s[4] = {0.f, 0.f, 0.f, 0.f}; float m = 0.f;
  if (sample) {
    if (br == 0) {
      if (e < 128) { const float* C0 = c.in[IN_MC] + (((size_t)l * DB + b) * NH + h) * HD * HD;
#pragma unroll
        for (int j = 0; j < 4; ++j) s[j] = C0[(size_t)(d0 + j) * HD + e]; }
      else { const float* n0 = c.in[IN_MN] + (((size_t)l * DB + b) * NH + h) * HD;
#pragma unroll
        for (int j = 0; j < 4; ++j) s[j] = n0[d0 + j]; }
      m = c.in[IN_MM][((size_t)l * DB + b) * NH + h];
    } else { const float* S0 = c.in[IN_RS] + (((size_t)l * DB + b) * NH + h) * HD * HD;
#pragma unroll
      for (int j = 0; j < 4; ++j) s[j] = S0[(size_t)(d0 + j) * HD + e]; }
  }
  const float* SCB = (const float*)(c.ws + WS_SCB); const float* SCG = (const float*)(c.ws + WS_SCG); float* MCp = (float*)(c.ws + WS_MC);
  const float cdec = br == 1 ? ex2(ret_log2gamma(h) * (float)L) : 0.f;
  constexpr int PB = 32;
  const int hl = c.lane & 31, hbase = c.lane & 32;
  LAS float* tab = (LAS float*)c.scr + 2 * hbase;
  if (nch == 1) {
    const int ck = ck0;
    const u32x2 dv1 = *(const u32x2*)(st_ptr(c, br, ck) + (size_t)e * HD + d0);
    const float q0 = bits_f(dv1.x << 16), q1 = bits_f(dv1.x & 0xffff0000u), q2 = bits_f(dv1.y << 16), q3 = bits_f(dv1.y & 0xffff0000u);
    if (live) *(u32x2*)(st2_ptr(c, br, ck) + (size_t)e * HD + d0) = (u32x2){pk2(s[0], s[1]), pk2(s[2], s[3])};
    if (br == 0) {
      const float Bl = SCB[ck], Gl = SCG[ck], m_out = fmaxf(m + Bl, Gl), dec = __expf(m + Bl - m_out), inj = __expf(Gl - m_out);
      if (live && e == 0 && hl == 0) MCp[ck] = m;
      s[0] = dec * s[0] + inj * q0; s[1] = dec * s[1] + inj * q1; s[2] = dec * s[2] + inj * q2; s[3] = dec * s[3] + inj * q3; m = m_out;
    } else { s[0] = cdec * s[0] + q0; s[1] = cdec * s[1] + q1; s[2] = cdec * s[2] + q2; s[3] = cdec * s[3] + q3; }
  } else
  for (int ci0 = 0; ci0 < nch; ci0 += PB) {
    u32x2 dv[PB];
#pragma unroll
    for (int j = 0; j < PB; ++j) {
      const int ck = ck0 + (ci0 + j < nch ? ci0 + j : nch - 1);
      dv[j] = *(const u32x2*)(st_ptr(c, br, ck) + (size_t)e * HD + d0);
    }
    if (br == 0) {
      const bool okc = ci0 + hl < nch;
      const int ckl = ck0 + (okc ? ci0 + hl : nch - 1);
      const float Bl = okc ? SCB[ckl] : 0.f, Gl = okc ? SCG[ckl] : -1e30f;
      float BB = Bl, GG = Gl;
#pragma unroll
      for (int o = 1; o < 32; o <<= 1) {
        const float pb = wshfl(BB, hbase + (hl >= o ? hl - o : hl)), pg = wshfl(GG, hbase + (hl >= o ? hl - o : hl));
        if (hl >= o) { GG = fmaxf(pg + BB, GG); BB = pb + BB; }
      }
      const float m_out = fmaxf(m + BB, GG);
      float m_in = wshfl(m_out, hbase + (hl > 0 ? hl - 1 : 0)); if (hl == 0) m_in = m;
      tab[2 * hl] = __expf(m_in + Bl - m_out); tab[2 * hl + 1] = __expf(Gl - m_out);
      if (live && okc && e == 0) MCp[ckl] = m_in;
      m = wshfl(m_out, hbase + 31);
      LDS_WAIT();
    }
#pragma unroll
    for (int j = 0; j < PB; ++j) {
      if (ci0 + j < nch) {
        const int ck = ck0 + ci0 + j;
        const float q0 = bits_f(dv[j].x << 16), q1 = bits_f(dv[j].x & 0xffff0000u), q2 = bits_f(dv[j].y << 16), q3 = bits_f(dv[j].y & 0xffff0000u);
        if (live) *(u32x2*)(st2_ptr(c, br, ck) + (size_t)e * HD + d0) = (u32x2){pk2(s[0], s[1]), pk2(s[2], s[3])};
        if (br == 0) { const float dec = tab[2 * j], inj = tab[2 * j + 1];
          s[0] = dec * s[0] + inj * q0; s[1] = dec * s[1] + inj * q1; s[2] = dec * s[2] + inj * q2; s[3] = dec * s[3] + inj * q3; }
        else { s[0] = cdec * s[0] + q0; s[1] = cdec * s[1] + q1; s[2] = cdec * s[2] + q2; s[3] = cdec * s[3] + q3; }
      }
    }
    LDS_WAIT();
  }
  if (!live) return;
  if (br == 0) {
    if (e < 128) { float* o = c.out + (sample ? O_SC + (((size_t)l * DB + b) * NH + h) * HD * HD : O_PC + (((size_t)l * NBATCH + b) * NH + h) * HD * HD);
#pragma unroll
      for (int j = 0; j < 4; ++j) o[(size_t)(d0 + j) * HD + e] = s[j]; }
    else { float* o = c.out + (sample ? O_SN + (((size_t)l * DB + b) * NH + h) * HD : O_PN + (((size_t)l * NBATCH + b) * NH + h) * HD); *(f32x4*)(o + d0) = (f32x4){s[0], s[1], s[2], s[3]}; }
    if (e == 0 && (c.lane & 31) == 0) c.out[(sample ? O_SM + ((size_t)l * DB + b) * NH + h : O_PM + ((size_t)l * NBATCH + b) * NH + h)] = m;
  } else {
    float* o = c.out + (sample ? O_SS + (((size_t)l * DB + b) * NH + h) * HD * HD : O_PS + (((size_t)l * NBATCH + b) * NH + h) * HD * HD);
#pragma unroll
    for (int j = 0; j < 4; ++j) o[(size_t)(d0 + j) * HD + e] = s[j];
  }
}

template <int BR> DI void scan_apply_unit(const Ctx& c, int l, int ck, int th) {
  int lane_ = c.lane; OPAQUE_V(lane_);
  const int lane = lane_, r = lane & 31, h = lane >> 5;
  const ChunkGeo g = chunk_geo(ck);
  if (32 * th >= g.L) return;
  const bf16_t* P = (const bf16_t*)(c.ws + WS_P);
  LAS unsigned char* vt = c.scr;
  LAS float* tb = (LAS float*)(c.scr + 64 * TS272);
  LAS float* t_a = tb; LAS float* t_w = tb + 64; LAS float* t_0 = tb + 128; LAS float* t_1 = tb + 160; LAS float* t_2 = tb + 192;
  const int qcb = BR == 0 ? CB_QB : CB_QC, kcb = BR == 0 ? CB_KB : CB_KC, vcb = BR == 0 ? CB_VB : CB_VC;
  const float* rope = (const float*)(c.ws + WS_ROPE);
  const int pos0 = seq_pos0(g);
  const float l2g = ret_log2gamma(g.h);
  const int tq = 32 * th + r, tqc = tq < g.L ? tq : g.L - 1;
  bf16x8 qf[8];
  u32x4 vreg[16];
#pragma unroll
  for (int s = 0; s < 8; ++s) qf[s] = *(const bf16x8*)(P + PIX(g.row0 + tqc, qcb) + g.h * HD + 16 * s + 8 * h);
#pragma unroll
  for (int i = 0; i < 16; ++i) { const int n = lane + 64 * i, s = n >> 4, ch = n & 15; const int row = g.row0 + (s < g.L ? s : g.L - 1);
    vreg[i] = *(const u32x4*)(P + PIX(row, vcb) + g.h * HD + ch * 8); }
  float Mt = 0.f;
  {
    const int s = lane;
    if (BR == 0) {
      const float* LFp = (const float*)(c.ws + WS_LF); const float* IGp = (const float*)(c.ws + WS_IG);
      const float lf = s < g.L ? LFp[(size_t)(g.row0 + s) * 4 + g.h] : 0.f;
      const float ig = s < g.L ? IGp[(size_t)(g.row0 + s) * 4 + g.h] : -1e30f;
      const float bcum = wave_prefix_sum(lf, lane);
      const float a = ig - bcum;
      const float pm = wave_prefix_max(a, lane);
      const float mc = ((const float*)(c.ws + WS_MC))[ck];
      const float M = fmaxf(mc, pm);
      t_a[s] = a;
      if ((s >> 5) == th) { t_0[s & 31] = __expf(mc - M); t_1[s & 31] = __expf(-(bcum + M)); }
      Mt = wshfl(M, 32 * th + r);
    } else {
      t_w[s] = ex2(-l2g * (float)s);
      if ((s >> 5) == th) t_0[s & 31] = ex2(l2g * (float)(s + 1));
    }
  }
  if (BR == 1) rotary_frags(qf, rope + (size_t)(pos0 + tqc) * 128, h);
#pragma unroll
  for (int i = 0; i < 16; ++i) { const int n = lane + 64 * i, s = n >> 4, ch = n & 15; *(LAS u32x4*)(vt + s * TS272 + ch * 16) = vreg[i]; }
  LDS_WAIT();
  constexpr int NB = BR == 0 ? 5 : 4;
  f32x16 acc[NB];
  const bf16_t* st = st2_ptr(c, BR, ck);
#pragma unroll
  for (int cc = 0; cc < NB; ++cc) {
#pragma unroll
    for (int i = 0; i < 16; ++i) acc[cc][i] = 0.f;
#pragma unroll
    for (int s = 0; s < 8; ++s) { const bf16x8 bfr = *(const bf16x8*)(st + (size_t)(32 * cc + r) * HD + 16 * s + 8 * h); acc[cc] = mfma32(qf[s], bfr, acc[cc]); }
  }
  {
    float sc[16];
#pragma unroll
    for (int i = 0; i < 16; ++i) sc[i] = t_0[crow(i, h)];
#pragma unroll
    for (int cc = 0; cc < NB; ++cc)
#pragma unroll
      for (int i = 0; i < 16; ++i) acc[cc][i] *= sc[i];
  }
  const float gt = BR == 1 ? ex2(l2g * (float)tq) : 0.f;
  for (int kb = 0; kb <= th; ++kb) {
    bf16x8 kf[8];
    const int sk = 32 * kb + r, skc = sk < g.L ? sk : g.L - 1;
#pragma unroll
    for (int s = 0; s < 8; ++s) kf[s] = *(const bf16x8*)(P + PIX(g.row0 + skc, kcb) + g.h * HD + 16 * s + 8 * h);
    if (BR == 1) rotary_frags(kf, rope + (size_t)(pos0 + skc) * 128, h);
    f32x16 sacc;
#pragma unroll
    for (int i = 0; i < 16; ++i) sacc[i] = 0.f;
#pragma unroll
    for (int s = 0; s < 8; ++s) sacc = mfma32(kf[s], qf[s], sacc);
    float wv[16];
#pragma unroll
    for (int i = 0; i < 16; ++i) {
      const int s = 32 * kb + crow(i, h);
      const bool ok = s <= tq && s < g.L;
      float w;
      if (BR == 0) w = __expf(fminf(t_a[s] - Mt, 0.f)) * sacc[i] * 0.08838834764831845f;
      else w = sacc[i] * 0.08838834764831845f * gt * t_w[s];
      wv[i] = ok ? w : 0.f;
    }
    const bf16x8 pf0 = pack8(wv[0], wv[1], wv[2], wv[3], wv[4], wv[5], wv[6], wv[7]);
    const bf16x8 pf1 = pack8(wv[8], wv[9], wv[10], wv[11], wv[12], wv[13], wv[14], wv[15]);
#pragma unroll
    for (int cc = 0; cc < 4; ++cc) {
      const bf16x8 v0 = tr_frag(vt, TS272, 32 * kb + 4 * h, 32 * kb + 8 + 4 * h, 32 * cc, lane);
      const bf16x8 v1 = tr_frag(vt, TS272, 32 * kb + 16 + 4 * h, 32 * kb + 24 + 4 * h, 32 * cc, lane);
      acc[cc] = mfma32(pf0, v0, acc[cc]);
      acc[cc] = mfma32(pf1, v1, acc[cc]);
    }
    if (BR == 0) {
      const bf16x8 ones = r == 0 ? (bf16x8){0x3F80, 0x3F80, 0x3F80, 0x3F80, 0x3F80, 0x3F80, 0x3F80, 0x3F80} : (bf16x8){0, 0, 0, 0, 0, 0, 0, 0};
      acc[NB - 1] = mfma32(pf0, ones, acc[NB - 1]);
      acc[NB - 1] = mfma32(pf1, ones, acc[NB - 1]);
    }
  }
  if (BR == 0) {
    if (r == 0) {
#pragma unroll
      for (int i = 0; i < 16; ++i) t_2[crow(i, h)] = acc[NB - 1][i];
    }
    LDS_WAIT();
#pragma unroll
    for (int i = 0; i < 16; ++i) {
      const int t = crow(i, h);
      const float dn = fmaxf(fabsf(t_2[t]), t_1[t]);
      const float inv = frcp(dn);
#pragma unroll
      for (int cc = 0; cc < 4; ++cc) acc[cc][i] *= inv;
    }
  }
  bf16_t* YC = (bf16_t*)(c.ws + WS_YCAT);
  LAS float* ot = (LAS float*)c.scr;
  LDS_WAIT();
  o_to_lds(acc, ot, r, h);
  LDS_WAIT();
  {
    const LAS float* rp = ot + r * OT_STRIDE + 64 * h;
    float s1 = 0.f, s2 = 0.f;
#pragma unroll
    for (int k = 0; k < 16; ++k) { const f32x4 x = *(const LAS f32x4*)(rp + 4 * k); s1 += (x.x + x.y) + (x.z + x.w); s2 += (x.x * x.x + x.y * x.y) + (x.z * x.z + x.w * x.w); }
    s1 += wshfl_xor(s1, 32, lane); s2 += wshfl_xor(s2, 32, lane);
    const float mean = s1 * (1.0f / HD), var = fmaxf(s2 * (1.0f / HD) - mean * mean, 0.f);
    if (h == 0) { t_0[r] = mean; t_1[r] = frsq(var + 1e-5f); }
  }
  LDS_WAIT();
#pragma unroll
  for (int i = 0; i < 8; ++i) {
    const int q = lane + 64 * i, t = q >> 4, ch = q & 15;
    if (32 * th + t < g.L) {
      const size_t row = (size_t)(g.row0 + 32 * th + t);
      const int col = g.h * HD + 8 * ch;
      const f32x4 x0 = *(const LAS f32x4*)(ot + t * OT_STRIDE + 8 * ch), x1 = *(const LAS f32x4*)(ot + t * OT_STRIDE + 8 * ch + 4);
      const float mean = t_0[t], rstd = t_1[t];
      float y[8] = {(x0.x - mean) * rstd, (x0.y - mean) * rstd, (x0.z - mean) * rstd, (x0.w - mean) * rstd, (x1.x - mean) * rstd, (x1.y - mean) * rstd, (x1.z - mean) * rstd, (x1.w - mean) * rstd};
      if (BR == 0) {
        float ob[8], zb[8]; unpack8(*(const u32x4*)(P + PIX(row, CB_OB) + col), ob); unpack8(*(const u32x4*)(P + PIX(row, CB_ZB) + col), zb);
#pragma unroll
        for (int j = 0; j < 8; ++j) y[j] *= sigmoid_f(ob[j]) * silu_f(zb[j]);
      } else {
        float zc[8]; unpack8(*(const u32x4*)(P + PIX(row, CB_ZC) + col), zc);
#pragma unroll
        for (int j = 0; j < 8; ++j) y[j] *= silu_f(zc[j]);
      }
      u32x4 w; w.x = pk2(y[0], y[1]); w.y = pk2(y[2], y[3]); w.z = pk2(y[4], y[5]); w.w = pk2(y[6], y[7]);
      *(u32x4*)(YC + row * D + (BR == 0 ? 1 : 2) * W + col) = w;
    }
  }
  LDS_WAIT();
}

template <int MODE> DI void sample_tail_gemm(const Ctx& c, int l, const bf16_t* Wt  , const bf16_t* Act  ) {
  int lane_ = c.lane; OPAQUE_V(lane_);
  const int lane = lane_, r = lane & 31, h = lane >> 5, wv = c.wave, tw = wv & 3, kh = wv >> 2;
  const bf16_t* P = (const bf16_t*)(c.ws + WS_P);
  constexpr int NTILE = (TS / 32) * (D / 32);
  LAS float* xch = (LAS float*)(c.lds) + tw * 1024;
  for (int tb = c.bid; tb * 4 < NTILE; tb += c.G) {
    const int tile = tb * 4 + tw, tt = tile / (D / 32), nn = tile % (D / 32);
    const int t0 = 32 * tt, n0 = 32 * nn;
    const bf16_t* ap = Wt + (size_t)(n0 + r) * D + kh * 1024 + 8 * h;
    const bf16_t* bp = Act + (size_t)(t0 + r) * D + kh * 1024 + 8 * h;
    f32x16 acc;
#pragma unroll
    for (int i = 0; i < 16; ++i) acc[i] = 0.f;
    const size_t grow = (size_t)(TP + t0 + r);
#pragma unroll 1
    for (int sg = 0; sg < 2; ++sg) {
#pragma unroll 1
      for (int k0 = 0; k0 < 32; k0 += 8) {
        bf16x8 af[8], bf[8];
#pragma unroll
        for (int q = 0; q < 8; ++q) { af[q] = *(const bf16x8*)(ap + (sg * 32 + k0 + q) * 16); bf[q] = *(const bf16x8*)(bp + (sg * 32 + k0 + q) * 16); }
#pragma unroll
        for (int q = 0; q < 8; ++q) acc = mfma32(af[q], bf[q], acc);
      }
      if (MODE == 0) {
        const int br = 2 * kh + sg;
#pragma unroll
        for (int g4 = 0; g4 < 4; ++g4) {
          const int n = n0 + 8 * g4 + 4 * h;
          const u32x2 ea = *(const u32x2*)(P + PIX(grow, CB_G0 + 4 * br + (n >> 9)) + (n & 511));
          float e0[4] = {bits_f(ea.x << 16), bits_f(ea.x & 0xffff0000u), bits_f(ea.y << 16), bits_f(ea.y & 0xffff0000u)};
          float sc[4];
          if (sg == 0) {
            const u32x2 eb = *(const u32x2*)(P + PIX(grow, CB_G0 + 4 * (br + 1) + (n >> 9)) + (n & 511));
            const float e1[4] = {bits_f(eb.x << 16), bits_f(eb.x & 0xffff0000u), bits_f(eb.y << 16), bits_f(eb.y & 0xffff0000u)};
#pragma unroll
            for (int j = 0; j < 4; ++j) sc[j] = e1[j] * frcp(e0[j]);
          } else {
#pragma unroll
            for (int j = 0; j < 4; ++j) sc[j] = frcp(e0[j]);
          }
#pragma unroll
          for (int j = 0; j < 4; ++j) acc[4 * g4 + j] *= sc[j];
        }
      }
    }
    if (kh == 1) {
#pragma unroll
      for (int i = 0; i < 16; ++i) xch[i * 64 + lane] = acc[i];
    }
    __syncthreads();
    if (kh == 0) {
#pragma unroll
      for (int i = 0; i < 16; ++i) acc[i] += xch[i * 64 + lane];
#pragma unroll
      for (int g4 = 0; g4 < 4; ++g4) {
        const int n = n0 + 8 * g4 + 4 * h;
        if (MODE == 0) {
          bf16_t* o = (bf16_t*)(c.ws + WS_MG) + grow * D + n;
          *(u32x2*)o = (u32x2){pk2(acc[4 * g4], acc[4 * g4 + 1]), pk2(acc[4 * g4 + 2], acc[4 * g4 + 3])};
        } else {
          const float* xin = (l == 0) ? c.in[IN_XS] + (size_t)(t0 + r) * D + n : c.out + O_Y + grow * D + n;
          const f32x4 xv = *(const f32x4*)xin;
          *(f32x4*)(c.out + O_Y + grow * D + n) = (f32x4){xv.x + acc[4 * g4], xv.y + acc[4 * g4 + 1], xv.z + acc[4 * g4 + 2], xv.w + acc[4 * g4 + 3]};
        }
      }
    }
    __syncthreads();
  }
}

DI void phase_final(const Ctx& c) {
  const float* fg = c.in[IN_FG];
  const int gwv = c.bid * NWAVES + c.wave, NGW = c.G * NWAVES, lane = c.lane;
  f32x4 gv[8];
#pragma unroll
  for (int j = 0; j < 8; ++j) gv[j] = *(const f32x4*)(fg + 256 * j + 4 * lane);
  for (int r = gwv; r < T; r += NGW) {
    float* xr = c.out + O_Y + (size_t)r * D;
    f32x4 v[8]; float ss = 0.f;
#pragma unroll
    for (int j = 0; j < 8; ++j) { v[j] = *(const f32x4*)(xr + 256 * j + 4 * lane); ss += (v[j].x * v[j].x + v[j].y * v[j].y) + (v[j].z * v[j].z + v[j].w * v[j].w); }
    const float rstd = frsq(wave_sum(ss, lane) * (1.0f / D) + 1e-6f);
#pragma unroll
    for (int j = 0; j < 8; ++j) *(f32x4*)(xr + 256 * j + 4 * lane) = v[j] * rstd * gv[j];
  }
}

constexpr int PH_PRO = 0, PH_PER_LAYER = 7, PH_FINAL = 1 + DEPTH * PH_PER_LAYER, PH_COUNT = PH_FINAL + 1;
constexpr int CW_BAR = 4096;

__global__ void __launch_bounds__(NTHREADS, 2) fwd(Args args) {
  DYN_LDS(lds);
  Ctx c;
  c.lds = lds; c.tid = threadIdx.x; c.lane = c.tid & 63; c.wave = rfl(c.tid >> 6); c.G = gridDim.x; c.bid = blockIdx.x;
  const int wave_s = c.wave; (void)wave_s;
  c.scr = lds + c.wave * WSCR;
#pragma unroll
  for (int i = 0; i < 20; ++i) c.in[i] = args.in[i];
  c.out = args.out; c.ws = args.ws;
  const int lo = args.ph_lo, hi = args.ph_hi;
#ifndef EMU
  if (c.tid < 16) ((LAS unsigned*)(lds + LDSCTL_OFF))[c.tid] = 0u;
  __syncthreads();
  XcdBarrier bar = xcd_barrier_post((unsigned*)(c.ws + WS_CTL) + CW_BAR, (volatile LAS unsigned*)(lds + LDSCTL_OFF));
#define GRID_BAR() xcd_barrier(bar)
#else
#define GRID_BAR() do {} while (0)
#endif
#ifndef PHMASK
#define PHMASK 0x1FF
#endif
#define KIND(kk) ((PHMASK >> (kk)) & 1)
#ifndef REP_NORM
#define REP_NORM 1
#endif
#ifndef REP_INPROJ
#define REP_INPROJ 1
#endif
#ifndef REP_MIX1
#define REP_MIX1 1
#endif
#ifndef REP_MIX3
#define REP_MIX3 1
#endif
#ifndef REP_MERGE
#define REP_MERGE 1
#endif
#ifdef EMU
#define LAUNDER() do {} while (0)
#else
#define LAUNDER() do { unsigned m_ = ~0u; int w_ = wave_s; asm volatile("" : "+s"(m_), "+s"(w_));   \
    c.lane = (int)__builtin_amdgcn_mbcnt_hi(m_, __builtin_amdgcn_mbcnt_lo(m_, 0u)); c.wave = w_; c.tid = w_ * 64 + c.lane; c.scr = lds + w_ * WSCR; } while (0)
#endif
#define IN(k) (lo <= (k) && (k) < hi)
#define SEAM(k) do { if (hi > (k) + 1) GRID_BAR(); } while (0)

  #ifndef REP_PRO
#define REP_PRO 1
#endif
  if (KIND(0) && IN(PH_PRO)) { _Pragma("unroll 1") for (int rp = 0; rp < REP_PRO; ++rp) { LAUNDER(); phase_prologue(c); } __syncthreads();   }

  for (int l = 0; l < DEPTH; ++l) {
    const int pb = 1 + l * PH_PER_LAYER;
    if (KIND(1) && IN(pb + 0)) { _Pragma("unroll 1") for (int rep = 0; rep < REP_NORM; ++rep) { LAUNDER(); phase_norm(c, l); SEAM(pb + 0); } }
    if (KIND(2) && IN(pb + 1)) _Pragma("unroll 1") for (int rep = 0; rep < REP_INPROJ; ++rep) { LAUNDER();
      pg8::Gemm g{(const bf16_t*)(c.ws + WS_HIN), (const bf16_t*)(c.ws + WS_WIN) + (size_t)l * NP * D, T, NP, D, D, D, 0, 0};
      pg8::StaticOrder S; S.init(T, NP, c.G, c.bid);
      EpiInproj E{(bf16_t*)(c.ws + WS_P), c.out, l};
      pg8::gemm_phase<EpiInproj, pg8::StaticOrder, true>(lds, g, S, E, c.tid);
      SEAM(pb + 1);
    }
    if (KIND(3) && IN(pb + 2)) _Pragma("unroll 1") for (int rep = 0; rep < REP_MIX1; ++rep) { LAUNDER();
#ifndef SUBMASK
#define SUBMASK 15
#endif
#ifndef REP_CONV
#define REP_CONV 1
#endif
#ifndef REP_ATTN
#define REP_ATTN 1
#endif
#ifndef REP_LOC
#define REP_LOC 1
#endif
      _Pragma("unroll 1") for (int rp = 0; rp < REP_CONV; ++rp) phase_conv(c, l);
      const int gwv = c.bid * NWAVES + c.wave, NGW = c.G * NWAVES;
      { const int NF = NGW > NLONGW ? NGW - NLONGW : 0, ND = NF < NUA / 2 ? NF : NUA / 2;
        _Pragma("unroll 1") for (int rp = 0; rp < REP_ATTN; ++rp) for (int u = gwv; u < NUA - ND; u += NGW) attn_unit(c, l, u); }
      _Pragma("unroll 1") for (int rp = 0; rp < REP_LOC; ++rp) {
      for (int u = (gwv + (NGW * 9) / 16) % NGW; u < NCHUNK * 5; u += NGW) scan_local_unit<0>(c, l, u / 5, u % 5);
      for (int u = (gwv + (NGW * 14) / 16) % NGW; u < NCHUNK * 4; u += NGW) scan_local_unit<1>(c, l, u >> 2, u & 3); }
      SEAM(pb + 2);
    }
    #ifndef REP_MIX2
#define REP_MIX2 1
#endif
    if (KIND(4) && IN(pb + 3)) _Pragma("unroll 1") for (int rp = 0; rp < REP_MIX2; ++rp) { LAUNDER();
      const int wv = c.wave * c.G + c.bid, NGW = c.G * NWAVES;
      constexpr int NIT = NSEQ * 129 + NSEQ * 128;
      for (int wi = wv; 2 * wi < NIT; wi += NGW) scan_prop_item(c, l, 2 * wi + (c.lane >> 5));
      { const int NF = NGW > NLONGW ? NGW - NLONGW : 0, ND = NF < NUA / 2 ? NF : NUA / 2;
        if (wv >= NLONGW && wv - NLONGW < ND) attn_unit(c, l, NUA - ND + (wv - NLONGW)); }
      SEAM(pb + 3);
    }
    if (KIND(5) && IN(pb + 4)) _Pragma("unroll 1") for (int rep = 0; rep < REP_MIX3; ++rep) { LAUNDER();
      const int gwv = c.bid * NWAVES + c.wave, NGW = c.G * NWAVES;
      for (int u = gwv; u < NCHUNK * 2; u += NGW) scan_apply_unit<0>(c, l, u >> 1, u & 1);
      for (int u = (gwv + NGW / 2) % NGW; u < NCHUNK * 2; u += NGW) scan_apply_unit<1>(c, l, u >> 1, u & 1);
      SEAM(pb + 4);
    }
    if (KIND(6) && IN(pb + 5)) _Pragma("unroll 1") for (int rep = 0; rep < REP_MERGE; ++rep) { LAUNDER();
      pg8::Gemm g{(const bf16_t*)(c.ws + WS_YCAT), (const bf16_t*)(c.ws + WS_WBR) + (size_t)l * D * D, TP, D, D, D, D, 0, 0};
      pg8::StaticOrder S; S.init(TP, D, c.G, c.bid);
      EpiMergeH E{(const bf16_t*)(c.ws + WS_P), (bf16_t*)(c.ws + WS_MG)};
      pg8::gemm_phase<EpiMergeH, pg8::StaticOrder, true>(lds, g, S, E, c.tid);
      sample_tail_gemm<0>(c, l, (const bf16_t*)(c.ws + WS_WBR) + (size_t)l * D * D, (const bf16_t*)(c.ws + WS_YCAT) + (size_t)TP * D);
      SEAM(pb + 5);
    }
    #ifndef REP_OUT0
#define REP_OUT0 1
#endif
    if (KIND(7) && IN(pb + 6)) _Pragma("unroll 1") for (int rp = 0; rp < (l == 0 ? REP_OUT0 : 1); ++rp) { LAUNDER();
      pg8::Gemm g{(const bf16_t*)(c.ws + WS_MG), (const bf16_t*)(c.ws + WS_WOUT) + (size_t)l * D * D, TP, D, D, D, D, 0, 0};
      pg8::StaticOrder S; S.init(TP, D, c.G, c.bid);
      EpiOut E{c.in[IN_XP], c.in[IN_XS], c.out + O_Y, c.out + O_Y, l};
      pg8::gemm_phase<EpiOut, pg8::StaticOrder, true>(lds, g, S, E, c.tid);
      sample_tail_gemm<1>(c, l, (const bf16_t*)(c.ws + WS_WOUT) + (size_t)l * D * D, (const bf16_t*)(c.ws + WS_MG) + (size_t)TP * D);
      SEAM(pb + 6);
    }
  }
  if (KIND(8) && IN(PH_FINAL)) { LAUNDER(); phase_final(c); }
#undef IN
#undef SEAM
}

#ifndef N_LAUNCHES
#define N_LAUNCHES 1
#endif
#ifdef EMU
void emu_after_phase(int p, unsigned char* ws, float* out);
#endif
extern "C" void kernel_launch(void* const* d_in, const int* in_sizes, int n_in, void* d_out, int out_size, void* d_ws, size_t ws_size, hipStream_t stream) {
  (void)in_sizes; (void)n_in; (void)out_size; (void)ws_size;
  Args a;
  memset(&a, 0, sizeof(a));
  for (int i = 0; i < 20; ++i) a.in[i] = (const float*)d_in[i];
  a.out = (float*)d_out; a.ws = (unsigned char*)d_ws;
#ifdef EMU
  int grid = EMU_GRID;
  for (int p = 0; p < PH_COUNT; ++p) { a.ph_lo = p; a.ph_hi = p + 1; emu_launch(fwd, grid, NTHREADS, LDS_BYTES, a); emu_after_phase(p, a.ws, a.out); }
#else
  static int grid = 0;
  if (grid == 0) {
    int dev = 0, cus = 0;
    if (hipGetDevice(&dev) != hipSuccess || hipDeviceGetAttribute(&cus, hipDeviceAttributeMultiprocessorCount, dev) != hipSuccess) { grid = -1; return; }
    if (hipFuncSetAttribute((const void*)fwd, hipFuncAttributeMaxDynamicSharedMemorySize, LDS_BYTES) != hipSuccess) { grid = -1; return; }
    int per_cu = 0;
    (void)hipOccupancyMaxActiveBlocksPerMultiprocessor(&per_cu, (const void*)fwd, NTHREADS, LDS_BYTES);
    (void)hipGetLastError();
    grid = cus;
  }
  if (grid < 0) return;
  (void)hipMemsetAsync((char*)d_ws + WS_CTL, 0, CTL_BYTES, stream);
  if (N_LAUNCHES == 1) { a.ph_lo = 0; a.ph_hi = PH_COUNT; hipLaunchKernelGGL(fwd, dim3(grid), dim3(NTHREADS), LDS_BYTES, stream, a); }
  else for (int p = 0; p < PH_COUNT; ++p) { a.ph_lo = p; a.ph_hi = p + 1; hipLaunchKernelGGL(fwd, dim3(grid), dim3(NTHREADS), LDS_BYTES, stream, a); }
#endif
}
```
